# Optimizing an MI355X kernel written in HIP

```python
import math
import jax, jax.numpy as jnp
from jax import lax
import numpy as np

D_MODEL = 1024
BATCH = 1
SEQ = 16384
DEPTH = 4
DEC_BATCH = 16
DEC_SEQ = 32
PAST_LEN = 2048

CHUNK = 64
QBLOCK = 128
N_MIXERS = 3
HEAD_DIM = 64
DIFF_HEADS = D_MODEL // (2 * HEAD_DIM)
SWA_Q_HEADS = D_MODEL // HEAD_DIM
SWA_KV_HEADS = 4
SWA_GROUP = SWA_Q_HEADS // SWA_KV_HEADS
WINDOW = 128
WIN_CHUNKS = WINDOW // CHUNK
SB_HEADS = D_MODEL // HEAD_DIM
N_BUCKETS = 32
MAX_DISTANCE = 128
BIAS_HEADS = 2 * DIFF_HEADS
D_FF = 4 * D_MODEL
EPS = 1e-6
N_DIFF = (DEPTH + 2) // 3
N_SWA = (DEPTH + 1) // 3
N_SB = DEPTH // 3

kernel_name = 'hybrid_streaming_diff_swa_stickbreak'


def rmsnorm(x, g):
    xf = x.astype(jnp.float32)
    y = xf * lax.rsqrt(jnp.mean(xf * xf, axis=-1, keepdims=True) + EPS)
    return (y * g.astype(jnp.float32)).astype(x.dtype)


def t5_bucket(rel):
    half = N_BUCKETS // 2
    exact = half // 2
    ret = jnp.where(rel > 0, half, 0).astype(jnp.int32)
    n = jnp.abs(rel)
    nf = jnp.maximum(n, 1).astype(jnp.float32)
    large = exact + (jnp.log(nf / exact) / math.log(MAX_DISTANCE / exact) * (half - exact)).astype(jnp.int32)
    large = jnp.minimum(large, half - 1)
    return ret + jnp.where(n < exact, n, large)


def pos_bias(rel_bias, rel):
    return jnp.moveaxis(rel_bias.astype(jnp.float32)[t5_bucket(rel)], -1, 0)


def split_blocks(x):
    b, t = x.shape[:2]
    return jnp.moveaxis(x.reshape(b, t // QBLOCK, QBLOCK, *x.shape[2:]), 1, 0)


def merge_blocks(o):
    nb, b, qb = o.shape[:3]
    return jnp.moveaxis(o, 0, 1).reshape(b, nb * qb, -1)


def mlp(h, w_up, w_down):
    return jnp.square(jax.nn.relu(h @ w_up)) @ w_down


def diff_project(h, w_qkv, q_gain, k_gain):
    b, t, _ = h.shape
    q, k, v = jnp.split(h @ w_qkv, 3, axis=-1)
    q = rmsnorm(q.reshape(b, t, DIFF_HEADS, 2, HEAD_DIM), q_gain) * (HEAD_DIM ** -0.5)
    k = rmsnorm(k.reshape(b, t, DIFF_HEADS, 2, HEAD_DIM), k_gain)
    return q, k, v.reshape(b, t, DIFF_HEADS, 2 * HEAD_DIM)


def diff_lambda_value(lam_p, lam_init):
    lp = lam_p.astype(jnp.float32)
    return jnp.exp(jnp.sum(lp[0] * lp[1])) - jnp.exp(jnp.sum(lp[2] * lp[3])) + lam_init


def diff_core(q, k, v, bias, mask, lam, lam_init, subln):
    logits = jnp.einsum('bqhmd,bshmd->bhmqs', q, k, preferred_element_type=jnp.float32)
    logits = logits + bias.reshape(DIFF_HEADS, 2, *bias.shape[1:])
    p = jax.nn.softmax(jnp.where(mask, logits, -jnp.inf), axis=-1)
    a = p[:, :, 0] - lam * p[:, :, 1]
    o = jnp.einsum('bhqs,bshe->bqhe', a, v.astype(jnp.float32))
    return rmsnorm(o, subln) * (1.0 - lam_init)


def diff_prompt(h, rel_bias, w_qkv, w_o, q_gain, k_gain, lam_p, subln, lam_init):
    b, t, _ = h.shape
    lam = diff_lambda_value(lam_p, lam_init)
    q, k, v = diff_project(h, w_qkv, q_gain, k_gain)
    s = jnp.arange(t)

    def block(args):
        qi, bi = args
        tq = bi * QBLOCK + jnp.arange(QBLOCK)
        mask = (s // CHUNK)[None, :] <= (tq // CHUNK)[:, None]
        return diff_core(qi, k, v, pos_bias(rel_bias, s[None, :] - tq[:, None]), mask, lam, lam_init, subln)

    o = merge_blocks(lax.map(block, (split_blocks(q), jnp.arange(t // QBLOCK))))
    y = o.astype(h.dtype) @ w_o
    return y, k.reshape(b, t, DIFF_HEADS, 2 * HEAD_DIM), v


def diff_sample(h, ck, cv, rel_bias, w_qkv, w_o, q_gain, k_gain, lam_p, subln, lam_init):
    b, t, _ = h.shape
    p_len = ck.shape[1]
    lam = diff_lambda_value(lam_p, lam_init)
    q, k, v = diff_project(h, w_qkv, q_gain, k_gain)
    kk = jnp.concatenate([ck.reshape(b, p_len, DIFF_HEADS, 2, HEAD_DIM), k], axis=1)
    vv = jnp.concatenate([cv, v], axis=1)
    s_pos = jnp.arange(p_len + t) - p_len
    t_pos = jnp.arange(t)
    mask = (s_pos // CHUNK)[None, :] <= (t_pos // CHUNK)[:, None]
    o = diff_core(q, kk, vv, pos_bias(rel_bias, s_pos[None, :] - t_pos[:, None]), mask, lam, lam_init, subln)
    y = o.reshape(b, t, D_MODEL).astype(h.dtype) @ w_o
    return y, k.reshape(b, t, DIFF_HEADS, 2 * HEAD_DIM), v


def swa_project(h, w_qkv, q_gain, k_gain):
    b, t, _ = h.shape
    nq = SWA_Q_HEADS * HEAD_DIM
    nkv = SWA_KV_HEADS * HEAD_DIM
    qkv = h @ w_qkv
    q = qkv[..., :nq].reshape(b, t, SWA_KV_HEADS, SWA_GROUP, HEAD_DIM)
    k = qkv[..., nq:nq + nkv].reshape(b, t, SWA_KV_HEADS, HEAD_DIM)
    v = qkv[..., nq + nkv:].reshape(b, t, SWA_KV_HEADS, HEAD_DIM)
    return rmsnorm(q, q_gain) * (HEAD_DIM ** -0.5), rmsnorm(k, k_gain), v


def swa_core(q, k, v, bias, mask, sinks):
    logits = jnp.einsum('...qkgd,...skd->...kgqs', q, k, preferred_element_type=jnp.float32)
    logits = logits + bias.reshape(SWA_KV_HEADS, SWA_GROUP, *bias.shape[1:])
    logits = jnp.where(mask, logits, -jnp.inf)
    sink = jnp.broadcast_to(sinks.astype(jnp.float32).reshape(SWA_KV_HEADS, SWA_GROUP, 1, 1),
                            logits.shape[:-1] + (1,))
    p = jax.nn.softmax(jnp.concatenate([logits, sink], axis=-1), axis=-1)[..., :-1]
    return jnp.einsum('...kgqs,...skd->...qkgd', p, v.astype(jnp.float32))


def swa_prompt(h, rel_bias, w_qkv, w_o, q_gain, k_gain, sinks):
    b, t, _ = h.shape
    nc = t // CHUNK
    q, k, v = swa_project(h, w_qkv, q_gain, k_gain)
    qc = q.reshape(b, nc, CHUNK, SWA_KV_HEADS, SWA_GROUP, HEAD_DIM)

    def band(x):
        xc = jnp.pad(x.reshape(b, nc, CHUNK, SWA_KV_HEADS, HEAD_DIM),
                     ((0, 0), (WIN_CHUNKS, 0), (0, 0), (0, 0), (0, 0)))
        return jnp.concatenate([xc[:, w:w + nc] for w in range(WIN_CHUNKS + 1)], axis=2)

    kb, vb = band(k), band(v)
    sb = (WIN_CHUNKS + 1) * CHUNK
    j = jnp.arange(sb)
    rel = j[None, :] - WIN_CHUNKS * CHUNK - jnp.arange(CHUNK)[:, None]
    valid = ((jnp.arange(nc)[:, None] - WIN_CHUNKS) * CHUNK + j[None, :]) >= 0
    mask = valid[None, :, None, None, None, :]
    o = swa_core(qc, kb, vb, pos_bias(rel_bias, rel), mask, sinks).reshape(b, t, SWA_Q_HEADS * HEAD_DIM)
    y = o.astype(h.dtype) @ w_o
    buf = min(WINDOW, t)
    return y, k[:, t - buf:], v[:, t - buf:]


def swa_sample(h, ck, cv, rel_bias, w_qkv, w_o, q_gain, k_gain, sinks):
    b, t, _ = h.shape
    buf = ck.shape[1]
    q, k, v = swa_project(h, w_qkv, q_gain, k_gain)
    kk = jnp.concatenate([ck, k], axis=1)
    vv = jnp.concatenate([cv, v], axis=1)
    s_pos = jnp.arange(buf + t) - buf
    t_pos = jnp.arange(t)
    sc, tc = s_pos // CHUNK, t_pos // CHUNK
    mask = (sc[None, :] <= tc[:, None]) & (sc[None, :] >= tc[:, None] - WIN_CHUNKS)
    o = swa_core(q, kk, vv, pos_bias(rel_bias, s_pos[None, :] - t_pos[:, None]), mask, sinks)
    y = o.reshape(b, t, SWA_Q_HEADS * HEAD_DIM).astype(h.dtype) @ w_o
    return y, kk[:, t:], vv[:, t:]


def sb_project(h, w_qkv):
    b, t, _ = h.shape
    q, k, v = jnp.split(h @ w_qkv, 3, axis=-1)
    shp = (b, t, SB_HEADS, HEAD_DIM)
    return q.reshape(shp), k.reshape(shp), v.reshape(shp)


def sb_core(q, k, v, mask):
    z = jnp.einsum('bqhd,bshd->bhqs', q, k, preferred_element_type=jnp.float32) * (HEAD_DIM ** -0.5)
    log_1m = jnp.where(mask, jax.nn.log_sigmoid(-z), 0.0)
    after = lax.cumsum(log_1m, axis=3, reverse=True) - log_1m
    a = jnp.where(mask, jnp.exp(jax.nn.log_sigmoid(z) + after), 0.0)
    return jnp.einsum('bhqs,bshd->bqhd', a, v.astype(jnp.float32))


def sb_prompt(h, w_qkv, w_o):
    b, t, _ = h.shape
    q, k, v = sb_project(h, w_qkv)
    s = jnp.arange(t)

    def block(args):
        qi, bi = args
        tq = bi * QBLOCK + jnp.arange(QBLOCK)
        return sb_core(qi, k, v, s[None, :] < tq[:, None])

    o = merge_blocks(lax.map(block, (split_blocks(q), jnp.arange(t // QBLOCK))))
    return o.astype(h.dtype) @ w_o, k, v


def sb_sample(h, ck, cv, w_qkv, w_o):
    b, t, _ = h.shape
    p_len = ck.shape[1]
    q, k, v = sb_project(h, w_qkv)
    kk = jnp.concatenate([ck, k], axis=1)
    vv = jnp.concatenate([cv, v], axis=1)
    s_pos = jnp.arange(p_len + t) - p_len
    mask = s_pos[None, :] < jnp.arange(t)[:, None]
    o = sb_core(q, kk, vv, mask).reshape(b, t, SB_HEADS * HEAD_DIM)
    return o.astype(h.dtype) @ w_o, k, v


def setup_inputs(seed: int = 0) -> dict:
    key = jax.random.key(seed)
    ks = jax.random.split(key, 26)

    def nrm(kk, shape, scale):
        return jax.random.normal(kk, shape, jnp.float32) * scale

    def gain(kk, shape):
        return 1.0 + 0.02 * jax.random.normal(kk, shape, jnp.float32)

    swa_buf = min(WINDOW, PAST_LEN)
    swa_qkv = (SWA_Q_HEADS + 2 * SWA_KV_HEADS) * HEAD_DIM
    return {
        'x_prompt': nrm(ks[0], (BATCH, SEQ, D_MODEL), 1.0),
        'x_sample': nrm(ks[1], (DEC_BATCH, DEC_SEQ, D_MODEL), 1.0),
        'cache_diff_k': nrm(ks[2], (N_DIFF, DEC_BATCH, PAST_LEN, DIFF_HEADS, 2 * HEAD_DIM), 1.0),
        'cache_diff_v': nrm(ks[3], (N_DIFF, DEC_BATCH, PAST_LEN, DIFF_HEADS, 2 * HEAD_DIM), 1.0),
        'cache_swa_k': nrm(ks[4], (N_SWA, DEC_BATCH, swa_buf, SWA_KV_HEADS, HEAD_DIM), 1.0),
        'cache_swa_v': nrm(ks[5], (N_SWA, DEC_BATCH, swa_buf, SWA_KV_HEADS, HEAD_DIM), 1.0),
        'cache_sb_k': nrm(ks[6], (N_SB, DEC_BATCH, PAST_LEN, SB_HEADS, HEAD_DIM), 1.0),
        'cache_sb_v': nrm(ks[7], (N_SB, DEC_BATCH, PAST_LEN, SB_HEADS, HEAD_DIM), 1.0),
        'rel_bias': nrm(ks[8], (N_BUCKETS, BIAS_HEADS), 0.5),
        'norm_mix': gain(ks[9], (DEPTH, D_MODEL)),
        'norm_mlp': gain(ks[10], (DEPTH, D_MODEL)),
        'w_up': nrm(ks[11], (DEPTH, D_MODEL, D_FF), D_MODEL ** -0.5),
        'w_down': nrm(ks[12], (DEPTH, D_FF, D_MODEL), D_FF ** -0.5),
        'diff_w_qkv': nrm(ks[13], (N_DIFF, D_MODEL, 3 * D_MODEL), D_MODEL ** -0.5),
        'diff_w_o': nrm(ks[14], (N_DIFF, D_MODEL, D_MODEL), D_MODEL ** -0.5),
        'diff_q_norm': gain(ks[15], (N_DIFF, HEAD_DIM)),
        'diff_k_norm': gain(ks[16], (N_DIFF, HEAD_DIM)),
        'diff_lambda': nrm(ks[17], (N_DIFF, 4, HEAD_DIM), 0.1),
        'diff_subln': gain(ks[18], (N_DIFF, 2 * HEAD_DIM)),
        'swa_w_qkv': nrm(ks[19], (N_SWA, D_MODEL, swa_qkv), D_MODEL ** -0.5),
        'swa_w_o': nrm(ks[20], (N_SWA, SWA_Q_HEADS * HEAD_DIM, D_MODEL), (SWA_Q_HEADS * HEAD_DIM) ** -0.5),
        'swa_q_norm': gain(ks[21], (N_SWA, HEAD_DIM)),
        'swa_k_norm': gain(ks[22], (N_SWA, HEAD_DIM)),
        'swa_sinks': nrm(ks[23], (N_SWA, SWA_Q_HEADS), 0.5),
        'sb_w_qkv': nrm(ks[24], (N_SB, D_MODEL, 3 * SB_HEADS * HEAD_DIM), D_MODEL ** -0.5),
        'sb_w_o': nrm(ks[25], (N_SB, SB_HEADS * HEAD_DIM, D_MODEL), (SB_HEADS * HEAD_DIM) ** -0.5),
    }


def reference(x_prompt, x_sample, cache_diff_k, cache_diff_v, cache_swa_k, cache_swa_v,
              cache_sb_k, cache_sb_v, rel_bias, norm_mix, norm_mlp, w_up, w_down,
              diff_w_qkv, diff_w_o, diff_q_norm, diff_k_norm, diff_lambda, diff_subln,
              swa_w_qkv, swa_w_o, swa_q_norm, swa_k_norm, swa_sinks, sb_w_qkv, sb_w_o):
    xp, xs = x_prompt, x_sample
    pdk, pdv, pwk, pwv, pbk, pbv = [], [], [], [], [], []
    sdk, sdv, swk, swv, sbk, sbv = [], [], [], [], [], []
    for i in range(DEPTH):
        j = i // N_MIXERS
        hp = rmsnorm(xp, norm_mix[i])
        hs = rmsnorm(xs, norm_mix[i])
        if i % N_MIXERS == 0:
            lam_init = 0.8 - 0.6 * math.exp(-0.3 * i)
            yp, kp, vp = diff_prompt(hp, rel_bias, diff_w_qkv[j], diff_w_o[j], diff_q_norm[j],
                                     diff_k_norm[j], diff_lambda[j], diff_subln[j], lam_init)
            ys, kn, vn = diff_sample(hs, cache_diff_k[j], cache_diff_v[j], rel_bias, diff_w_qkv[j],
                                     diff_w_o[j], diff_q_norm[j], diff_k_norm[j], diff_lambda[j],
                                     diff_subln[j], lam_init)
            pdk.append(kp); pdv.append(vp); sdk.append(kn); sdv.append(vn)
        elif i % N_MIXERS == 1:
            yp, kp, vp = swa_prompt(hp, rel_bias, swa_w_qkv[j], swa_w_o[j], swa_q_norm[j],
                                    swa_k_norm[j], swa_sinks[j])
            ys, kn, vn = swa_sample(hs, cache_swa_k[j], cache_swa_v[j], rel_bias, swa_w_qkv[j],
                                    swa_w_o[j], swa_q_norm[j], swa_k_norm[j], swa_sinks[j])
            pwk.append(kp); pwv.append(vp); swk.append(kn); swv.append(vn)
        else:
            yp, kp, vp = sb_prompt(hp, sb_w_qkv[j], sb_w_o[j])
            ys, kn, vn = sb_sample(hs, cache_sb_k[j], cache_sb_v[j], sb_w_qkv[j], sb_w_o[j])
            pbk.append(kp); pbv.append(vp); sbk.append(kn); sbv.append(vn)
        xp = xp + yp
        xs = xs + ys
        xp = xp + mlp(rmsnorm(xp, norm_mlp[i]), w_up[i], w_down[i])
        xs = xs + mlp(rmsnorm(xs, norm_mlp[i]), w_up[i], w_down[i])
    return (xp, xs,
            jnp.stack(pdk), jnp.stack(pdv), jnp.stack(pwk), jnp.stack(pwv), jnp.stack(pbk), jnp.stack(pbv),
            jnp.stack(sdk), jnp.stack(sdv), jnp.stack(swk), jnp.stack(swv), jnp.stack(sbk), jnp.stack(sbv))
```

```cpp
#include <hip/hip_runtime.h>
#include <cstdio>
#include <cstdint>
#include <cmath>
namespace nv {
constexpr int D = 1024, TP = 16384, TS = 512, T = TP + TS, FF = 4096;

__device__ __forceinline__ float wave_sum(float v) {
#pragma unroll
    for (int o = 32; o; o >>= 1) v += __shfl_xor(v, o);
    return v;
}
__device__ __forceinline__ int t5_bucket(int rel) {
    const int ret = rel > 0 ? 16 : 0; const int n = rel < 0 ? -rel : rel;
    const int b = n < 8 ? n : n < 12 ? 8 : n < 16 ? 9 : n < 23 ? 10 : n < 32 ? 11 : n < 46 ? 12 : n < 64 ? 13 : n < 91 ? 14 : 15;
    return ret + b;
}
__global__ __launch_bounds__(256) void rmsnorm_rows(const float* __restrict__ x, const float* __restrict__ g, float* __restrict__ out, int rows) {
    const int row = blockIdx.x * 4 + (threadIdx.x >> 6), lane = threadIdx.x & 63;
    if (row >= rows) return;
    const float4* xr = (const float4*)(x + (size_t)row * D); const float4* gr = (const float4*)g; float4* orow = (float4*)(out + (size_t)row * D);
    float4 v[4]; float s = 0.f;
#pragma unroll
    for (int j = 0; j < 4; ++j) { v[j] = xr[lane + 64 * j]; s += v[j].x * v[j].x + v[j].y * v[j].y + v[j].z * v[j].z + v[j].w * v[j].w; }
    s = wave_sum(s);
    const float r = rsqrtf(s * (1.f / D) + 1e-6f);
#pragma unroll
    for (int j = 0; j < 4; ++j) { const float4 gg = gr[lane + 64 * j]; float4 o; o.x = v[j].x * r * gg.x; o.y = v[j].y * r * gg.y; o.z = v[j].z * r * gg.z; o.w = v[j].w * r * gg.w; orow[lane + 64 * j] = o; }
}
template <int EPI>
__global__ __launch_bounds__(256) void gemm_f32(const float* __restrict__ A, const float* __restrict__ B, float* C, const float* R, int M, int N, int K) {
    __shared__ float As[16][132]; __shared__ float Bs[16][132];
    const int tid = threadIdx.x, tx = tid & 15, ty = tid >> 4;
    const int bm = blockIdx.y * 128, bn = blockIdx.x * 128;
    float acc[8][8];
#pragma unroll
    for (int i = 0; i < 8; ++i)
#pragma unroll
        for (int j = 0; j < 8; ++j) acc[i][j] = 0.f;
    for (int k0 = 0; k0 < K; k0 += 16) {
#pragma unroll
        for (int i = 0; i < 2; ++i) { const int row = (tid >> 2) + 64 * i, kq = (tid & 3) * 4;
            const float4 a = *(const float4*)(A + (size_t)(bm + row) * K + k0 + kq);
            As[kq + 0][row] = a.x; As[kq + 1][row] = a.y; As[kq + 2][row] = a.z; As[kq + 3][row] = a.w; }
#pragma unroll
        for (int i = 0; i < 2; ++i) { const int kr = (tid >> 5) + 8 * i, col = (tid & 31) * 4;
            *(float4*)&Bs[kr][col] = *(const float4*)(B + (size_t)(k0 + kr) * N + bn + col); }
        __syncthreads();
#pragma unroll
        for (int k = 0; k < 16; ++k) {
            const float4 a0 = *(const float4*)&As[k][ty * 4], a1 = *(const float4*)&As[k][64 + ty * 4];
            const float4 b0 = *(const float4*)&Bs[k][tx * 4], b1 = *(const float4*)&Bs[k][64 + tx * 4];
            const float a[8] = {a0.x, a0.y, a0.z, a0.w, a1.x, a1.y, a1.z, a1.w}, b[8] = {b0.x, b0.y, b0.z, b0.w, b1.x, b1.y, b1.z, b1.w};
#pragma unroll
            for (int i = 0; i < 8; ++i)
#pragma unroll
                for (int j = 0; j < 8; ++j) acc[i][j] += a[i] * b[j];
        }
        __syncthreads();
    }
#pragma unroll
    for (int i = 0; i < 8; ++i) { const int row = bm + (i < 4 ? ty * 4 + i : 64 + ty * 4 + i - 4);
#pragma unroll
        for (int jj = 0; jj < 2; ++jj) { const int col = bn + jj * 64 + tx * 4; const size_t off = (size_t)row * N + col;
            float4 v = {acc[i][jj * 4 + 0], acc[i][jj * 4 + 1], acc[i][jj * 4 + 2], acc[i][jj * 4 + 3]};
            if (EPI == 1) { v.x = v.x > 0.f ? v.x * v.x : 0.f; v.y = v.y > 0.f ? v.y * v.y : 0.f; v.z = v.z > 0.f ? v.z * v.z : 0.f; v.w = v.w > 0.f ? v.w * v.w : 0.f; }
            if (EPI == 2) { const float4 r = *(const float4*)(R + off); v.x += r.x; v.y += r.y; v.z += r.z; v.w += r.w; }
            *(float4*)(C + off) = v; } }
}
__global__ __launch_bounds__(256) void split_norm(const float* __restrict__ src, int ld, int nq, int nk, int has_norm, const float* __restrict__ qg, const float* __restrict__ kg, float qscale,
                                                  float* __restrict__ qdst, float* __restrict__ kp, float* __restrict__ vp, float* __restrict__ ks, float* __restrict__ vs, int rows) {
    const int row = blockIdx.x * 4 + (threadIdx.x >> 6), lane = threadIdx.x & 63;
    if (row >= rows) return;
    const float* s = src + (size_t)row * ld; const int ng = nq + 2 * nk;
    for (int g = 0; g < ng; ++g) {
        float v = s[g * 64 + lane];
        if (g < nq) { if (has_norm) { const float ss = wave_sum(v * v); v = v * rsqrtf(ss * (1.f / 64.f) + 1e-6f) * qg[lane]; } qdst[(size_t)row * (nq * 64) + g * 64 + lane] = v * qscale; }
        else if (g < nq + nk) { if (has_norm) { const float ss = wave_sum(v * v); v = v * rsqrtf(ss * (1.f / 64.f) + 1e-6f) * kg[lane]; }
            float* d = row < TP ? kp + (size_t)row * (nk * 64) : ks + (size_t)(row - TP) * (nk * 64); d[(g - nq) * 64 + lane] = v; }
        else { float* d = row < TP ? vp + (size_t)row * (nk * 64) : vs + (size_t)(row - TP) * (nk * 64); d[(g - nq - nk) * 64 + lane] = v; }
    }
}
__global__ __launch_bounds__(64) void attn_diff_naive(const float* __restrict__ q, const float* __restrict__ k0, const float* __restrict__ v0, int len0,
                                                      const float* __restrict__ k1, const float* __restrict__ v1, int nq, const float* __restrict__ rel_bias, float* __restrict__ omaps) {
    const int c = gridDim.x - 1 - blockIdx.x, hm = blockIdx.y, seq = blockIdx.z, h = hm >> 1;
    const int t = c * 64 + threadIdx.x; const bool act = t < nq; const int tt = act ? t : nq - 1;
    const size_t row = (size_t)seq * nq + tt;
    float qv[64];
#pragma unroll
    for (int d = 0; d < 64; ++d) qv[d] = q[row * 1024 + hm * 64 + d];
    float o[128];
#pragma unroll
    for (int e = 0; e < 128; ++e) o[e] = 0.f;
    float mx = -INFINITY, l = 0.f;
    const int vis = (c + 1) * 64 < nq ? (c + 1) * 64 : nq; const int L = len0 + vis;
    for (int idx = 0; idx < L; ++idx) {
        const float* kr; const float* vr;
        if (idx < len0) { const size_t r = (size_t)seq * len0 + idx; kr = k0 + r * 1024 + hm * 64; vr = v0 + r * 1024 + h * 128; }
        else { const size_t r = (size_t)seq * nq + (idx - len0); kr = k1 + r * 1024 + hm * 64; vr = v1 + r * 1024 + h * 128; }
        float dot = 0.f;
#pragma unroll
        for (int d = 0; d < 64; ++d) dot += qv[d] * kr[d];
        const int rel = (idx - len0) - tt;
        const float logit = dot + rel_bias[t5_bucket(rel) * 16 + hm];
        if (logit > mx) { const float f = expf(mx - logit); l *= f;
#pragma unroll
            for (int e = 0; e < 128; ++e) o[e] *= f;
            mx = logit; }
        const float p = expf(logit - mx); l += p;
#pragma unroll
        for (int e = 0; e < 128; ++e) o[e] += p * vr[e];
    }
    if (act) { const float rl = 1.f / l;
#pragma unroll
        for (int e = 0; e < 128; ++e) omaps[(row * 16 + hm) * 128 + e] = o[e] * rl; }
}
__global__ __launch_bounds__(256) void diff_combine(const float* __restrict__ omaps, const float* __restrict__ lam_p, const float* __restrict__ subln, float lam_init, float* __restrict__ o, int rows) {
    const int wv = blockIdx.x * 4 + (threadIdx.x >> 6), lane = threadIdx.x & 63;
    if (wv >= rows * 8) return;
    const int row = wv >> 3, h = wv & 7;
    const float s01 = wave_sum(lam_p[lane] * lam_p[64 + lane]), s23 = wave_sum(lam_p[128 + lane] * lam_p[192 + lane]);
    const float lam = expf(s01) - expf(s23) + lam_init;
    const float* a = omaps + ((size_t)row * 16 + 2 * h) * 128; const float* b = a + 128;
    const float x0 = a[lane] - lam * b[lane], x1 = a[64 + lane] - lam * b[64 + lane];
    const float ss = wave_sum(x0 * x0 + x1 * x1);
    const float r = rsqrtf(ss * (1.f / 128.f) + 1e-6f) * (1.f - lam_init);
    o[(size_t)row * 1024 + h * 128 + lane] = x0 * r * subln[lane]; o[(size_t)row * 1024 + h * 128 + 64 + lane] = x1 * r * subln[64 + lane];
}
__global__ __launch_bounds__(64) void attn_swa_naive(const float* __restrict__ q, const float* __restrict__ k0, const float* __restrict__ v0, int len0,
                                                     const float* __restrict__ k1, const float* __restrict__ v1, int nq, const float* __restrict__ rel_bias, const float* __restrict__ sinks, float* __restrict__ out) {
    const int c = blockIdx.x, hq = blockIdx.y, seq = blockIdx.z, kvh = hq >> 2;
    const int t = c * 64 + threadIdx.x; const bool act = t < nq; const int tt = act ? t : nq - 1;
    const size_t row = (size_t)seq * nq + tt;
    float qv[64], o[64];
#pragma unroll
    for (int d = 0; d < 64; ++d) { qv[d] = q[row * 1024 + hq * 64 + d]; o[d] = 0.f; }
    float mx = sinks[hq], l = 1.f;
    int lo = (c - 2) * 64; if (lo < -len0) lo = -len0; int hi = (c + 1) * 64; if (hi > nq) hi = nq;
    for (int sp = lo; sp < hi; ++sp) {
        const float* kr; const float* vr;
        if (sp < 0) { const size_t r = (size_t)seq * len0 + (sp + len0); kr = k0 + r * 256 + kvh * 64; vr = v0 + r * 256 + kvh * 64; }
        else { const size_t r = (size_t)seq * nq + sp; kr = k1 + r * 256 + kvh * 64; vr = v1 + r * 256 + kvh * 64; }
        float dot = 0.f;
#pragma unroll
        for (int d = 0; d < 64; ++d) dot += qv[d] * kr[d];
        const float logit = dot + rel_bias[t5_bucket(sp - tt) * 16 + hq];
        if (logit > mx) { const float f = expf(mx - logit); l *= f;
#pragma unroll
            for (int e = 0; e < 64; ++e) o[e] *= f;
            mx = logit; }
        const float p = expf(logit - mx); l += p;
#pragma unroll
        for (int e = 0; e < 64; ++e) o[e] += p * vr[e];
    }
    if (act) { const float rl = 1.f / l;
#pragma unroll
        for (int e = 0; e < 64; ++e) out[row * 1024 + hq * 64 + e] = o[e] * rl; }
}
__global__ __launch_bounds__(64) void attn_sb_naive(const float* __restrict__ q, const float* __restrict__ k0, const float* __restrict__ v0, int len0,
                                                    const float* __restrict__ k1, const float* __restrict__ v1, int nq, float* __restrict__ out) {
    const int c = gridDim.x - 1 - blockIdx.x, h = blockIdx.y, seq = blockIdx.z;
    const int t = c * 64 + threadIdx.x; const bool act = t < nq; const int tt = act ? t : nq - 1;
    const size_t row = (size_t)seq * nq + tt;
    float qv[64], o[64];
#pragma unroll
    for (int d = 0; d < 64; ++d) { qv[d] = q[row * 1024 + h * 64 + d]; o[d] = 0.f; }
    float acc = 0.f;
    int hi = (c + 1) * 64; if (hi > nq) hi = nq;
    for (int sp = hi - 1; sp >= -len0; --sp) {
        const float* kr; const float* vr;
        if (sp < 0) { const size_t r = (size_t)seq * len0 + (sp + len0); kr = k0 + r * 1024 + h * 64; vr = v0 + r * 1024 + h * 64; }
        else { const size_t r = (size_t)seq * nq + sp; kr = k1 + r * 1024 + h * 64; vr = v1 + r * 1024 + h * 64; }
        float dot = 0.f;
#pragma unroll
        for (int d = 0; d < 64; ++d) dot += qv[d] * kr[d];
        const float z = dot * 0.125f;
        const float sps = fmaxf(z, 0.f) + log1pf(expf(-fabsf(z)));
        if (sp < tt) { const float a = expf(z - sps + acc); acc -= sps;
#pragma unroll
            for (int e = 0; e < 64; ++e) o[e] += a * vr[e]; }
    }
    if (act) {
#pragma unroll
        for (int e = 0; e < 64; ++e) out[row * 1024 + h * 64 + e] = o[e]; }
}
__global__ void swa_window_out(const float* __restrict__ cache, const float* __restrict__ knew, float* __restrict__ out) {
    const int i = blockIdx.x * blockDim.x + threadIdx.x; if (i >= 16 * 128 * 256) return;
    const int cc = i & 255, r = (i >> 8) & 127, b = i >> 15;
    out[i] = r < 96 ? cache[((size_t)b * 128 + r + 32) * 256 + cc] : knew[((size_t)b * 32 + r - 96) * 256 + cc];
}
struct Out {
    static constexpr size_t Y = 0, DKP = (size_t)T * D, DVP = DKP + 2ull * TP * D, WKP = DVP + 2ull * TP * D, WVP = WKP + 32768, BKP = WVP + 32768, BVP = BKP + (size_t)TP * D,
        DKS = BVP + (size_t)TP * D, DVS = DKS + 2ull * TS * D, WKS = DVS + 2ull * TS * D, WVS = WKS + 524288, BKS = WVS + 524288, BVS = BKS + 524288, END = BVS + 524288;
};
static_assert(Out::END == 122224640ull, "output size");
struct Ws {
    static constexpr size_t H = 0, QKV = H + (size_t)T * D, Q = QKV + (size_t)T * 3072, OM = Q + (size_t)T * D, O = OM + (size_t)T * 2048, KB = O + (size_t)T * D, VB = KB + (size_t)T * 256, END = VB + (size_t)T * 256, U = QKV;
};
enum In { X_P = 0, X_S, C_DK, C_DV, C_WK, C_WV, C_BK, C_BV, REL_BIAS, NORM_MIX, NORM_MLP, W_UP, W_DOWN, D_WQKV, D_WO, D_QN, D_KN, D_LAM, D_SUBLN, S_WQKV, S_WO, S_QN, S_KN, S_SINKS, B_WQKV, B_WO };

static void run(void* const* d_in, float* out, float* ws, hipStream_t st) {
    auto in = [&](int i) { return (const float*)d_in[i]; };
    float* x = out + Out::Y;
    hipMemcpyAsync(x, in(X_P), (size_t)TP * D * 4, hipMemcpyDeviceToDevice, st);
    hipMemcpyAsync(x + (size_t)TP * D, in(X_S), (size_t)TS * D * 4, hipMemcpyDeviceToDevice, st);
    float *H = ws + Ws::H, *QKV = ws + Ws::QKV, *Q = ws + Ws::Q, *OM = ws + Ws::OM, *O = ws + Ws::O, *KB = ws + Ws::KB, *VB = ws + Ws::VB, *U = ws + Ws::U;
    const float* rb = in(REL_BIAS);
    for (int i = 0; i < 4; ++i) {
        const int mix = i % 3, j = i / 3;
        rmsnorm_rows<<<T / 4, 256, 0, st>>>(x, in(NORM_MIX) + i * D, H, T);
        if (mix == 0) {
            const float lam_init = (float)(0.8 - 0.6 * exp(-0.3 * i));
            gemm_f32<0><<<dim3(3072 / 128, T / 128), 256, 0, st>>>(H, in(D_WQKV) + (size_t)j * D * 3072, QKV, nullptr, T, 3072, D);
            float *kp = out + Out::DKP + (size_t)j * TP * D, *vp = out + Out::DVP + (size_t)j * TP * D, *ks = out + Out::DKS + (size_t)j * TS * D, *vs = out + Out::DVS + (size_t)j * TS * D;
            split_norm<<<T / 4, 256, 0, st>>>(QKV, 3072, 16, 16, 1, in(D_QN) + j * 64, in(D_KN) + j * 64, 0.125f, Q, kp, vp, ks, vs, T);
            attn_diff_naive<<<dim3(256, 16, 1), 64, 0, st>>>(Q, nullptr, nullptr, 0, kp, vp, TP, rb, OM);
            attn_diff_naive<<<dim3(1, 16, 16), 64, 0, st>>>(Q + (size_t)TP * D, in(C_DK) + (size_t)j * 16 * 2048 * D, in(C_DV) + (size_t)j * 16 * 2048 * D, 2048, ks, vs, 32, rb, OM + (size_t)TP * 2048);
            diff_combine<<<T * 8 / 4, 256, 0, st>>>(OM, in(D_LAM) + j * 256, in(D_SUBLN) + j * 128, lam_init, O, T);
            gemm_f32<2><<<dim3(D / 128, T / 128), 256, 0, st>>>(O, in(D_WO) + (size_t)j * D * D, x, x, T, D, D);
        } else if (mix == 1) {
            gemm_f32<0><<<dim3(1536 / 128, T / 128), 256, 0, st>>>(H, in(S_WQKV), QKV, nullptr, T, 1536, D);
            split_norm<<<T / 4, 256, 0, st>>>(QKV, 1536, 16, 4, 1, in(S_QN), in(S_KN), 0.125f, Q, KB, VB, KB + (size_t)TP * 256, VB + (size_t)TP * 256, T);
            attn_swa_naive<<<dim3(256, 16, 1), 64, 0, st>>>(Q, nullptr, nullptr, 0, KB, VB, TP, rb, in(S_SINKS), O);
            attn_swa_naive<<<dim3(1, 16, 16), 64, 0, st>>>(Q + (size_t)TP * D, in(C_WK), in(C_WV), 128, KB + (size_t)TP * 256, VB + (size_t)TP * 256, 32, rb, in(S_SINKS), O + (size_t)TP * D);
            hipMemcpyAsync(out + Out::WKP, KB + (size_t)(TP - 128) * 256, 32768 * 4, hipMemcpyDeviceToDevice, st);
            hipMemcpyAsync(out + Out::WVP, VB + (size_t)(TP - 128) * 256, 32768 * 4, hipMemcpyDeviceToDevice, st);
            swa_window_out<<<16 * 128 * 256 / 256, 256, 0, st>>>(in(C_WK), KB + (size_t)TP * 256, out + Out::WKS);
            swa_window_out<<<16 * 128 * 256 / 256, 256, 0, st>>>(in(C_WV), VB + (size_t)TP * 256, out + Out::WVS);
            gemm_f32<2><<<dim3(D / 128, T / 128), 256, 0, st>>>(O, in(S_WO), x, x, T, D, D);
        } else {
            gemm_f32<0><<<dim3(3072 / 128, T / 128), 256, 0, st>>>(H, in(B_WQKV), QKV, nullptr, T, 3072, D);
            float *kp = out + Out::BKP, *vp = out + Out::BVP, *ks = out + Out::BKS, *vs = out + Out::BVS;
            split_norm<<<T / 4, 256, 0, st>>>(QKV, 3072, 16, 16, 0, nullptr, nullptr, 1.f, Q, kp, vp, ks, vs, T);
            attn_sb_naive<<<dim3(256, 16, 1), 64, 0, st>>>(Q, nullptr, nullptr, 0, kp, vp, TP, O);
            attn_sb_naive<<<dim3(1, 16, 16), 64, 0, st>>>(Q + (size_t)TP * D, in(C_BK), in(C_BV), 2048, ks, vs, 32, O + (size_t)TP * D);
            gemm_f32<2><<<dim3(D / 128, T / 128), 256, 0, st>>>(O, in(B_WO), x, x, T, D, D);
        }
        rmsnorm_rows<<<T / 4, 256, 0, st>>>(x, in(NORM_MLP) + i * D, H, T);
        gemm_f32<1><<<dim3(FF / 128, T / 128), 256, 0, st>>>(H, in(W_UP) + (size_t)i * D * FF, U, nullptr, T, FF, D);
        gemm_f32<2><<<dim3(D / 128, T / 128), 256, 0, st>>>(U, in(W_DOWN) + (size_t)i * FF * D, x, x, T, D, FF);
    }
}
}
extern "C" void kernel_launch(void* const* d_in, const int* in_sizes, int n_in, void* d_out, int out_size, void* d_ws, size_t ws_size, hipStream_t stream) {
    if (n_in != 26 || out_size != (int)nv::Out::END || ws_size < nv::Ws::END * 4) { fprintf(stderr, "kernel_launch: unexpected sizes n_in %d out %d ws %zu\n", n_in, out_size, ws_size); return; }
    nv::run(d_in, (float*)d_out, (float*)d_ws, stream);
}
```

```cpp
#include <hip/hip_runtime.h>
#include <cstdio>
#include <cstdint>
#include <cmath>
namespace pg8 {

#define PG8_LAS __attribute__((address_space(3)))
typedef unsigned short bf16_t;
typedef short bf16x8 __attribute__((ext_vector_type(8)));
typedef float f32x4 __attribute__((ext_vector_type(4)));
typedef unsigned u32x4 __attribute__((ext_vector_type(4)));
constexpr int BM = 256, BK = 64, HALF = 128, HTB = HALF * BK * 2  , STAGE_BYTES = 8 * HTB, NXCD = 8, WGM = 8;

__host__ __device__ __forceinline__ int lds_byte(int r, int c) { const int st = (r >> 4) * 2 + (c >> 5), rr = r & 15, cc = c & 31, ob = rr * 64 + cc * 2; return st * 1024 + (ob ^ (((ob >> 9) & 1) << 5)); }
__host__ __device__ __forceinline__ void stage_rc(int b, int& R, int& C) { const int st = b / 1024, sb = b % 1024, swz = sb ^ (((sb >> 9) & 1) << 5); R = (st >> 1) * 16 + swz / 64; C = (st & 1) * 32 + (swz % 64) / 2; }
__host__ __device__ __forceinline__ int perm32(int rho) { const int n = rho >> 4, i = rho & 15; return 8 * (i >> 2) + 4 * n + (i & 3); }

__device__ __forceinline__ int otid() { int t = threadIdx.x; asm volatile("" : "+v"(t)); return t; }
template <class Tp> __device__ __forceinline__ Tp* opq(Tp* x) { asm volatile("" : "+s"(x)); return x; }
struct Unit { int pm, pn; };
struct Gemm { const bf16_t* A; const bf16_t* Bt; int M, N, K; };

struct StaticOrder {
    int nM, nN, nwg, G, c;
    __host__ __device__ void init(int M, int N, int G_, int c_) { nM = M / BM; nN = N / BM; nwg = nM * nN; G = G_; c = c_; }
    __host__ __device__ bool next(int i, Unit& u) const {
        const long L = (long)i * G + c; if (L >= nwg) return false;
        int wgid = (int)L; { const int q = nwg / NXCD, r = nwg % NXCD, xcd = wgid % NXCD, off = wgid / NXCD; wgid = (xcd < r ? xcd * (q + 1) : r * (q + 1) + (xcd - r) * q) + off; }
        const int nig = WGM * nN, gid = wgid / nig, fm = gid * WGM, gsz = (nM - fm) < WGM ? (nM - fm) : WGM;
        u.pm = fm + ((wgid % nig) % gsz); u.pn = (wgid % nig) / gsz; return true;
    }
    __device__ __forceinline__ void a_ready(const Unit&) const {}
    __device__ __forceinline__ void done(const Unit&) const {}
};

typedef unsigned u32x2e __attribute__((ext_vector_type(2)));
__device__ __forceinline__ unsigned cvt_pk_bf16(float lo, float hi) { unsigned r; asm volatile("v_cvt_pk_bf16_f32 %0, %1, %2" : "=v"(r) : "v"(lo), "v"(hi)); return r; }
constexpr int E_TP = 16384;

struct EpiQKV {
    static constexpr bool PERM = true, AFTER_DRAIN = false;
    bf16_t *Qb, *Kb, *Vb; int ldkv, nq, nk, has_norm; const float *qg, *kg; float qscale;
    float *kp, *vp, *ks, *vs; int swa;
    __device__ __forceinline__ void operator()(const f32x4 (&acc)[2][2][4][2], const Unit& u, int wr, int wc, int fr, int fq) const {
        bf16_t *Qb_ = opq(Qb), *Kb_ = opq(Kb), *Vb_ = opq(Vb); float *kp_ = opq(kp), *vp_ = opq(vp), *ks_ = opq(ks), *vs_ = opq(vs); const float *qg_ = opq(qg), *kg_ = opq(kg);
        const int hg = u.pn * 4 + wc; int type, gi;
        if (hg < nq) { type = 0; gi = hg; } else if (hg < nq + nk) { type = 1; gi = hg - nq; } else { type = 2; gi = hg - nq - nk; }
        float gsc[2][8];
        const float base = type == 0 ? qscale : 1.f;
#pragma unroll
        for (int bj = 0; bj < 2; ++bj)
#pragma unroll
            for (int e = 0; e < 8; ++e) gsc[bj][e] = base;
        const bool normed = has_norm && type < 2;
        if (normed) { const float* g = type == 0 ? qg_ : kg_;
#pragma unroll
            for (int bj = 0; bj < 2; ++bj)
#pragma unroll
                for (int e = 0; e < 8; ++e) gsc[bj][e] = g[32 * bj + 8 * fq + e] * base; }
        const int row0 = u.pm * BM + wr * 64 + fr; const bool prompt = u.pm < E_TP / BM;
        bf16_t* bdst = type == 0 ? Qb_ : (type == 1 ? Kb_ : Vb_); const int bld = type == 0 ? 1024 : ldkv;
        float* fdst = type == 1 ? (prompt ? kp_ : ks_) : (prompt ? vp_ : vs_);
#pragma unroll
        for (int ai = 0; ai < 2; ++ai)
#pragma unroll
            for (int m = 0; m < 4; ++m) {
                const int row = row0 + ai * HALF + m * 16;
                float rs = 1.f;
                if (normed) { float ss = 0.f;
#pragma unroll
                    for (int bj = 0; bj < 2; ++bj)
#pragma unroll
                        for (int n = 0; n < 2; ++n) { const f32x4 x = acc[ai][bj][m][n]; ss += (x[0] * x[0] + x[1] * x[1]) + (x[2] * x[2] + x[3] * x[3]); }
                    ss += __shfl_xor(ss, 16); ss += __shfl_xor(ss, 32);
                    rs = rsqrtf(ss * (1.f / 64.f) + 1e-6f); }
                long frow = -1;
                if (type >= 1) { if (!swa) frow = prompt ? row : row - E_TP;
                                 else if (prompt) frow = row - (E_TP - 128); else { const int rr = row - E_TP; frow = (long)(rr >> 5) * 128 + 96 + (rr & 31); } }
#pragma unroll
                for (int bj = 0; bj < 2; ++bj) {
                    f32x4 v0 = acc[ai][bj][m][0] * rs, v1 = acc[ai][bj][m][1] * rs;
                    v0[0] *= gsc[bj][0]; v0[1] *= gsc[bj][1]; v0[2] *= gsc[bj][2]; v0[3] *= gsc[bj][3]; v1[0] *= gsc[bj][4]; v1[1] *= gsc[bj][5]; v1[2] *= gsc[bj][6]; v1[3] *= gsc[bj][7];
                    const int col = gi * 64 + 32 * bj + 8 * fq;
                    u32x4 w; w.x = cvt_pk_bf16(v0[0], v0[1]); w.y = cvt_pk_bf16(v0[2], v0[3]); w.z = cvt_pk_bf16(v1[0], v1[1]); w.w = cvt_pk_bf16(v1[2], v1[3]);
                    *(u32x4*)(bdst + (size_t)row * bld + col) = w;
                    if (frow >= 0) { float* f = fdst + (size_t)frow * ldkv + col; *(f32x4*)f = v0; *(f32x4*)(f + 4) = v1; }
                }
            }
    }
};
struct EpiResid {
    static constexpr bool PERM = false, AFTER_DRAIN = false;
    const float *xin_p, *xin_s; float* xout;
    __device__ __forceinline__ void operator()(const f32x4 (&acc)[2][2][4][2], const Unit& u, int wr, int wc, int fr, int fq) const {
        const int row0 = u.pm * BM + wr * 64 + fr, col0 = u.pn * BM + wc * 32 + 4 * fq; const bool prompt = u.pm < E_TP / BM;
        const float *xp_ = opq(xin_p), *xs_ = opq(xin_s);
#pragma unroll
        for (int ai = 0; ai < 2; ++ai)
#pragma unroll
            for (int m = 0; m < 4; ++m) { const int row = row0 + ai * HALF + m * 16;
                const float* xi = prompt ? xp_ + (size_t)row * 1024 : xs_ + (size_t)(row - E_TP) * 1024; float* xo = xout + (size_t)row * 1024;
#pragma unroll
                for (int bj = 0; bj < 2; ++bj)
#pragma unroll
                    for (int n = 0; n < 2; ++n) { const int off = col0 + bj * HALF + n * 16; const f32x4 r = *(const f32x4*)(xi + off); *(f32x4*)(xo + off) = r + acc[ai][bj][m][n]; }
                if (m & 1) asm volatile("" ::: "memory"); }
    }
};
struct EpiRelu2 {
    static constexpr bool PERM = true, AFTER_DRAIN = false;
    bf16_t* O; int ldc;
    __device__ __forceinline__ void operator()(const f32x4 (&acc)[2][2][4][2], const Unit& u, int wr, int wc, int fr, int fq) const {
        const int row0 = u.pm * BM + wr * 64 + fr, col0 = u.pn * BM + wc * 32 + 8 * fq;
#pragma unroll
        for (int ai = 0; ai < 2; ++ai)
#pragma unroll
            for (int m = 0; m < 4; ++m) { bf16_t* rowp = O + (size_t)(row0 + ai * HALF + m * 16) * ldc + col0;
#pragma unroll
                for (int bj = 0; bj < 2; ++bj) { f32x4 v0 = acc[ai][bj][m][0], v1 = acc[ai][bj][m][1];
#pragma unroll
                    for (int e = 0; e < 4; ++e) { const float a = fmaxf(v0[e], 0.f), b = fmaxf(v1[e], 0.f); v0[e] = a * a; v1[e] = b * b; }
                    u32x4 w; w.x = cvt_pk_bf16(v0[0], v0[1]); w.y = cvt_pk_bf16(v0[2], v0[3]); w.z = cvt_pk_bf16(v1[0], v1[1]); w.w = cvt_pk_bf16(v1[2], v1[3]);
                    *(u32x4*)(rowp + bj * HALF) = w; } }
    }
};
template <class Epi, class Sched, bool ALIGN_EPI = false, bool SP2 = false>
__device__ __forceinline__ void gemm_phase(PG8_LAS unsigned char* lds, const Gemm g, const Sched& S, const Epi& E) {
    const int tid = otid(), wid = __builtin_amdgcn_readfirstlane(tid >> 6), lane = tid & 63, wr = wid >> 2, wc = wid & 3, fr = lane & 15, fq = lane >> 4;
    const int K = g.K, nt = K / BK;
    unsigned voffA[2], voffB[2];
#pragma unroll
    for (int i = 0; i < 2; ++i) { int R, C; stage_rc(tid * 16 + i * 8192, R, C); const int Rb = Epi::PERM ? ((R & ~31) + perm32(R & 31)) : R;
        voffA[i] = (unsigned)(R * K + C) * 2u; voffB[i] = (unsigned)(Rb * K + C) * 2u; }
    const size_t kstep = (size_t)(BK * 2);
    const size_t hstep = (size_t)HALF * K * 2;
    const size_t tstep = 2 * hstep;
    const unsigned ldsw = (unsigned)wid * 1024u;
    const int aoff = lds_byte(wr * 64 + fr, fq * 8), boff = lds_byte(wc * 32 + fr, fq * 8);
#define PG8_SA(b, h) (((b) * 2 + (h)) * HTB)
#define PG8_SB(b, h) ((4 + (b) * 2 + (h)) * HTB)
#define PG8_STAGE(bufoff, gbase, voff) do { _Pragma("unroll") for (int _i = 0; _i < 2; ++_i) \
        __builtin_amdgcn_global_load_lds((const unsigned*)((const char*)(gbase) + (voff)[_i]), (PG8_LAS unsigned*)(lds + (bufoff) + ldsw + _i * 8192), 16, 0, 0); } while (0)
#define PG8_LDA(dst, b, h) do { _Pragma("unroll") for (int m = 0; m < 4; ++m) _Pragma("unroll") for (int k = 0; k < 2; ++k) dst[m][k] = *(const PG8_LAS bf16x8*)(lds + PG8_SA(b, h) + aoff + m * 2048 + k * 1024); } while (0)
#define PG8_LDB(dst, b, h) do { _Pragma("unroll") for (int n = 0; n < 2; ++n) _Pragma("unroll") for (int k = 0; k < 2; ++k) dst[n][k] = *(const PG8_LAS bf16x8*)(lds + PG8_SB(b, h) + boff + n * 2048 + k * 1024); } while (0)
#define PG8_MMA(ai, bj, At, Bt) do { __builtin_amdgcn_s_setprio(1); _Pragma("unroll") for (int m = 0; m < 4; ++m) _Pragma("unroll") for (int n = 0; n < 2; ++n) _Pragma("unroll") for (int k = 0; k < 2; ++k) \
        acc[ai][bj][m][n] = __builtin_amdgcn_mfma_f32_16x16x32_bf16(Bt[n][k], At[m][k], acc[ai][bj][m][n], 0, 0, 0); __builtin_amdgcn_s_setprio(0); } while (0)
#define PG8_WAIT_V(n) asm volatile("s_waitcnt vmcnt(" #n ")" ::: "memory")
#define PG8_WAIT_L(n) asm volatile("s_waitcnt lgkmcnt(" #n ")" ::: "memory")
#define PG8_BAR __builtin_amdgcn_s_barrier()
#define PG8_SCHED __builtin_amdgcn_sched_barrier(0)
    Unit cur, nxt; int ui = 0;
    if (!S.next(0, cur)) return;
    f32x4 acc[2][2][4][2];
#pragma unroll
    for (int a = 0; a < 2; ++a)
#pragma unroll
        for (int b = 0; b < 2; ++b)
#pragma unroll
            for (int m = 0; m < 4; ++m)
#pragma unroll
                for (int n = 0; n < 2; ++n) acc[a][b][m][n] = (f32x4){0.f, 0.f, 0.f, 0.f};
    bf16x8 At[4][2], B0[2][2], B1[2][2];
    const char* cA = (const char*)g.A + (size_t)cur.pm * tstep; const char* cB = (const char*)g.Bt + (size_t)cur.pn * tstep;
    S.a_ready(cur);
    if constexpr (SP2) {
        PG8_STAGE(PG8_SB(0, 0), cB, voffB); PG8_STAGE(PG8_SB(0, 1), cB + hstep, voffB); PG8_STAGE(PG8_SA(0, 0), cA, voffA); PG8_STAGE(PG8_SA(0, 1), cA + hstep, voffA);
        if (wr == 1) PG8_BAR;
        PG8_WAIT_V(2); PG8_BAR;
        PG8_STAGE(PG8_SB(1, 0), cB + kstep, voffB); PG8_STAGE(PG8_SA(1, 0), cA + kstep, voffA); PG8_STAGE(PG8_SB(1, 1), cB + hstep + kstep, voffB);
        PG8_WAIT_V(6); PG8_BAR;
    } else {
        PG8_STAGE(PG8_SB(0, 0), cB, voffB); PG8_STAGE(PG8_SA(0, 0), cA, voffA); PG8_STAGE(PG8_SB(0, 1), cB + hstep, voffB); PG8_STAGE(PG8_SA(0, 1), cA + hstep, voffA);
        if (wr == 1) PG8_BAR;
        PG8_WAIT_V(4); PG8_BAR;
        PG8_STAGE(PG8_SB(1, 0), cB + kstep, voffB); PG8_STAGE(PG8_SA(1, 0), cA + kstep, voffA); PG8_STAGE(PG8_SB(1, 1), cB + hstep + kstep, voffB);
        PG8_WAIT_V(6); PG8_BAR;
    }
    for (;;) {
        const bool has_next = S.next(ui + 1, nxt);
        const char* nA = has_next ? (const char*)g.A + (size_t)nxt.pm * tstep : cA; const char* nB = has_next ? (const char*)g.Bt + (size_t)nxt.pn * tstep : cB;
        for (int t = 0; t < nt; t += 2) {
            const bool last = (t == nt - 2);
            const char* a1 = cA + (size_t)(t + 1) * kstep;
            const char* a2 = last ? nA : cA + (size_t)(t + 2) * kstep; const char* b2 = last ? nB : cB + (size_t)(t + 2) * kstep;
            const char* a3 = a2 + kstep; const char* b3 = b2 + kstep;
            if (last && has_next) S.a_ready(nxt);
            if constexpr (SP2) {
            PG8_LDB(B0, 0, 0); PG8_LDB(B1, 0, 1); PG8_SCHED; PG8_LDA(At, 0, 0); PG8_STAGE(PG8_SA(1, 1), a1 + hstep, voffA);
            PG8_WAIT_V(8); PG8_WAIT_L(0); PG8_BAR; PG8_MMA(0, 0, At, B0); PG8_MMA(0, 1, At, B1); PG8_BAR; PG8_SCHED;
            PG8_LDA(At, 0, 1); PG8_STAGE(PG8_SB(0, 0), b2, voffB); PG8_STAGE(PG8_SB(0, 1), b2 + hstep, voffB); PG8_STAGE(PG8_SA(0, 0), a2, voffA);
            PG8_WAIT_V(8); PG8_WAIT_L(0); PG8_BAR; PG8_MMA(1, 0, At, B0); PG8_MMA(1, 1, At, B1); PG8_BAR; PG8_SCHED;
            PG8_LDB(B0, 1, 0); PG8_LDB(B1, 1, 1); PG8_SCHED; PG8_LDA(At, 1, 0); PG8_STAGE(PG8_SA(0, 1), a2 + hstep, voffA);
            PG8_WAIT_V(8); PG8_WAIT_L(0); PG8_BAR; PG8_MMA(0, 0, At, B0); PG8_MMA(0, 1, At, B1); PG8_BAR; PG8_SCHED;
            PG8_LDA(At, 1, 1); PG8_STAGE(PG8_SB(1, 0), b3, voffB); PG8_STAGE(PG8_SB(1, 1), b3 + hstep, voffB); PG8_STAGE(PG8_SA(1, 0), a3, voffA);
            PG8_WAIT_V(8); PG8_WAIT_L(0); PG8_BAR; PG8_MMA(1, 0, At, B0); PG8_MMA(1, 1, At, B1); PG8_BAR; PG8_SCHED;
            } else {
            PG8_LDB(B0, 0, 0); PG8_SCHED; PG8_LDA(At, 0, 0); PG8_STAGE(PG8_SA(1, 1), a1 + hstep, voffA);
            PG8_WAIT_L(8); PG8_BAR; PG8_WAIT_L(0); PG8_MMA(0, 0, At, B0); PG8_BAR; PG8_SCHED;
            PG8_LDB(B1, 0, 1); PG8_STAGE(PG8_SB(0, 0), b2, voffB);
            PG8_BAR; PG8_WAIT_L(0); PG8_MMA(0, 1, At, B1); PG8_BAR;
            PG8_LDA(At, 0, 1); PG8_STAGE(PG8_SA(0, 0), a2, voffA);
            PG8_BAR; PG8_WAIT_L(0); PG8_MMA(1, 0, At, B0); PG8_BAR; PG8_SCHED;
            PG8_STAGE(PG8_SB(0, 1), b2 + hstep, voffB);
            PG8_WAIT_V(6); PG8_BAR; PG8_MMA(1, 1, At, B1); PG8_BAR;
            PG8_LDB(B0, 1, 0); PG8_SCHED; PG8_LDA(At, 1, 0); PG8_STAGE(PG8_SA(0, 1), a2 + hstep, voffA);
            PG8_WAIT_L(8); PG8_BAR; PG8_WAIT_L(0); PG8_MMA(0, 0, At, B0); PG8_BAR; PG8_SCHED;
            PG8_LDB(B1, 1, 1); PG8_STAGE(PG8_SB(1, 0), b3, voffB);
            PG8_BAR; PG8_WAIT_L(0); PG8_MMA(0, 1, At, B1); PG8_BAR;
            PG8_LDA(At, 1, 1); PG8_STAGE(PG8_SA(1, 0), a3, voffA);
            PG8_BAR; PG8_WAIT_L(0); PG8_MMA(1, 0, At, B0); PG8_BAR; PG8_SCHED;
            PG8_STAGE(PG8_SB(1, 1), b3 + hstep, voffB);
            PG8_WAIT_V(6); PG8_BAR; PG8_MMA(1, 1, At, B1); PG8_BAR;
            }
        }
        if constexpr (ALIGN_EPI) { if (wr == 0) PG8_BAR; }
        if constexpr (!Epi::AFTER_DRAIN) { E(acc, cur, wr, wc, fr, fq); S.done(cur); }
        if (!has_next) break;
#pragma unroll
        for (int a = 0; a < 2; ++a)
#pragma unroll
            for (int b = 0; b < 2; ++b)
#pragma unroll
                for (int m = 0; m < 4; ++m)
#pragma unroll
                    for (int n = 0; n < 2; ++n) acc[a][b][m][n] = (f32x4){0.f, 0.f, 0.f, 0.f};
        cur = nxt; cA = nA; cB = nB; ++ui;
        if constexpr (ALIGN_EPI) { if (wr == 1) PG8_BAR; }
    }
    PG8_WAIT_V(0);
    if constexpr (!ALIGN_EPI) { if (wr == 0) PG8_BAR; }
    PG8_BAR;
    if constexpr (Epi::AFTER_DRAIN) { E.fused(acc, cur, wr, wc, fr, fq, lds, wid, lane); S.done(cur); }
#undef PG8_SA
#undef PG8_SB
#undef PG8_STAGE
#undef PG8_LDA
#undef PG8_LDB
#undef PG8_MMA
#undef PG8_WAIT_V
#undef PG8_WAIT_L
#undef PG8_BAR
#undef PG8_SCHED
}
}
namespace fx {
#define LAS __attribute__((address_space(3)))
typedef unsigned short bf16_t;
typedef short bf16x8 __attribute__((ext_vector_type(8)));
typedef short s16x4 __attribute__((ext_vector_type(4)));
typedef float f32x4 __attribute__((ext_vector_type(4)));
typedef float f32x16 __attribute__((ext_vector_type(16)));
typedef unsigned u32x4 __attribute__((ext_vector_type(4)));
typedef unsigned u32x2 __attribute__((ext_vector_type(2)));
constexpr int D = 1024, TP = 16384, TS = 512, T = TP + TS, FF = 4096, NWAVES = 8;
constexpr float LOG2E = 1.4426950408889634f, QSC = 0.125f * LOG2E;

typedef float f32x2_t __attribute__((ext_vector_type(2))); typedef __bf16 bf16x2_t __attribute__((ext_vector_type(2)));
__device__ __forceinline__ unsigned cvtpk(float lo, float hi) { f32x2_t v = {lo, hi}; bf16x2_t b = __builtin_convertvector(v, bf16x2_t); return __builtin_bit_cast(unsigned, b); }
__device__ __forceinline__ u32x4 pack8(f32x4 a, f32x4 b) { u32x4 w; w.x = cvtpk(a.x, a.y); w.y = cvtpk(a.z, a.w); w.z = cvtpk(b.x, b.y); w.w = cvtpk(b.z, b.w); return w; }
__device__ __forceinline__ float wave_sum(float v) {
#pragma unroll
    for (int o = 32; o; o >>= 1) v += __shfl_xor(v, o);
    return v;
}
__device__ __forceinline__ int t5_bucket(int rel) {
    const int ret = rel > 0 ? 16 : 0; const int n = rel < 0 ? -rel : rel;
    const int b = n < 8 ? n : n < 12 ? 8 : n < 16 ? 9 : n < 23 ? 10 : n < 32 ? 11 : n < 46 ? 12 : n < 64 ? 13 : n < 91 ? 14 : 15;
    return ret + b;
}
__device__ __forceinline__ int crow(int r, int hi) { return (r & 3) + 8 * (r >> 2) + 4 * hi; }
constexpr size_t MiB = 1u << 20;
constexpr size_t WS_CTL = 0, CTL_ZERO_BYTES = 1 * MiB;
constexpr size_t WL_QKV = 0, WL_O = (size_t)3072 * 1024 * 2, WL_UP = WL_O + (size_t)1024 * 1024 * 2, WL_DN = WL_UP + (size_t)4096 * 1024 * 2, WL_BYTES = WL_DN + (size_t)4096 * 1024 * 2;
constexpr size_t WS_W = 1 * MiB, WS_XN = WS_W + 4 * WL_BYTES, ACT_B = (size_t)T * D * 2;
constexpr size_t WS_Q = WS_XN + ACT_B, WS_K = WS_Q + ACT_B, WS_V = WS_K + ACT_B, WS_O = WS_V + ACT_B, WS_U = WS_Q, WS_END = WS_O + ACT_B;
static_assert(WL_BYTES == 24 * MiB && WS_END < 272 * MiB, "ws map");
constexpr int CW_TMO = 0, CW_CODE = 1, CW_BAR = 4096;
constexpr int RING_BYTES = 131072, LDSCTL_OFF = RING_BYTES, MISC_OFF = LDSCTL_OFF + 320, GA_TAB = LDSCTL_OFF + 512, GA_WSF = GA_TAB + 4 * 160 * 4, GA_FLG = GA_WSF + NWAVES * 64 * 4, LDS_BYTES = 147456;
static_assert(GA_FLG + 64 <= LDS_BYTES, "LDS map");
enum In { X_P = 0, X_S, C_DK, C_DV, C_WK, C_WV, C_BK, C_BV, REL_BIAS, NORM_MIX, NORM_MLP, W_UP, W_DOWN, D_WQKV, D_WO, D_QN, D_KN, D_LAM, D_SUBLN, S_WQKV, S_WO, S_QN, S_KN, S_SINKS, B_WQKV, B_WO };

struct Params {
    const float* in[26];
    unsigned char* ws;
    float* xres;
    float *dkp[2], *dvp[2], *dks[2], *dvs[2];
    float *wkp, *wvp, *wks, *wvs;
    float *bkp, *bvp, *bks, *bvs;
    int ph_lo, ph_hi, li, pad;
};

#define XB_TMO      128
#define XB_XCNT(j)  (256  + 64 * (j))
#define XB_XSUB(j)  (1280 + 64 * (j))
#define XB_XGEN(j)  (2304 + 64 * (j))
#define XB_TOP      3328
#define XB_TOPGEN   3392
#define XCD_BAR_WORDS 3456
#define XB_SPIN_CAP (1u << 18)

__device__ __forceinline__ unsigned xb_ld(unsigned* p)              { return __hip_atomic_load(p, __ATOMIC_RELAXED, __HIP_MEMORY_SCOPE_AGENT); }
__device__ __forceinline__ unsigned xb_add(unsigned* p, unsigned v) { return __hip_atomic_fetch_add(p, v, __ATOMIC_RELAXED, __HIP_MEMORY_SCOPE_AGENT); }
__device__ __forceinline__ unsigned xb_xcc_id() { return (unsigned)__builtin_amdgcn_s_getreg((3 << 11) | 20) & 0xFu; }
#define XB_SPIN(cond, bar) do { unsigned _sp = 0; while (cond) { __builtin_amdgcn_s_sleep(1); \
    if ((++_sp & 255u) == 0u) { if (xb_ld(&(bar)[XB_TMO])) break; if (_sp > XB_SPIN_CAP) { atomicAdd(&(bar)[XB_TMO], 1u); break; } } } } while (0)

struct XcdBarrier {
    unsigned* bar; unsigned x;
    volatile LAS unsigned* st;
};

__device__ __forceinline__ XcdBarrier xcd_barrier_post(unsigned* bar, volatile LAS unsigned* st) {
    XcdBarrier b; b.bar = bar; b.x = xb_xcc_id(); b.st = st;
    if (threadIdx.x == 0) (void)xb_add(&bar[XB_XCNT(b.x)], 1u);
    return b;
}
__device__ __forceinline__ void xcd_barrier_complete(unsigned* bar, unsigned x, unsigned& nloc, unsigned& nx) {
    const unsigned G = gridDim.x * gridDim.y * gridDim.z;
    unsigned sum, cnt, mine, sp = 0u;
    for (;;) {
        sum = 0u; cnt = 0u; mine = 0u;
#pragma unroll
        for (unsigned j = 0; j < 16; ++j) { const unsigned c = xb_ld(&bar[XB_XCNT(j)]); sum += c; cnt += (c > 0u) ? 1u : 0u; mine = (j == x) ? c : mine; }
        if (sum == G) break;
        __builtin_amdgcn_s_sleep(1);
        if ((++sp & 255u) == 0u) { if (xb_ld(&bar[XB_TMO])) break; if (sp > XB_SPIN_CAP) { atomicAdd(&bar[XB_TMO], 1u); break; } }
    }
    nloc = mine > 0u ? mine : 1u; nx = cnt > 0u ? cnt : 1u;
}

__device__ __forceinline__ void xcd_barrier(const XcdBarrier& b) {
    asm volatile("s_waitcnt vmcnt(0)" ::: "memory");
    __syncthreads();
    if (threadIdx.x == 0) {
        unsigned* bar = b.bar;
        __builtin_amdgcn_s_waitcnt(0);
        unsigned nloc = b.st[0], nx = b.st[1];
        if (nloc == 0u) { xcd_barrier_complete(bar, b.x, nloc, nx); b.st[0] = nloc; b.st[1] = nx; }
        const unsigned old = xb_add(&bar[XB_XSUB(b.x)], 1u);
        const unsigned gen = old / nloc;
        if (old + 1u == (gen + 1u) * nloc) {
            __builtin_amdgcn_fence(__ATOMIC_RELEASE, "agent");
            asm volatile("s_waitcnt vmcnt(0)" ::: "memory");
            const unsigned og = xb_add(&bar[XB_TOP], 1u);
            const unsigned tg = og / nx;
            if (og + 1u == (tg + 1u) * nx) xb_add(&bar[XB_TOPGEN], 1u);
            else XB_SPIN(xb_ld(&bar[XB_TOPGEN]) == tg, bar);
            __builtin_amdgcn_fence(__ATOMIC_ACQUIRE, "agent");
            xb_add(&bar[XB_XGEN(b.x)], 1u);
            asm volatile("s_waitcnt vmcnt(0)" ::: "memory");
        } else {
            XB_SPIN(xb_ld(&bar[XB_XGEN(b.x)]) == gen, bar);
            __builtin_amdgcn_fence(__ATOMIC_ACQUIRE, "agent");
            asm volatile("s_waitcnt vmcnt(0)" ::: "memory");
        }
    }
    __syncthreads();
}


__device__ __forceinline__ unsigned f2bf(float f) { unsigned u = __builtin_bit_cast(unsigned, f); return (u + 0x7fffu + ((u >> 16) & 1u)) >> 16; }
__device__ __forceinline__ unsigned pk2(float lo, float hi) { return f2bf(lo) | (f2bf(hi) << 16); }
__device__ __forceinline__ void transpose_item(const float* W, int K, int N, bf16_t* WT, int k0, int n0, int dst_n0, LAS float* scr, int lane) {
#pragma unroll 8
    for (int i = 0; i < 32; ++i) { const int kk = 2 * i + (lane >> 5); scr[kk * 33 + (lane & 31)] = W[(size_t)(k0 + kk) * N + n0 + (lane & 31)]; }
    asm volatile("s_waitcnt lgkmcnt(0)" ::: "memory");
    const int c = lane & 7;
#pragma unroll
    for (int j = 0; j < 4; ++j) { const int n = (lane >> 3) + 8 * j; const LAS float* s = scr + (8 * c) * 33 + n;
        u32x4 o; o.x = pk2(s[0 * 33], s[1 * 33]); o.y = pk2(s[2 * 33], s[3 * 33]); o.z = pk2(s[4 * 33], s[5 * 33]); o.w = pk2(s[6 * 33], s[7 * 33]);
        *(u32x4*)(WT + (size_t)(dst_n0 + n) * K + k0 + 8 * c) = o; }
    asm volatile("s_waitcnt lgkmcnt(0)" ::: "memory");
}
__device__ __forceinline__ void prologue(const Params& p, LAS unsigned char* lds, int gw, int NGW, int wave, int lane) {
    LAS float* scr = (LAS float*)(lds + wave * 16384);
    constexpr int I_QKV = 16 * 96, I_O = 16 * 32, I_UP = 16 * 128, I_DN = 64 * 32, PER = I_QKV + I_O + I_UP + I_DN;
    for (int it = gw; it < 4 * PER; it += NGW) {
        const int layer = it / PER, mix = layer % 3, j = layer / 3; int r = it % PER;
        bf16_t* wl = (bf16_t*)(p.ws + WS_W + (size_t)layer * WL_BYTES);
        if (r < I_QKV) {
            const int N = mix == 1 ? 1536 : 3072, nblk = N / 32; if (r >= 16 * nblk) continue;
            const float* W = mix == 0 ? p.in[D_WQKV] + (size_t)j * D * 3072 : (mix == 1 ? p.in[S_WQKV] : p.in[B_WQKV]);
            const int kb = r / nblk, nb = r % nblk, n0 = 32 * nb, within = n0 & 255;
            const int dst = (n0 & ~255) + 128 * ((within >> 5) & 1) + 32 * (within >> 6);
            transpose_item(W, D, N, (bf16_t*)((unsigned char*)wl + WL_QKV), 64 * kb, n0, dst, scr, lane); continue; }
        r -= I_QKV;
        if (r < I_O) { const float* W = mix == 0 ? p.in[D_WO] + (size_t)j * D * D : (mix == 1 ? p.in[S_WO] : p.in[B_WO]);
            transpose_item(W, D, D, (bf16_t*)((unsigned char*)wl + WL_O), 64 * (r / 32), 32 * (r % 32), 32 * (r % 32), scr, lane); continue; }
        r -= I_O;
        if (r < I_UP) { transpose_item(p.in[W_UP] + (size_t)layer * D * FF, D, FF, (bf16_t*)((unsigned char*)wl + WL_UP), 64 * (r / 128), 32 * (r % 128), 32 * (r % 128), scr, lane); continue; }
        r -= I_UP;
        transpose_item(p.in[W_DOWN] + (size_t)layer * FF * D, FF, D, (bf16_t*)((unsigned char*)wl + WL_DN), 64 * (r / 32), 32 * (r % 32), 32 * (r % 32), scr, lane);
    }
    for (int i = gw * 64 + lane; i < 16 * 96 * 64; i += NGW * 64) { const int c4 = i & 63, r = (i >> 6) % 96, b = i / (96 * 64);
        ((f32x4*)p.wks)[((size_t)b * 128 + r) * 64 + c4] = ((const f32x4*)p.in[C_WK])[((size_t)b * 128 + r + 32) * 64 + c4];
        ((f32x4*)p.wvs)[((size_t)b * 128 + r) * 64 + c4] = ((const f32x4*)p.in[C_WV])[((size_t)b * 128 + r + 32) * 64 + c4]; }
}
__device__ __forceinline__ void rms_phase(const float* xp, const float* xs, const float* g, bf16_t* XN, int gw, int NGW, int lane) {
    f32x4 gv[4];
#pragma unroll
    for (int j = 0; j < 4; ++j) gv[j] = ((const f32x4*)g)[lane + 64 * j];
    for (int row = gw; row < T; row += NGW) {
        const f32x4* xr = (const f32x4*)(row < TP ? xp + (size_t)row * D : xs + (size_t)(row - TP) * D);
        f32x4 v[4]; float s = 0.f;
#pragma unroll
        for (int j = 0; j < 4; ++j) { v[j] = xr[lane + 64 * j]; s += (v[j].x * v[j].x + v[j].y * v[j].y) + (v[j].z * v[j].z + v[j].w * v[j].w); }
        const float r = rsqrtf(wave_sum(s) * (1.f / D) + 1e-6f);
        u32x2* o = (u32x2*)(XN + (size_t)row * D);
#pragma unroll
        for (int j = 0; j < 4; ++j) { const f32x4 y = v[j] * r * gv[j]; u32x2 w; w.x = cvtpk(y.x, y.y); w.y = cvtpk(y.z, y.w); o[lane + 64 * j] = w; }
    }
}
typedef short v4i16_t __attribute__((ext_vector_type(4)));
__device__ __forceinline__ s16x4 vtr(const LAS unsigned char* p) { return __builtin_bit_cast(s16x4, __builtin_amdgcn_ds_read_tr16_b64_v4i16((LAS v4i16_t*)p)); }
#define MFMA32(a, b, c) __builtin_amdgcn_mfma_f32_32x32x16_bf16(a, b, c, 0, 0, 0)
enum { M_DIFF_P = 0, M_DIFF_S, M_SWA_P, M_SWA_S, M_SB_P, M_SB_S };

__device__ __forceinline__ void load_k_slot(LAS unsigned char* dst, const void* src, bool f32, long ld, int nvalid) {
    const int tid = pg8::otid(), key = (tid & 7) + 8 * (tid >> 6), chunk = (tid >> 3) & 7;
    u32x4 w = {0u, 0u, 0u, 0u};
    if (key < nvalid) {
        if (f32) { const float* s = (const float*)src + (size_t)key * ld + chunk * 8; w = pack8(*(const f32x4*)s, *(const f32x4*)(s + 4)); }
        else w = *(const u32x4*)((const bf16_t*)src + (size_t)key * ld + chunk * 8);
    }
    *(LAS u32x4*)(dst + chunk * 1024 + key * 16) = w;
}
template <int DV> __device__ __forceinline__ void load_v_slot(LAS unsigned char* dst, const void* src, bool f32, long ld, int nvalid) {
    const int tid = pg8::otid(), pl = tid & 3, key = (tid >> 2) & 63;
#pragma unroll
    for (int pass = 0; pass < DV / 64; ++pass) {
        const int dblk = (tid >> 8) + 2 * pass, d0 = dblk * 32 + pl * 8;
        u32x4 w = {0u, 0u, 0u, 0u};
        if (key < nvalid) {
            if (f32) { const float* s = (const float*)src + (size_t)key * ld + d0; w = pack8(*(const f32x4*)s, *(const f32x4*)(s + 4)); }
            else w = *(const u32x4*)((const bf16_t*)src + (size_t)key * ld + d0);
        }
        *(LAS u32x4*)(dst + dblk * 4096 + key * 64 + pl * 16) = w;
    }
}

template <int MODE>
__device__ __forceinline__ void attn_unit(const Params& p, LAS unsigned char* lds, int ua, int ub, int j, float lam, float lam_init, const bf16_t* Qb, const bf16_t* Kb, const bf16_t* Vb, bf16_t* Ob) {
    constexpr bool IS_DIFF = MODE == M_DIFF_P || MODE == M_DIFF_S, IS_SWA = MODE == M_SWA_P || MODE == M_SWA_S, IS_SB = MODE == M_SB_P || MODE == M_SB_S;
    constexpr int DV = IS_DIFF ? 128 : 64, NDB = DV / 32, NKS = IS_DIFF ? 2 : (IS_SWA ? 1 : 4), NVS = IS_DIFF ? 1 : (IS_SWA ? 1 : 4), LDKV = IS_SWA ? 256 : 1024;
    constexpr int NTAB = IS_DIFF ? 2 : 4;
    const int tid = pg8::otid(), lane = tid & 63, r32 = lane & 31, hi = lane >> 5; const int wid = __builtin_amdgcn_readfirstlane(tid >> 6);
    LAS float* tab = (LAS float*)(lds + GA_TAB); LAS float* wsf = (LAS float*)(lds + GA_WSF) + wid * 64; LAS unsigned* flg = (LAS unsigned*)(lds + GA_FLG);
    bool compute = true; int qrow0 = 0, qcol = 0, tq0 = 0, kslot = 0, vslot = 0, tsel = 0, kvcol = 0, ntiles = 0, hq = 0, grp = 0;
    if (MODE == M_DIFF_P) { const int m = wid & 1; grp = wid >> 1; qrow0 = ub * 128 + grp * 32; qcol = (2 * ua + m) * 64; tq0 = qrow0; kslot = m; tsel = m; kvcol = ua * 128; ntiles = 2 * ub + 2; }
    if (MODE == M_DIFF_S) { compute = wid < 2; const int m = wid & 1; qrow0 = TP + ua * 32; qcol = (2 * ub + m) * 64; tq0 = 0; kslot = m; tsel = m; kvcol = ub * 128; ntiles = 33; }
    if (MODE == M_SWA_P)  { grp = wid >> 1; hq = ub * 4 + grp; qrow0 = ua * 64 + (wid & 1) * 32; qcol = hq * 64; tq0 = qrow0; tsel = grp; kvcol = ub * 64; ntiles = 3; }
    if (MODE == M_SWA_S)  { compute = wid < 4; grp = wid & 3; hq = ub * 4 + grp; qrow0 = TP + ua * 32; qcol = hq * 64; tq0 = 0; tsel = grp; kvcol = ub * 64; ntiles = 3; }
    if (MODE == M_SB_P)   { grp = wid >> 1; qrow0 = ua * 64 + (wid & 1) * 32; qcol = (ub * 4 + grp) * 64; tq0 = qrow0; kslot = grp; vslot = grp; kvcol = ub * 256; ntiles = ua + 1; }
    if (MODE == M_SB_S)   { compute = wid < 4; grp = wid & 3; qrow0 = TP + ua * 32; qcol = (ub * 4 + grp) * 64; tq0 = 0; kslot = grp; vslot = grp; kvcol = ub * 256; ntiles = 33; }
    __syncthreads();
    if (!IS_SB) {
        for (int idx = tid; idx < NTAB * 155; idx += NWAVES * 64) { const int ti = idx / 155, i = idx % 155;
            const int head = IS_DIFF ? 2 * (MODE == M_DIFF_P ? ua : ub) + ti : ub * 4 + ti;
            float v = p.in[REL_BIAS][t5_bucket(i - 91) * 16 + head];
            if (IS_DIFF) v -= p.in[REL_BIAS][15 * 16 + head];
            tab[ti * 160 + i] = v * LOG2E; }
    }
    bf16x8 qr[4];
    { const bf16_t* qp = Qb + (size_t)(qrow0 + r32) * 1024 + qcol + hi * 8;
#pragma unroll
      for (int d0 = 0; d0 < 4; ++d0) qr[d0] = *(const bf16x8*)(qp + d0 * 16); }
    f32x16 o[NDB];
#pragma unroll
    for (int db = 0; db < NDB; ++db)
#pragma unroll
        for (int r = 0; r < 16; ++r) o[db][r] = 0.f;
    float l = 0.f, acc = 0.f; bool mydone = !compute;
    if (IS_SWA) l = hi == 0 ? __builtin_amdgcn_exp2f(p.in[S_SINKS][hq] * LOG2E) : 0.f;
    const int tq = tq0 + r32;
    const LAS unsigned char* kbase = lds + kslot * 8192 + hi * 1024 + r32 * 16;
    const LAS unsigned char* vbase = lds + 32768 + vslot * (DV * 128) + ((lane >> 4) & 1) * 32 + (lane & 3) * 8 + (4 * hi + ((lane & 15) >> 2)) * 64;
    for (int it = 0; it < ntiles; ++it) {
        const void *kp = nullptr, *vp = nullptr; bool f32 = false, tvalid = true, active = true, far = false; int nvalid = 64, pos0 = 0; long ld = LDKV;
        if (MODE == M_DIFF_P) { const size_t off = (size_t)it * 64 * 1024 + kvcol; kp = Kb + off; vp = Vb + off; pos0 = it * 64; active = it <= 2 * ub + (grp >> 1); far = (pos0 + 63 - tq0) <= -91; }
        if (MODE == M_DIFF_S) { if (it < 32) { const size_t off = ((size_t)(j * 16 + ua) * 2048 + it * 64) * 1024 + kvcol; kp = p.in[C_DK] + off; vp = p.in[C_DV] + off; f32 = true; pos0 = -2048 + it * 64; far = pos0 + 63 <= -91; }
                                else { const size_t off = (size_t)(TP + ua * 32) * 1024 + kvcol; kp = Kb + off; vp = Vb + off; nvalid = 32; pos0 = 0; } }
        if (MODE == M_SWA_P)  { const int tc = ua - 2 + it; tvalid = tc >= 0; const size_t off = (size_t)(tc < 0 ? 0 : tc) * 64 * 256 + kvcol; kp = Kb + off; vp = Vb + off; pos0 = tc * 64; }
        if (MODE == M_SWA_S)  { if (it < 2) { const size_t off = ((size_t)ua * 128 + it * 64) * 256 + kvcol; kp = p.in[C_WK] + off; vp = p.in[C_WV] + off; f32 = true; pos0 = -128 + it * 64; }
                                else { const size_t off = (size_t)(TP + ua * 32) * 256 + kvcol; kp = Kb + off; vp = Vb + off; nvalid = 32; pos0 = 0; } }
        if (MODE == M_SB_P)   { const int tc = ua - it; const size_t off = (size_t)tc * 64 * 1024 + kvcol; kp = Kb + off; vp = Vb + off; pos0 = tc * 64; }
        if (MODE == M_SB_S)   { if (it == 0) { const size_t off = (size_t)(TP + ua * 32) * 1024 + kvcol; kp = Kb + off; vp = Vb + off; nvalid = 32; pos0 = 0; }
                                else { const int tc = 32 - it; const size_t off = ((size_t)ua * 2048 + tc * 64) * 1024 + kvcol; kp = p.in[C_BK] + off; vp = p.in[C_BV] + off; f32 = true; pos0 = -2048 + tc * 64; } }
        if (tvalid) {
#pragma unroll
            for (int s = 0; s < NKS; ++s) load_k_slot(lds + s * 8192, f32 ? (const void*)((const float*)kp + s * 64) : (const void*)((const bf16_t*)kp + s * 64), f32, ld, nvalid);
#pragma unroll
            for (int s = 0; s < NVS; ++s) load_v_slot<DV>(lds + 32768 + s * (DV * 128), f32 ? (const void*)((const float*)vp + s * DV) : (const void*)((const bf16_t*)vp + s * DV), f32, ld, nvalid);
        }
        __syncthreads();
        if (tvalid && compute && active && !mydone) {
            f32x16 p0, p1;
#pragma unroll
            for (int r = 0; r < 16; ++r) { p0[r] = 0.f; p1[r] = 0.f; }
#pragma unroll
            for (int d0 = 0; d0 < 4; ++d0) { const bf16x8 b0 = *(const LAS bf16x8*)(kbase + d0 * 2048), b1 = *(const LAS bf16x8*)(kbase + d0 * 2048 + 512);
                p0 = MFMA32(b0, qr[d0], p0); p1 = MFMA32(b1, qr[d0], p1); }
            if (!IS_SB) {
                const LAS float* tb = tab + tsel * 160; const int relb = pos0 - tq + 91; float ls = 0.f;
#pragma unroll
                for (int r = 0; r < 16; ++r) { const int kv = crow(r, hi); float s0 = p0[r], s1 = p1[r];
                    if (!far) { int i0 = relb + kv, i1 = i0 + 32; i0 = i0 < 0 ? 0 : (i0 > 154 ? 154 : i0); i1 = i1 < 0 ? 0 : (i1 > 154 ? 154 : i1); s0 += tb[i0]; s1 += tb[i1]; }
                    float e0 = __builtin_amdgcn_exp2f(s0), e1 = __builtin_amdgcn_exp2f(s1);
                    if (kv >= nvalid) e0 = 0.f; if (kv + 32 >= nvalid) e1 = 0.f;
                    p0[r] = e0; p1[r] = e1; ls += e0 + e1; }
                l += ls;
            } else {
                float L0[16], L1[16];
#pragma unroll
                for (int r = 0; r < 16; ++r) { const int kv = crow(r, hi);
                    if (!(kv < nvalid && pos0 + kv < tq)) p0[r] = -INFINITY;
                    if (!(kv + 32 < nvalid && pos0 + kv + 32 < tq)) p1[r] = -INFINITY;
                    L0[r] = __builtin_amdgcn_logf(1.f + __builtin_amdgcn_exp2f(p0[r])); L1[r] = __builtin_amdgcn_logf(1.f + __builtin_amdgcn_exp2f(p1[r])); }
                float gs[8], go[8];
#pragma unroll
                for (int g = 0; g < 4; ++g) { gs[g] = (L0[4 * g] + L0[4 * g + 1]) + (L0[4 * g + 2] + L0[4 * g + 3]); gs[4 + g] = (L1[4 * g] + L1[4 * g + 1]) + (L1[4 * g + 2] + L1[4 * g + 3]); }
#pragma unroll
                for (int g = 0; g < 8; ++g) go[g] = __shfl_xor(gs[g], 32);
                float after = 0.f;
#pragma unroll
                for (int g = 7; g >= 0; --g) {
                    float run = after + (hi == 0 ? go[g] : 0.f);
#pragma unroll
                    for (int i = 3; i >= 0; --i) { const int r = 4 * (g & 3) + i;
                        if (g < 4) { const float Lr = L0[r]; p0[r] = __builtin_amdgcn_exp2f(p0[r] - Lr + acc - run); run += Lr; }
                        else       { const float Lr = L1[r]; p1[r] = __builtin_amdgcn_exp2f(p1[r] - Lr + acc - run); run += Lr; } }
                    after += gs[g] + go[g];
                }
                acc -= after;
                mydone = __all(acc < -152.f);
            }
            u32x4 pw[4];
            pw[0] = (u32x4){cvtpk(p0[0], p0[1]), cvtpk(p0[2], p0[3]), cvtpk(p0[4], p0[5]), cvtpk(p0[6], p0[7])};
            pw[1] = (u32x4){cvtpk(p0[8], p0[9]), cvtpk(p0[10], p0[11]), cvtpk(p0[12], p0[13]), cvtpk(p0[14], p0[15])};
            pw[2] = (u32x4){cvtpk(p1[0], p1[1]), cvtpk(p1[2], p1[3]), cvtpk(p1[4], p1[5]), cvtpk(p1[6], p1[7])};
            pw[3] = (u32x4){cvtpk(p1[8], p1[9]), cvtpk(p1[10], p1[11]), cvtpk(p1[12], p1[13]), cvtpk(p1[14], p1[15])};
#pragma unroll
            for (int db = 0; db < NDB; ++db)
#pragma unroll
                for (int ks = 0; ks < 4; ++ks) { const s16x4 lo = vtr(vbase + db * 4096 + ks * 1024), hh = vtr(vbase + db * 4096 + ks * 1024 + 512);
                    const bf16x8 vf = (bf16x8){lo[0], lo[1], lo[2], lo[3], hh[0], hh[1], hh[2], hh[3]};
                    o[db] = MFMA32(__builtin_bit_cast(bf16x8, pw[ks]), vf, o[db]); }
        }
        if (IS_SB) { if (lane == 0) flg[wid] = mydone ? 1u : 0u; }
        __syncthreads();
        if (IS_SB) { unsigned all = 1u;
#pragma unroll
            for (int w = 0; w < NWAVES; ++w) all &= flg[w];
            if (all) break; }
    }
    LAS float* st = (LAS float*)(lds + wid * (32 * DV * 4));
    if (compute) {
        float rinv[16];
        if (!IS_SB) { const float lt = l + __shfl_xor(l, 32); if (hi == 0) wsf[r32] = lt;
            asm volatile("s_waitcnt lgkmcnt(0)" ::: "memory");
#pragma unroll
            for (int r = 0; r < 16; ++r) rinv[r] = 1.f / wsf[crow(r, hi)]; }
        else {
#pragma unroll
            for (int r = 0; r < 16; ++r) rinv[r] = 1.f; }
#pragma unroll
        for (int db = 0; db < NDB; ++db)
#pragma unroll
            for (int r = 0; r < 16; ++r) st[crow(r, hi) * DV + 32 * db + r32] = o[db][r] * rinv[r];
    }
    __syncthreads();
    if (compute) {
        if (IS_DIFF) {
            const int pair = wid >> 1, row = 16 * (wid & 1) + (lane >> 2), qd = lane & 3;
            const LAS float* s0 = (const LAS float*)(lds + (2 * pair) * 16384) + row * 128 + qd * 32; const LAS float* s1 = s0 + 4096;
            const int head = MODE == M_DIFF_P ? ua : ub; const size_t orow = MODE == M_DIFF_P ? (size_t)ub * 128 + pair * 32 + row : (size_t)TP + ua * 32 + row;
            float x[32]; float ss = 0.f;
#pragma unroll
            for (int e = 0; e < 32; ++e) { x[e] = s0[e] - lam * s1[e]; ss += x[e] * x[e]; }
            ss += __shfl_xor(ss, 1); ss += __shfl_xor(ss, 2);
            const float rs = rsqrtf(ss * (1.f / 128.f) + 1e-6f) * (1.f - lam_init);
            const float* sg = p.in[D_SUBLN] + j * 128 + qd * 32; bf16_t* op = Ob + orow * 1024 + head * 128 + qd * 32;
#pragma unroll
            for (int c = 0; c < 4; ++c) { u32x4 w;
                w.x = cvtpk(x[8 * c] * rs * sg[8 * c], x[8 * c + 1] * rs * sg[8 * c + 1]); w.y = cvtpk(x[8 * c + 2] * rs * sg[8 * c + 2], x[8 * c + 3] * rs * sg[8 * c + 3]);
                w.z = cvtpk(x[8 * c + 4] * rs * sg[8 * c + 4], x[8 * c + 5] * rs * sg[8 * c + 5]); w.w = cvtpk(x[8 * c + 6] * rs * sg[8 * c + 6], x[8 * c + 7] * rs * sg[8 * c + 7]);
                *(u32x4*)(op + 8 * c) = w; }
        } else {
            const int row = lane >> 1, hf = lane & 1; const LAS float* s0 = st + row * 64 + hf * 32; bf16_t* op = Ob + (size_t)(qrow0 + row) * 1024 + qcol + hf * 32;
#pragma unroll
            for (int c = 0; c < 4; ++c) { u32x4 w; w.x = cvtpk(s0[8 * c], s0[8 * c + 1]); w.y = cvtpk(s0[8 * c + 2], s0[8 * c + 3]); w.z = cvtpk(s0[8 * c + 4], s0[8 * c + 5]); w.w = cvtpk(s0[8 * c + 6], s0[8 * c + 7]);
                *(u32x4*)(op + 8 * c) = w; }
        }
    }
}
#ifndef FX_SP2
#define FX_SP2 true
#endif
__global__ void __launch_bounds__(NWAVES * 64, 2) mega(Params p) {
    extern __shared__ __attribute__((aligned(16))) unsigned char lds_raw[];
    LAS unsigned char* lds = (LAS unsigned char*)lds_raw;
    const int tid = threadIdx.x, lane = tid & 63; const int wave = __builtin_amdgcn_readfirstlane(tid >> 6);
    const int G = gridDim.x; const int vcu = (G % 8 == 0) ? ((int)blockIdx.x % 8) * (G / 8) + (int)blockIdx.x / 8 : (int)blockIdx.x;
    const int gw = vcu * NWAVES + wave, NGW = G * NWAVES;
    unsigned* ctl = (unsigned*)(p.ws + WS_CTL);
    for (int u = tid; u < (LDS_BYTES - LDSCTL_OFF) / 4; u += NWAVES * 64) ((LAS unsigned*)(lds + LDSCTL_OFF))[u] = 0u;
    __syncthreads();
    XcdBarrier bar = xcd_barrier_post(ctl + CW_BAR + p.li * XCD_BAR_WORDS, (volatile LAS unsigned*)(lds + MISC_OFF) + 8);
    const int lo = p.ph_lo, hi_ph = p.ph_hi;
#define IN(k) (lo <= (k) && (k) < hi_ph)
#define SEAM(k) do { if (IN(k) && IN((k) + 1)) xcd_barrier(bar); } while (0)
#define WSP(off) ((bf16_t*)(pg8::opq(p.ws) + (off)))
#define XRES() pg8::opq(p.xres)

    if (IN(0)) prologue(p, lds, gw, NGW, wave, pg8::otid() & 63);
    SEAM(0);
    for (int layer = 0; layer < 4; ++layer) {
        const int pb = 1 + 7 * layer, mix = layer % 3, j = layer / 3;
        const size_t wlo = WS_W + (size_t)layer * WL_BYTES;

        if (IN(pb + 0)) { float* xres = XRES(); rms_phase(layer == 0 ? p.in[X_P] : xres, layer == 0 ? p.in[X_S] : xres + (size_t)TP * D, p.in[NORM_MIX] + layer * D, WSP(WS_XN), gw, NGW, pg8::otid() & 63); }
        SEAM(pb + 0);
        if (IN(pb + 1)) {
            const int N = mix == 1 ? 1536 : 3072;
            pg8::Gemm g{WSP(WS_XN), WSP(wlo + WL_QKV), T, N, D}; pg8::StaticOrder S; S.init(T, N, G, (int)blockIdx.x);
            pg8::EpiQKV E;
            E.Qb = WSP(WS_Q); E.Kb = WSP(WS_K); E.Vb = WSP(WS_V); E.ldkv = mix == 1 ? 256 : 1024; E.nq = 16; E.nk = mix == 1 ? 4 : 16; E.has_norm = mix != 2; E.swa = mix == 1;
            E.qg = mix == 0 ? p.in[D_QN] + j * 64 : p.in[S_QN]; E.kg = mix == 0 ? p.in[D_KN] + j * 64 : p.in[S_KN]; E.qscale = QSC;
            E.kp = mix == 0 ? p.dkp[j] : (mix == 1 ? p.wkp : p.bkp); E.vp = mix == 0 ? p.dvp[j] : (mix == 1 ? p.wvp : p.bvp);
            E.ks = mix == 0 ? p.dks[j] : (mix == 1 ? p.wks : p.bks); E.vs = mix == 0 ? p.dvs[j] : (mix == 1 ? p.wvs : p.bvs);
            pg8::gemm_phase<pg8::EpiQKV, pg8::StaticOrder, true, FX_SP2>(lds, g, S, E);
        }
        SEAM(pb + 1);
        if (IN(pb + 2)) {
            bf16_t *Qb = WSP(WS_Q), *Kb = WSP(WS_K), *Vb = WSP(WS_V), *Ob = WSP(WS_O);
            if (mix == 0) {
                const float lam_init = layer == 0 ? 0.2f : 0.55605820417f;
                const float* lp = p.in[D_LAM] + j * 256;
                const int ln = pg8::otid() & 63; const float lam = expf(wave_sum(lp[ln] * lp[64 + ln])) - expf(wave_sum(lp[128 + ln] * lp[192 + ln])) + lam_init;
                for (int u = vcu; u < 1024; u += G) { const int k = u >> 8, v = u & 255, h = v >> 5, s = v & 31; const int qb = k == 0 ? s : (k == 1 ? 63 - s : (k == 2 ? 64 + s : 127 - s));
                    attn_unit<M_DIFF_P>(p, lds, h, qb, j, lam, lam_init, Qb, Kb, Vb, Ob); }
                for (int u = vcu; u < 128; u += G) attn_unit<M_DIFF_S>(p, lds, u >> 3, u & 7, j, lam, lam_init, Qb, Kb, Vb, Ob);
            } else if (mix == 1) {
                for (int u = vcu; u < 1024; u += G) attn_unit<M_SWA_P>(p, lds, u >> 2, u & 3, 0, 0.f, 0.f, Qb, Kb, Vb, Ob);
                for (int u = vcu; u < 64; u += G) attn_unit<M_SWA_S>(p, lds, u >> 2, u & 3, 0, 0.f, 0.f, Qb, Kb, Vb, Ob);
            } else {
                for (int u = vcu; u < 1024; u += G) attn_unit<M_SB_P>(p, lds, u >> 2, u & 3, 0, 0.f, 0.f, Qb, Kb, Vb, Ob);
                for (int u = vcu; u < 64; u += G) attn_unit<M_SB_S>(p, lds, u >> 2, u & 3, 0, 0.f, 0.f, Qb, Kb, Vb, Ob);
            }
        }
        SEAM(pb + 2);
        if (IN(pb + 3)) {
            float* xres = XRES();
            pg8::Gemm g{WSP(WS_O), WSP(wlo + WL_O), T, D, D}; pg8::StaticOrder S; S.init(T, D, G, (int)blockIdx.x);
            pg8::EpiResid E{layer == 0 ? p.in[X_P] : xres, layer == 0 ? p.in[X_S] : xres + (size_t)TP * D, xres};
            pg8::gemm_phase<pg8::EpiResid, pg8::StaticOrder, true, FX_SP2>(lds, g, S, E);
        }
        SEAM(pb + 3);
        if (IN(pb + 4)) { float* xres = XRES(); rms_phase(xres, xres + (size_t)TP * D, p.in[NORM_MLP] + layer * D, WSP(WS_XN), gw, NGW, pg8::otid() & 63); }
        SEAM(pb + 4);
        if (IN(pb + 5)) {
            pg8::Gemm g{WSP(WS_XN), WSP(wlo + WL_UP), T, FF, D}; pg8::StaticOrder S; S.init(T, FF, G, (int)blockIdx.x);
            pg8::EpiRelu2 E{WSP(WS_U), FF};
            pg8::gemm_phase<pg8::EpiRelu2, pg8::StaticOrder, true, FX_SP2>(lds, g, S, E);
        }
        SEAM(pb + 5);
        if (IN(pb + 6)) {
            float* xres = XRES();
            pg8::Gemm g{WSP(WS_U), WSP(wlo + WL_DN), T, D, FF}; pg8::StaticOrder S; S.init(T, D, G, (int)blockIdx.x);
            pg8::EpiResid E{xres, xres + (size_t)TP * D, xres};
            pg8::gemm_phase<pg8::EpiResid, pg8::StaticOrder, true, FX_SP2>(lds, g, S, E);
        }
        SEAM(pb + 6);
    }
#undef IN
#undef SEAM
#undef WSP
#undef XRES
}
constexpr int N_PHASES = 29;

static int fast_grid() {
    static int grid = 0;
    if (grid == 0) {
        int dev = 0, cus = 0;
        if (hipGetDevice(&dev) != hipSuccess || hipDeviceGetAttribute(&cus, hipDeviceAttributeMultiprocessorCount, dev) != hipSuccess) { grid = -1; return grid; }
        if (hipFuncSetAttribute((const void*)mega, hipFuncAttributeMaxDynamicSharedMemorySize, LDS_BYTES) != hipSuccess) { fprintf(stderr, "hipFuncSetAttribute failed\n"); grid = -1; return grid; }
        int per_cu = 0;
        if (hipOccupancyMaxActiveBlocksPerMultiprocessor(&per_cu, (const void*)mega, NWAVES * 64, LDS_BYTES) != hipSuccess || per_cu < 1) { fprintf(stderr, "occupancy query: %d blocks/CU\n", per_cu); (void)hipGetLastError(); }
        grid = cus;
    }
    return grid;
}
static void launch_fast(Params p, int lo, int hi, int li, hipStream_t st) {
    const int grid = fast_grid(); if (grid <= 0) return;
    p.ph_lo = lo; p.ph_hi = hi; p.li = li; p.pad = 0;
    hipLaunchKernelGGL(mega, dim3(grid), dim3(NWAVES * 64), LDS_BYTES, st, p);
    const hipError_t e = hipPeekAtLastError(); if (e != hipSuccess) fprintf(stderr, "mega launch failed: %s\n", hipGetErrorName(e));
}
}
namespace oo {
constexpr size_t TPD = (size_t)fx::TP * fx::D, TSD = (size_t)fx::TS * fx::D;
constexpr size_t Y = 0, DKP = (size_t)fx::T * fx::D, DVP = DKP + 2 * TPD, WKP = DVP + 2 * TPD, WVP = WKP + 32768, BKP = WVP + 32768, BVP = BKP + TPD,
    DKS = BVP + TPD, DVS = DKS + 2 * TSD, WKS = DVS + 2 * TSD, WVS = WKS + 524288, BKS = WVS + 524288, BVS = BKS + 524288, END = BVS + 524288;
static_assert(END == 122224640ull, "output size");
}
#ifndef FX_N_LAUNCH
#define FX_N_LAUNCH 1
#endif
extern "C" void kernel_launch(void* const* d_in, const int* in_sizes, int n_in, void* d_out, int out_size, void* d_ws, size_t ws_size, hipStream_t stream) {
    using namespace fx;
    if (n_in != 26 || out_size != (int)oo::END || ws_size < WS_END) { fprintf(stderr, "kernel_launch: unexpected sizes n_in %d out %d ws %zu\n", n_in, out_size, ws_size); return; }
    unsigned char* ws = (unsigned char*)d_ws; float* out = (float*)d_out;
    (void)hipMemsetAsync(ws + WS_CTL, 0, CTL_ZERO_BYTES, stream);
    Params p{};
    for (int i = 0; i < 26; ++i) p.in[i] = (const float*)d_in[i];
    p.ws = ws; p.xres = out + oo::Y;
    for (int j = 0; j < 2; ++j) { p.dkp[j] = out + oo::DKP + j * oo::TPD; p.dvp[j] = out + oo::DVP + j * oo::TPD; p.dks[j] = out + oo::DKS + j * oo::TSD; p.dvs[j] = out + oo::DVS + j * oo::TSD; }
    p.wkp = out + oo::WKP; p.wvp = out + oo::WVP; p.wks = out + oo::WKS; p.wvs = out + oo::WVS;
    p.bkp = out + oo::BKP; p.bvp = out + oo::BVP; p.bks = out + oo::BKS; p.bvs = out + oo::BVS;
    if (FX_N_LAUNCH == 1) launch_fast(p, 0, N_PHASES, 0, stream);
    else for (int k = 0; k < N_PHASES; ++k) launch_fast(p, k, k + 1, k, stream);
}
```

```cpp
#include <hip/hip_runtime.h>
#include <cstdio>
#include <cstdint>
#include <cmath>
namespace pg8 {


#define PG8_LAS __attribute__((address_space(3)))
typedef unsigned short bf16_t;
typedef short bf16x8 __attribute__((ext_vector_type(8)));
typedef float f32x4 __attribute__((ext_vector_type(4)));
typedef unsigned u32x4 __attribute__((ext_vector_type(4)));
constexpr int BM = 256, BK = 64, HALF = 128, HTB = HALF * BK * 2  , STAGE_BYTES = 8 * HTB, NXCD = 8, WGM = 8;

__host__ __device__ __forceinline__ int lds_byte(int r, int c) { const int st = (r >> 4) * 2 + (c >> 5), rr = r & 15, cc = c & 31, ob = rr * 64 + cc * 2; return st * 1024 + (ob ^ (((ob >> 9) & 1) << 5)); }
__host__ __device__ __forceinline__ void stage_rc(int b, int& R, int& C) { const int st = b / 1024, sb = b % 1024, swz = sb ^ (((sb >> 9) & 1) << 5); R = (st >> 1) * 16 + swz / 64; C = (st & 1) * 32 + (swz % 64) / 2; }
__host__ __device__ __forceinline__ int perm32(int rho) { const int n = rho >> 4, i = rho & 15; return 8 * (i >> 2) + 4 * n + (i & 3); }

__device__ __forceinline__ int otid() { int t = threadIdx.x; asm volatile("" : "+v"(t)); return t; }
template <class Tp> __device__ __forceinline__ Tp* opq(Tp* x) { asm volatile("" : "+s"(x)); return x; }
__device__ __forceinline__ int opqi(int x) { asm volatile("" : "+s"(x)); return x; }
struct Unit { int pm, pn; };
struct Gemm { const bf16_t* A; const bf16_t* Bt; int M, N, K; };

__device__ __forceinline__ int static_pm0(int M, int N, int G, int c) {
    const int nM = M / BM, nN = N / BM, nwg = nM * nN; if (c >= nwg) return -1;
    int wgid = c; { const int q = nwg / NXCD, r = nwg % NXCD, xcd = wgid % NXCD, off = wgid / NXCD; wgid = (xcd < r ? xcd * (q + 1) : r * (q + 1) + (xcd - r) * q) + off; }
    const int nig = WGM * nN, gid = wgid / nig, fm = gid * WGM, gsz = (nM - fm) < WGM ? (nM - fm) : WGM;
    return fm + ((wgid % nig) % gsz);
}
struct StaticOrder {
    int nM, nN, nwg, G, c;
    __host__ __device__ void init(int M, int N, int G_, int c_) { nM = M / BM; nN = N / BM; nwg = nM * nN; G = G_; c = c_; }
    __host__ __device__ bool next(int i, Unit& u) const {
        const long L = (long)i * G + c; if (L >= nwg) return false;
        int wgid = (int)L; { const int q = nwg / NXCD, r = nwg % NXCD, xcd = wgid % NXCD, off = wgid / NXCD; wgid = (xcd < r ? xcd * (q + 1) : r * (q + 1) + (xcd - r) * q) + off; }
        const int nig = WGM * nN, gid = wgid / nig, fm = gid * WGM, gsz = (nM - fm) < WGM ? (nM - fm) : WGM;
        u.pm = fm + ((wgid % nig) % gsz); u.pn = (wgid % nig) / gsz; return true;
    }
    __device__ __forceinline__ void a_ready(const Unit&) const {}
    __device__ __forceinline__ void done(const Unit&) const {}
};

typedef unsigned u32x2e __attribute__((ext_vector_type(2)));
__device__ __forceinline__ unsigned cvt_pk_bf16(float lo, float hi) { unsigned r; asm volatile("v_cvt_pk_bf16_f32 %0, %1, %2" : "=v"(r) : "v"(lo), "v"(hi)); return r; }
constexpr int E_TP = 16384;
__device__ __forceinline__ void rows_rin(const float* rowss, int row0, int fq, float (&rin)[2][4]) {
    f32x4 a[2][4];
#pragma unroll
    for (int ai = 0; ai < 2; ++ai)
#pragma unroll
        for (int m = 0; m < 4; ++m) a[ai][m] = *(const f32x4*)(rowss + (size_t)(row0 + ai * HALF + m * 16) * 16 + 4 * fq);
    float sv[2][4];
#pragma unroll
    for (int ai = 0; ai < 2; ++ai)
#pragma unroll
        for (int m = 0; m < 4; ++m) sv[ai][m] = (a[ai][m][0] + a[ai][m][1]) + (a[ai][m][2] + a[ai][m][3]);
#pragma unroll
    for (int ai = 0; ai < 2; ++ai)
#pragma unroll
        for (int m = 0; m < 4; ++m) sv[ai][m] += __shfl_xor(sv[ai][m], 16);
#pragma unroll
    for (int ai = 0; ai < 2; ++ai)
#pragma unroll
        for (int m = 0; m < 4; ++m) sv[ai][m] += __shfl_xor(sv[ai][m], 32);
#pragma unroll
    for (int ai = 0; ai < 2; ++ai)
#pragma unroll
        for (int m = 0; m < 4; ++m) rin[ai][m] = rsqrtf(sv[ai][m] * (1.f / 1024.f) + 1e-6f);
}
__device__ __forceinline__ float row_rin(const float* rowss, int row, int fq) { const f32x4 a = *(const f32x4*)(rowss + (size_t)row * 16 + 4 * fq); float s = (a[0] + a[1]) + (a[2] + a[3]);
    s += __shfl_xor(s, 16); s += __shfl_xor(s, 32); return rsqrtf(s * (1.f / 1024.f) + 1e-6f); }

struct EpiQKV {
    static constexpr bool PERM = true, AFTER_DRAIN = false;
    bf16_t *Qb, *Kb, *Vb; int ldkv, nq, nk, has_norm; const float *qg, *kg; float qscale;
    float *kp, *vp, *ks, *vs; int swa;
    const float* rowss;
    const PG8_LAS float* rtab;
    __device__ __forceinline__ void operator()(const f32x4 (&acc)[2][2][4][2], const Unit& u, int wr, int wc, int fr, int fq) const {
        const float* rss_ = opq(rowss);
        bf16_t *Qb_ = opq(Qb), *Kb_ = opq(Kb), *Vb_ = opq(Vb); float *kp_ = opq(kp), *vp_ = opq(vp), *ks_ = opq(ks), *vs_ = opq(vs); const float *qg_ = opq(qg), *kg_ = opq(kg);
        const int hg = u.pn * 4 + wc; int type, gi;
        if (hg < nq) { type = 0; gi = hg; } else if (hg < nq + nk) { type = 1; gi = hg - nq; } else { type = 2; gi = hg - nq - nk; }
        float gsc[2][8];
        const float base = type == 0 ? qscale : 1.f;
#pragma unroll
        for (int bj = 0; bj < 2; ++bj)
#pragma unroll
            for (int e = 0; e < 8; ++e) gsc[bj][e] = base;
        const bool normed = has_norm && type < 2;
        if (normed) { const float* g = type == 0 ? qg_ : kg_;
#pragma unroll
            for (int bj = 0; bj < 2; ++bj)
#pragma unroll
                for (int e = 0; e < 8; ++e) gsc[bj][e] = g[32 * bj + 8 * fq + e] * base; }
        const int row0 = u.pm * BM + wr * 64 + fr; const bool prompt = u.pm < E_TP / BM;
        float rinv[2][4];
        if (rss_) {
#pragma unroll
            for (int ai = 0; ai < 2; ++ai)
#pragma unroll
                for (int m = 0; m < 4; ++m) rinv[ai][m] = rtab[wr * 64 + ai * HALF + m * 16 + fr]; }
        bf16_t* bdst = type == 0 ? Qb_ : (type == 1 ? Kb_ : Vb_); const int bld = type == 0 ? 1024 : ldkv;
        float* fdst = type == 1 ? (prompt ? kp_ : ks_) : (prompt ? vp_ : vs_);
        float hss[2][4];
        if (normed) {
#pragma unroll
            for (int ai = 0; ai < 2; ++ai)
#pragma unroll
                for (int m = 0; m < 4; ++m) { float ss = 0.f;
#pragma unroll
                    for (int bj = 0; bj < 2; ++bj)
#pragma unroll
                        for (int n = 0; n < 2; ++n) { const f32x4 x = acc[ai][bj][m][n]; ss += (x[0] * x[0] + x[1] * x[1]) + (x[2] * x[2] + x[3] * x[3]); }
                    hss[ai][m] = ss; }
#pragma unroll
            for (int ai = 0; ai < 2; ++ai)
#pragma unroll
                for (int m = 0; m < 4; ++m) hss[ai][m] += __shfl_xor(hss[ai][m], 16);
#pragma unroll
            for (int ai = 0; ai < 2; ++ai)
#pragma unroll
                for (int m = 0; m < 4; ++m) hss[ai][m] += __shfl_xor(hss[ai][m], 32); }
#pragma unroll
        for (int ai = 0; ai < 2; ++ai)
#pragma unroll
            for (int m = 0; m < 4; ++m) {
                const int row = row0 + ai * HALF + m * 16;
                const float rin = rss_ ? rinv[ai][m] : 1.f;
                float rs = rin;
                if (normed) rs = rin * rsqrtf(hss[ai][m] * (rin * rin) * (1.f / 64.f) + 1e-6f);
                long frow = -1;
                if (type >= 1) { if (!swa) frow = prompt ? row : row - E_TP;
                                 else if (prompt) frow = row - (E_TP - 128); else { const int rr = row - E_TP; frow = (long)(rr >> 5) * 128 + 96 + (rr & 31); } }
#pragma unroll
                for (int bj = 0; bj < 2; ++bj) {
                    f32x4 v0 = acc[ai][bj][m][0] * rs, v1 = acc[ai][bj][m][1] * rs;
                    v0[0] *= gsc[bj][0]; v0[1] *= gsc[bj][1]; v0[2] *= gsc[bj][2]; v0[3] *= gsc[bj][3]; v1[0] *= gsc[bj][4]; v1[1] *= gsc[bj][5]; v1[2] *= gsc[bj][6]; v1[3] *= gsc[bj][7];
                    const int col = gi * 64 + 32 * bj + 8 * fq;
                    u32x4 w; w.x = cvt_pk_bf16(v0[0], v0[1]); w.y = cvt_pk_bf16(v0[2], v0[3]); w.z = cvt_pk_bf16(v1[0], v1[1]); w.w = cvt_pk_bf16(v1[2], v1[3]);
                    *(u32x4*)(bdst + (size_t)row * bld + col) = w;
                    if (frow >= 0) { float* f = fdst + (size_t)frow * ldkv + col; *(f32x4*)f = v0; *(f32x4*)(f + 4) = v1; }
                }
            }
    }
};
struct EpiResid {
    static constexpr bool PERM = true, AFTER_DRAIN = false;
    const float* xin32; const bf16_t* xin16; bf16_t* xout16; float* y32; float* rss;
    __device__ __forceinline__ void operator()(const f32x4 (&acc)[2][2][4][2], const Unit& u, int wr, int wc, int fr, int fq) const {
        const int row0 = u.pm * BM + wr * 64 + fr, col0 = u.pn * BM + wc * 32 + 8 * fq;
        const float* x32 = opq(xin32); float* yo = opq(y32); float* rs_ = opq(rss); float ssv[2][4];
#pragma unroll
        for (int ai = 0; ai < 2; ++ai)
#pragma unroll
            for (int m = 0; m < 4; ++m) { const size_t ro = (size_t)(row0 + ai * HALF + m * 16) * 1024 + col0; float ss = 0.f;
#pragma unroll
                for (int bj = 0; bj < 2; ++bj) { const size_t o = ro + bj * HALF; f32x4 x0, x1;
                    if (x32) { x0 = *(const f32x4*)(x32 + o); x1 = *(const f32x4*)(x32 + o + 4); }
                    else { const u32x4 b = *(const u32x4*)(xin16 + o);
                        x0 = (f32x4){__uint_as_float(b.x << 16), __uint_as_float(b.x & 0xffff0000u), __uint_as_float(b.y << 16), __uint_as_float(b.y & 0xffff0000u)};
                        x1 = (f32x4){__uint_as_float(b.z << 16), __uint_as_float(b.z & 0xffff0000u), __uint_as_float(b.w << 16), __uint_as_float(b.w & 0xffff0000u)}; }
                    x0 = x0 + acc[ai][bj][m][0]; x1 = x1 + acc[ai][bj][m][1];
                    if (yo) { *(f32x4*)(yo + o) = x0; *(f32x4*)(yo + o + 4) = x1; }
                    else { u32x4 w; w.x = cvt_pk_bf16(x0[0], x0[1]); w.y = cvt_pk_bf16(x0[2], x0[3]); w.z = cvt_pk_bf16(x1[0], x1[1]); w.w = cvt_pk_bf16(x1[2], x1[3]); *(u32x4*)(xout16 + o) = w;
#pragma unroll
                        for (int e = 0; e < 4; ++e) { const float a = __uint_as_float(w[e] << 16), b = __uint_as_float(w[e] & 0xffff0000u); ss += a * a + b * b; } } }
                ssv[ai][m] = ss;
                if (m & 1) asm volatile("" ::: "memory"); }
        if (rs_) {
#pragma unroll
            for (int ai = 0; ai < 2; ++ai)
#pragma unroll
                for (int m = 0; m < 4; ++m) ssv[ai][m] += __shfl_xor(ssv[ai][m], 16);
#pragma unroll
            for (int ai = 0; ai < 2; ++ai)
#pragma unroll
                for (int m = 0; m < 4; ++m) ssv[ai][m] += __shfl_xor(ssv[ai][m], 32);
            if (fq == 0) {
#pragma unroll
                for (int ai = 0; ai < 2; ++ai)
#pragma unroll
                    for (int m = 0; m < 4; ++m) rs_[(size_t)(row0 + ai * HALF + m * 16) * 16 + u.pn * 4 + wc] = ssv[ai][m]; } }
    }
};
struct EpiRelu2 {
    static constexpr bool PERM = true, AFTER_DRAIN = false;
    bf16_t* O; int ldc; const float* rowss;
    const PG8_LAS float* rtab;
    __device__ __forceinline__ void operator()(const f32x4 (&acc)[2][2][4][2], const Unit& u, int wr, int wc, int fr, int fq) const {
        const int row0 = u.pm * BM + wr * 64 + fr, col0 = u.pn * BM + wc * 32 + 8 * fq;
        float rinv[2][4];
#pragma unroll
        for (int ai = 0; ai < 2; ++ai)
#pragma unroll
            for (int m = 0; m < 4; ++m) rinv[ai][m] = rtab[wr * 64 + ai * HALF + m * 16 + fr];
#pragma unroll
        for (int ai = 0; ai < 2; ++ai)
#pragma unroll
            for (int m = 0; m < 4; ++m) { bf16_t* rowp = O + (size_t)(row0 + ai * HALF + m * 16) * ldc + col0;
                const float rin2 = rinv[ai][m] * rinv[ai][m];
#pragma unroll
                for (int bj = 0; bj < 2; ++bj) { f32x4 v0 = acc[ai][bj][m][0], v1 = acc[ai][bj][m][1];
#pragma unroll
                    for (int e = 0; e < 4; ++e) { const float a = fmaxf(v0[e], 0.f), b = fmaxf(v1[e], 0.f); v0[e] = a * a * rin2; v1[e] = b * b * rin2; }
                    u32x4 w; w.x = cvt_pk_bf16(v0[0], v0[1]); w.y = cvt_pk_bf16(v0[2], v0[3]); w.z = cvt_pk_bf16(v1[0], v1[1]); w.w = cvt_pk_bf16(v1[2], v1[3]);
                    *(u32x4*)(rowp + bj * HALF) = w; } }
    }
};
template <class Epi, class Sched, bool ALIGN_EPI = false, bool SP2 = false>
__device__ __forceinline__ void gemm_phase(PG8_LAS unsigned char* lds, const Gemm g, const Sched& S, const Epi& E) {
    const int tid = otid(), wid = __builtin_amdgcn_readfirstlane(tid >> 6), lane = tid & 63, wr = wid >> 2, wc = wid & 3, fr = lane & 15, fq = lane >> 4;
    const int K = g.K, nt = K / BK;
    unsigned voffA[2], voffB[2];
#pragma unroll
    for (int i = 0; i < 2; ++i) { int R, C; stage_rc(tid * 16 + i * 8192, R, C); const int Rb = Epi::PERM ? ((R & ~31) + perm32(R & 31)) : R;
        voffA[i] = (unsigned)(R * K + C) * 2u; voffB[i] = (unsigned)(Rb * K + C) * 2u; }
    const size_t kstep = (size_t)(BK * 2);
    const size_t hstep = (size_t)HALF * K * 2;
    const size_t tstep = 2 * hstep;
    const unsigned ldsw = (unsigned)wid * 1024u;
    const int aoff = lds_byte(wr * 64 + fr, fq * 8), boff = lds_byte(wc * 32 + fr, fq * 8);
#define PG8_SA(b, h) (((b) * 2 + (h)) * HTB)
#define PG8_SB(b, h) ((4 + (b) * 2 + (h)) * HTB)
#define PG8_STAGE(bufoff, gbase, voff) do { _Pragma("unroll") for (int _i = 0; _i < 2; ++_i) \
        __builtin_amdgcn_global_load_lds((const unsigned*)((const char*)(gbase) + (voff)[_i]), (PG8_LAS unsigned*)(lds + (bufoff) + ldsw + _i * 8192), 16, 0, 0); } while (0)
#define PG8_LDA(dst, b, h) do { _Pragma("unroll") for (int m = 0; m < 4; ++m) _Pragma("unroll") for (int k = 0; k < 2; ++k) dst[m][k] = *(const PG8_LAS bf16x8*)(lds + PG8_SA(b, h) + aoff + m * 2048 + k * 1024); } while (0)
#define PG8_LDB(dst, b, h) do { _Pragma("unroll") for (int n = 0; n < 2; ++n) _Pragma("unroll") for (int k = 0; k < 2; ++k) dst[n][k] = *(const PG8_LAS bf16x8*)(lds + PG8_SB(b, h) + boff + n * 2048 + k * 1024); } while (0)
#define PG8_MMA(ai, bj, At, Bt) do { __builtin_amdgcn_s_setprio(1); _Pragma("unroll") for (int m = 0; m < 4; ++m) _Pragma("unroll") for (int n = 0; n < 2; ++n) _Pragma("unroll") for (int k = 0; k < 2; ++k) \
        acc[ai][bj][m][n] = __builtin_amdgcn_mfma_f32_16x16x32_bf16(Bt[n][k], At[m][k], acc[ai][bj][m][n], 0, 0, 0); __builtin_amdgcn_s_setprio(0); } while (0)
#define PG8_WAIT_V(n) asm volatile("s_waitcnt vmcnt(" #n ")" ::: "memory")
#define PG8_WAIT_L(n) asm volatile("s_waitcnt lgkmcnt(" #n ")" ::: "memory")
#define PG8_BAR __builtin_amdgcn_s_barrier()
#define PG8_SCHED __builtin_amdgcn_sched_barrier(0)
    Unit cur, nxt; int ui = 0;
    if (!S.next(0, cur)) return;
    f32x4 acc[2][2][4][2];
#pragma unroll
    for (int a = 0; a < 2; ++a)
#pragma unroll
        for (int b = 0; b < 2; ++b)
#pragma unroll
            for (int m = 0; m < 4; ++m)
#pragma unroll
                for (int n = 0; n < 2; ++n) acc[a][b][m][n] = (f32x4){0.f, 0.f, 0.f, 0.f};
    bf16x8 At[4][2], B0[2][2], B1[2][2];
    const char* cA = (const char*)g.A + (size_t)cur.pm * tstep; const char* cB = (const char*)g.Bt + (size_t)cur.pn * tstep;
    S.a_ready(cur);
    if constexpr (SP2) {
        PG8_STAGE(PG8_SB(0, 0), cB, voffB); PG8_STAGE(PG8_SB(0, 1), cB + hstep, voffB); PG8_STAGE(PG8_SA(0, 0), cA, voffA); PG8_STAGE(PG8_SA(0, 1), cA + hstep, voffA);
        if (wr == 1) PG8_BAR;
        PG8_WAIT_V(2); PG8_BAR;
        PG8_STAGE(PG8_SB(1, 0), cB + kstep, voffB); PG8_STAGE(PG8_SA(1, 0), cA + kstep, voffA); PG8_STAGE(PG8_SB(1, 1), cB + hstep + kstep, voffB);
        PG8_WAIT_V(6); PG8_BAR;
    } else {
        PG8_STAGE(PG8_SB(0, 0), cB, voffB); PG8_STAGE(PG8_SA(0, 0), cA, voffA); PG8_STAGE(PG8_SB(0, 1), cB + hstep, voffB); PG8_STAGE(PG8_SA(0, 1), cA + hstep, voffA);
        if (wr == 1) PG8_BAR;
        PG8_WAIT_V(4); PG8_BAR;
        PG8_STAGE(PG8_SB(1, 0), cB + kstep, voffB); PG8_STAGE(PG8_SA(1, 0), cA + kstep, voffA); PG8_STAGE(PG8_SB(1, 1), cB + hstep + kstep, voffB);
        PG8_WAIT_V(6); PG8_BAR;
    }
    for (;;) {
        const bool has_next = S.next(ui + 1, nxt);
        const char* nA = has_next ? (const char*)g.A + (size_t)nxt.pm * tstep : cA; const char* nB = has_next ? (const char*)g.Bt + (size_t)nxt.pn * tstep : cB;
        for (int t = 0; t < nt; t += 2) {
            const bool last = (t == nt - 2);
            const char* a1 = cA + (size_t)(t + 1) * kstep;
            const char* a2 = last ? nA : cA + (size_t)(t + 2) * kstep; const char* b2 = last ? nB : cB + (size_t)(t + 2) * kstep;
            const char* a3 = a2 + kstep; const char* b3 = b2 + kstep;
            if (last && has_next) S.a_ready(nxt);
            if constexpr (SP2) {
            PG8_LDB(B0, 0, 0); PG8_LDB(B1, 0, 1); PG8_SCHED; PG8_LDA(At, 0, 0); PG8_STAGE(PG8_SA(1, 1), a1 + hstep, voffA);
            PG8_WAIT_V(8); PG8_WAIT_L(0); PG8_BAR; PG8_MMA(0, 0, At, B0); PG8_MMA(0, 1, At, B1); PG8_BAR; PG8_SCHED;
            PG8_LDA(At, 0, 1); PG8_STAGE(PG8_SB(0, 0), b2, voffB); PG8_STAGE(PG8_SB(0, 1), b2 + hstep, voffB); PG8_STAGE(PG8_SA(0, 0), a2, voffA);
            PG8_WAIT_V(8); PG8_WAIT_L(0); PG8_BAR; PG8_MMA(1, 0, At, B0); PG8_MMA(1, 1, At, B1); PG8_BAR; PG8_SCHED;
            PG8_LDB(B0, 1, 0); PG8_LDB(B1, 1, 1); PG8_SCHED; PG8_LDA(At, 1, 0); PG8_STAGE(PG8_SA(0, 1), a2 + hstep, voffA);
            PG8_WAIT_V(8); PG8_WAIT_L(0); PG8_BAR; PG8_MMA(0, 0, At, B0); PG8_MMA(0, 1, At, B1); PG8_BAR; PG8_SCHED;
            PG8_LDA(At, 1, 1); PG8_STAGE(PG8_SB(1, 0), b3, voffB); PG8_STAGE(PG8_SB(1, 1), b3 + hstep, voffB); PG8_STAGE(PG8_SA(1, 0), a3, voffA);
            PG8_WAIT_V(8); PG8_WAIT_L(0); PG8_BAR; PG8_MMA(1, 0, At, B0); PG8_MMA(1, 1, At, B1); PG8_BAR; PG8_SCHED;
            } else {
            PG8_LDB(B0, 0, 0); PG8_SCHED; PG8_LDA(At, 0, 0); PG8_STAGE(PG8_SA(1, 1), a1 + hstep, voffA);
            PG8_WAIT_L(8); PG8_BAR; PG8_WAIT_L(0); PG8_MMA(0, 0, At, B0); PG8_BAR; PG8_SCHED;
            PG8_LDB(B1, 0, 1); PG8_STAGE(PG8_SB(0, 0), b2, voffB);
            PG8_BAR; PG8_WAIT_L(0); PG8_MMA(0, 1, At, B1); PG8_BAR;
            PG8_LDA(At, 0, 1); PG8_STAGE(PG8_SA(0, 0), a2, voffA);
            PG8_BAR; PG8_WAIT_L(0); PG8_MMA(1, 0, At, B0); PG8_BAR; PG8_SCHED;
            PG8_STAGE(PG8_SB(0, 1), b2 + hstep, voffB);
            PG8_WAIT_V(6); PG8_BAR; PG8_MMA(1, 1, At, B1); PG8_BAR;
            PG8_LDB(B0, 1, 0); PG8_SCHED; PG8_LDA(At, 1, 0); PG8_STAGE(PG8_SA(0, 1), a2 + hstep, voffA);
            PG8_WAIT_L(8); PG8_BAR; PG8_WAIT_L(0); PG8_MMA(0, 0, At, B0); PG8_BAR; PG8_SCHED;
            PG8_LDB(B1, 1, 1); PG8_STAGE(PG8_SB(1, 0), b3, voffB);
            PG8_BAR; PG8_WAIT_L(0); PG8_MMA(0, 1, At, B1); PG8_BAR;
            PG8_LDA(At, 1, 1); PG8_STAGE(PG8_SA(1, 0), a3, voffA);
            PG8_BAR; PG8_WAIT_L(0); PG8_MMA(1, 0, At, B0); PG8_BAR; PG8_SCHED;
            PG8_STAGE(PG8_SB(1, 1), b3 + hstep, voffB);
            PG8_WAIT_V(6); PG8_BAR; PG8_MMA(1, 1, At, B1); PG8_BAR;
            }
        }
        if constexpr (ALIGN_EPI) { if (wr == 0) PG8_BAR; }
        if constexpr (!Epi::AFTER_DRAIN) { E(acc, cur, wr, wc, fr, fq); S.done(cur); }
        if (!has_next) break;
#pragma unroll
        for (int a = 0; a < 2; ++a)
#pragma unroll
            for (int b = 0; b < 2; ++b)
#pragma unroll
                for (int m = 0; m < 4; ++m)
#pragma unroll
                    for (int n = 0; n < 2; ++n) acc[a][b][m][n] = (f32x4){0.f, 0.f, 0.f, 0.f};
        cur = nxt; cA = nA; cB = nB; ++ui;
        if constexpr (ALIGN_EPI) { if (wr == 1) PG8_BAR; }
    }
    PG8_WAIT_V(0);
    if constexpr (!ALIGN_EPI) { if (wr == 0) PG8_BAR; }
    PG8_BAR;
    if constexpr (Epi::AFTER_DRAIN) { E.fused(acc, cur, wr, wc, fr, fq, lds, wid, lane); S.done(cur); }
#undef PG8_SA
#undef PG8_SB
#undef PG8_STAGE
#undef PG8_LDA
#undef PG8_LDB
#undef PG8_MMA
#undef PG8_WAIT_V
#undef PG8_WAIT_L
#undef PG8_BAR
#undef PG8_SCHED
}
}
namespace fx {
#define LAS __attribute__((address_space(3)))
typedef unsigned short bf16_t;
typedef short bf16x8 __attribute__((ext_vector_type(8)));
typedef short s16x4 __attribute__((ext_vector_type(4)));
typedef float f32x4 __attribute__((ext_vector_type(4)));
typedef float f32x16 __attribute__((ext_vector_type(16)));
typedef unsigned u32x4 __attribute__((ext_vector_type(4)));
typedef unsigned u32x2 __attribute__((ext_vector_type(2)));
constexpr int D = 1024, TP = 16384, TS = 512, T = TP + TS, FF = 4096, NWAVES = 8;
constexpr float LOG2E = 1.4426950408889634f, QSC = 0.125f * LOG2E;

typedef float f32x2_t __attribute__((ext_vector_type(2))); typedef __bf16 bf16x2_t __attribute__((ext_vector_type(2)));
__device__ __forceinline__ unsigned cvtpk(float lo, float hi) { f32x2_t v = {lo, hi}; bf16x2_t b = __builtin_convertvector(v, bf16x2_t); return __builtin_bit_cast(unsigned, b); }
__device__ __forceinline__ u32x4 pack8(f32x4 a, f32x4 b) { u32x4 w; w.x = cvtpk(a.x, a.y); w.y = cvtpk(a.z, a.w); w.z = cvtpk(b.x, b.y); w.w = cvtpk(b.z, b.w); return w; }
__device__ __forceinline__ float wave_sum(float v) {
#pragma unroll
    for (int o = 32; o; o >>= 1) v += __shfl_xor(v, o);
    return v;
}
__device__ __forceinline__ int t5_bucket(int rel) {
    const int ret = rel > 0 ? 16 : 0; const int n = rel < 0 ? -rel : rel;
    const int b = n < 8 ? n : n < 12 ? 8 : n < 16 ? 9 : n < 23 ? 10 : n < 32 ? 11 : n < 46 ? 12 : n < 64 ? 13 : n < 91 ? 14 : 15;
    return ret + b;
}
__device__ __forceinline__ int crow(int r, int hi) { return (r & 3) + 8 * (r >> 2) + 4 * hi; }
constexpr size_t MiB = 1u << 20;
#if defined(FX_STAMP) && FX_STAMP
constexpr size_t WS_CTL = 0, CTL_ZERO_BYTES = 1 * MiB;
#else
constexpr size_t WS_CTL = 0, CTL_ZERO_BYTES = 128 * 1024;
#endif
constexpr size_t WL_QKV = 0, WL_O = (size_t)3072 * 1024 * 2, WL_UP = WL_O + (size_t)1024 * 1024 * 2, WL_DN = WL_UP + (size_t)4096 * 1024 * 2, WL_BYTES = WL_DN + (size_t)4096 * 1024 * 2;
constexpr size_t WS_W = 1 * MiB, WS_XN = WS_W + 4 * WL_BYTES, ACT_B = (size_t)T * D * 2;
constexpr size_t WS_Q = WS_XN + ACT_B, WS_K = WS_Q + ACT_B, WS_V = WS_K + ACT_B, WS_O = WS_V + ACT_B, WS_U = WS_Q, WS_XR = WS_O + ACT_B, WS_SLAB = WS_XR + ACT_B, WS_RSS = WS_SLAB + 4 * (size_t)TS * D * 4, WS_END = WS_RSS + (size_t)TP * 16 * 4;
static_assert(WL_BYTES == 24 * MiB && WS_END < 320 * MiB, "ws map");
constexpr int CW_TMO = 0, CW_CODE = 1, CW_BAR = 4096, CW_FLAG = 16384;
constexpr int RING_BYTES = 131072, LDSCTL_OFF = RING_BYTES, MISC_OFF = LDSCTL_OFF + 320, GA_TAB = LDSCTL_OFF + 512, GA_WSF = GA_TAB + 4 * 160 * 4, GA_FLG = GA_WSF + NWAVES * 64 * 4, LDS_BYTES = 147456;
static_assert(GA_FLG + 64 <= LDS_BYTES, "LDS map");
enum In { X_P = 0, X_S, C_DK, C_DV, C_WK, C_WV, C_BK, C_BV, REL_BIAS, NORM_MIX, NORM_MLP, W_UP, W_DOWN, D_WQKV, D_WO, D_QN, D_KN, D_LAM, D_SUBLN, S_WQKV, S_WO, S_QN, S_KN, S_SINKS, B_WQKV, B_WO };

struct Params {
    const float* in[26];
    unsigned char* ws;
    float* yout;
    float *dkp[2], *dvp[2], *dks[2], *dvs[2];
    float *wkp, *wvp, *wks, *wvs;
    float *bkp, *bvp, *bks, *bvs;
    int ph_lo, ph_hi, li, pad;
};

#define XB_TMO      128
#define XB_XCNT(j)  (256  + 64 * (j))
#define XB_XSUB(j)  (1280 + 64 * (j))
#define XB_XGEN(j)  (2304 + 64 * (j))
#define XB_TOP      3328
#define XB_TOPGEN   3392
#define XCD_BAR_WORDS 3456
#define XB_SPIN_CAP (1u << 18)

__device__ __forceinline__ unsigned xb_ld(unsigned* p)              { return __hip_atomic_load(p, __ATOMIC_RELAXED, __HIP_MEMORY_SCOPE_AGENT); }
__device__ __forceinline__ unsigned xb_add(unsigned* p, unsigned v) { return __hip_atomic_fetch_add(p, v, __ATOMIC_RELAXED, __HIP_MEMORY_SCOPE_AGENT); }
__device__ __forceinline__ unsigned xb_xcc_id() { return (unsigned)__builtin_amdgcn_s_getreg((3 << 11) | 20) & 0xFu; }
#define XB_SPIN(cond, bar) do { unsigned _sp = 0; while (cond) { __builtin_amdgcn_s_sleep(1); \
    if ((++_sp & 255u) == 0u) { if (xb_ld(&(bar)[XB_TMO])) break; if (_sp > XB_SPIN_CAP) { atomicAdd(&(bar)[XB_TMO], 1u); break; } } } } while (0)

struct XcdBarrier {
    unsigned* bar; unsigned x;
    volatile LAS unsigned* st;
};

__device__ __forceinline__ XcdBarrier xcd_barrier_post(unsigned* bar, volatile LAS unsigned* st) {
    XcdBarrier b; b.bar = bar; b.x = xb_xcc_id(); b.st = st;
    if (threadIdx.x == 0) (void)xb_add(&bar[XB_XCNT(b.x)], 1u);
    return b;
}
__device__ __forceinline__ void xcd_barrier_complete(unsigned* bar, unsigned x, unsigned& nloc, unsigned& nx) {
    const unsigned G = gridDim.x * gridDim.y * gridDim.z;
    unsigned sum, cnt, mine, sp = 0u;
    for (;;) {
        sum = 0u; cnt = 0u; mine = 0u;
#pragma unroll
        for (unsigned j = 0; j < 16; ++j) { const unsigned c = xb_ld(&bar[XB_XCNT(j)]); sum += c; cnt += (c > 0u) ? 1u : 0u; mine = (j == x) ? c : mine; }
        if (sum == G) break;
        __builtin_amdgcn_s_sleep(1);
        if ((++sp & 255u) == 0u) { if (xb_ld(&bar[XB_TMO])) break; if (sp > XB_SPIN_CAP) { atomicAdd(&bar[XB_TMO], 1u); break; } }
    }
    nloc = mine > 0u ? mine : 1u; nx = cnt > 0u ? cnt : 1u;
}

__device__ __forceinline__ void xcd_barrier(const XcdBarrier& b) {
    asm volatile("s_waitcnt vmcnt(0)" ::: "memory");
    __syncthreads();
    if (threadIdx.x == 0) {
        unsigned* bar = b.bar;
        __builtin_amdgcn_s_waitcnt(0);
        unsigned nloc = b.st[0], nx = b.st[1];
        if (nloc == 0u) { xcd_barrier_complete(bar, b.x, nloc, nx); b.st[0] = nloc; b.st[1] = nx; }
        const unsigned old = xb_add(&bar[XB_XSUB(b.x)], 1u);
        const unsigned gen = old / nloc;
        if (old + 1u == (gen + 1u) * nloc) {
            __builtin_amdgcn_fence(__ATOMIC_RELEASE, "agent");
            asm volatile("s_waitcnt vmcnt(0)" ::: "memory");
            const unsigned og = xb_add(&bar[XB_TOP], 1u);
            const unsigned tg = og / nx;
            if (og + 1u == (tg + 1u) * nx) xb_add(&bar[XB_TOPGEN], 1u);
            else XB_SPIN(xb_ld(&bar[XB_TOPGEN]) == tg, bar);
            __builtin_amdgcn_fence(__ATOMIC_ACQUIRE, "agent");
            xb_add(&bar[XB_XGEN(b.x)], 1u);
            asm volatile("s_waitcnt vmcnt(0)" ::: "memory");
        } else {
            XB_SPIN(xb_ld(&bar[XB_XGEN(b.x)]) == gen, bar);
            __builtin_amdgcn_fence(__ATOMIC_ACQUIRE, "agent");
            asm volatile("s_waitcnt vmcnt(0)" ::: "memory");
        }
    }
    __syncthreads();
}


__device__ __forceinline__ unsigned f2bf(float f) { unsigned u = __builtin_bit_cast(unsigned, f); return (u + 0x7fffu + ((u >> 16) & 1u)) >> 16; }
__device__ __forceinline__ unsigned pk2(float lo, float hi) { return f2bf(lo) | (f2bf(hi) << 16); }
struct PItem { const float* W; const float* gk; bf16_t* WT; int K, N, k0, n0, dst; };
__device__ __forceinline__ bool pro_item(const Params& p, int it, PItem& q) {
    constexpr int I_QKV = 16 * 96, I_O = 16 * 32, I_UP = 16 * 128, I_DN = 64 * 32, PER = I_QKV + I_O + I_UP + I_DN;
    const int layer = it / PER, mix = layer % 3, j = layer / 3; int r = it % PER;
    unsigned char* wl = p.ws + WS_W + (size_t)layer * WL_BYTES;
    if (r < I_QKV) {
        const int N = mix == 1 ? 1536 : 3072, nblk = N / 32; if (r >= 16 * nblk) return false;
        const float* W = mix == 0 ? p.in[D_WQKV] + (size_t)j * D * 3072 : (mix == 1 ? p.in[S_WQKV] : p.in[B_WQKV]);
        const int kb = r / nblk, nb = r % nblk, n0 = 32 * nb, within = n0 & 255;
        q.W = W; q.gk = p.in[NORM_MIX] + layer * D; q.WT = (bf16_t*)(wl + WL_QKV); q.K = D; q.N = N; q.k0 = 64 * kb; q.n0 = n0;
        q.dst = (n0 & ~255) + 128 * ((within >> 5) & 1) + 32 * (within >> 6);
        return true; }
    r -= I_QKV;
    if (r < I_O) { q.W = mix == 0 ? p.in[D_WO] + (size_t)j * D * D : (mix == 1 ? p.in[S_WO] : p.in[B_WO]); q.gk = nullptr; q.WT = (bf16_t*)(wl + WL_O); q.K = D; q.N = D; q.k0 = 64 * (r / 32); q.n0 = 32 * (r % 32); q.dst = q.n0; return true; }
    r -= I_O;
    if (r < I_UP) { q.W = p.in[W_UP] + (size_t)layer * D * FF; q.gk = p.in[NORM_MLP] + layer * D; q.WT = (bf16_t*)(wl + WL_UP); q.K = D; q.N = FF; q.k0 = 64 * (r / 128); q.n0 = 32 * (r % 128); q.dst = q.n0; return true; }
    r -= I_UP;
    q.W = p.in[W_DOWN] + (size_t)layer * FF * D; q.gk = nullptr; q.WT = (bf16_t*)(wl + WL_DN); q.K = FF; q.N = D; q.k0 = 64 * (r / 32); q.n0 = 32 * (r % 32); q.dst = q.n0; return true;
}
__device__ __forceinline__ void pro_load(const PItem& q, int lane, f32x4 (&wv)[8]) {
#pragma unroll
    for (int i = 0; i < 8; ++i) wv[i] = *(const f32x4*)(q.W + (size_t)(q.k0 + 8 * i + (lane >> 3)) * q.N + q.n0 + 4 * (lane & 7));
}
__device__ __forceinline__ void pro_store(const PItem& q, int lane, const f32x4 (&wv)[8], LAS float* scr) {
#pragma unroll
    for (int i = 0; i < 8; ++i) { const int kk = 8 * i + (lane >> 3); const float g_ = q.gk ? q.gk[q.k0 + kk] : 1.f; LAS float* d_ = scr + kk * 33 + 4 * (lane & 7);
        d_[0] = wv[i][0] * g_; d_[1] = wv[i][1] * g_; d_[2] = wv[i][2] * g_; d_[3] = wv[i][3] * g_; }
    asm volatile("s_waitcnt lgkmcnt(0)" ::: "memory");
    const int c = lane & 7;
#pragma unroll
    for (int j = 0; j < 4; ++j) { const int n = (lane >> 3) + 8 * j; const LAS float* s = scr + (8 * c) * 33 + n;
        u32x4 o; o.x = pk2(s[0 * 33], s[1 * 33]); o.y = pk2(s[2 * 33], s[3 * 33]); o.z = pk2(s[4 * 33], s[5 * 33]); o.w = pk2(s[6 * 33], s[7 * 33]);
        *(u32x4*)(q.WT + (size_t)(q.dst + n) * q.K + q.k0 + 8 * c) = o; }
    asm volatile("s_waitcnt lgkmcnt(0)" ::: "memory");
}
__device__ __forceinline__ void prologue(const Params& p, LAS unsigned char* lds, int gw, int NGW, int wave, int lane) {
    LAS float* scr = (LAS float*)(lds + wave * 16384);
    constexpr int NIT = 4 * (16 * 96 + 16 * 32 + 16 * 128 + 64 * 32);
    PItem a, b; f32x4 wa[8], wb[8]; int it = gw; bool va = false, vb = false;
    while (it < NIT && !(va = pro_item(p, it, a))) it += NGW;
    if (va) pro_load(a, lane, wa);
    if (va) { it += NGW; while (it < NIT && !(vb = pro_item(p, it, b))) it += NGW; }
    if (vb) pro_load(b, lane, wb);
    while (va) {
        PItem c; f32x4 wc[8]; bool vc = false;
        if (vb) { it += NGW; while (it < NIT && !(vc = pro_item(p, it, c))) it += NGW; }
        if (vc) pro_load(c, lane, wc);
        pro_store(a, lane, wa, scr);
        a = b; va = vb; b = c; vb = vc;
#pragma unroll
        for (int i = 0; i < 8; ++i) { wa[i] = wb[i]; wb[i] = wc[i]; }
    }
    for (int i = gw * 64 + lane; i < 16 * 96 * 64; i += NGW * 64) { const int c4 = i & 63, r = (i >> 6) % 96, b = i / (96 * 64);
        ((f32x4*)p.wks)[((size_t)b * 128 + r) * 64 + c4] = ((const f32x4*)p.in[C_WK])[((size_t)b * 128 + r + 32) * 64 + c4];
        ((f32x4*)p.wvs)[((size_t)b * 128 + r) * 64 + c4] = ((const f32x4*)p.in[C_WV])[((size_t)b * 128 + r + 32) * 64 + c4]; }
}
__device__ __forceinline__ void rms_phase(const float* xp32, const float* xs32, bf16_t* xb, const float* slab, int row_lo, bf16_t* XN, int gw, int NGW, int lane) {
    for (int row = row_lo + gw; row < T; row += NGW) {
        f32x4 v[4]; const bool smp = row >= TP; const float* x32 = smp ? xs32 : xp32;
        if (!x32) { const u32x4* xr = (const u32x4*)(xb + (size_t)row * D) + 2 * lane; const u32x4 a = xr[0], c = xr[1];
            v[0] = (f32x4){__uint_as_float(a.x << 16), __uint_as_float(a.x & 0xffff0000u), __uint_as_float(a.y << 16), __uint_as_float(a.y & 0xffff0000u)};
            v[1] = (f32x4){__uint_as_float(a.z << 16), __uint_as_float(a.z & 0xffff0000u), __uint_as_float(a.w << 16), __uint_as_float(a.w & 0xffff0000u)};
            v[2] = (f32x4){__uint_as_float(c.x << 16), __uint_as_float(c.x & 0xffff0000u), __uint_as_float(c.y << 16), __uint_as_float(c.y & 0xffff0000u)};
            v[3] = (f32x4){__uint_as_float(c.z << 16), __uint_as_float(c.z & 0xffff0000u), __uint_as_float(c.w << 16), __uint_as_float(c.w & 0xffff0000u)}; }
        else { const f32x4* xr = (const f32x4*)(x32 + (size_t)(smp ? row - TP : row) * D) + 4 * lane;
#pragma unroll
            for (int j = 0; j < 4; ++j) v[j] = xr[j]; }
        if (smp && slab) {
#pragma unroll
            for (int ks = 0; ks < 4; ++ks) { const f32x4* sr = (const f32x4*)(slab + ((size_t)ks * TS + (row - TP)) * D) + 4 * lane;
#pragma unroll
                for (int j = 0; j < 4; ++j) v[j] = v[j] + sr[j]; }
            u32x4 s0, s1; s0.x = cvtpk(v[0].x, v[0].y); s0.y = cvtpk(v[0].z, v[0].w); s0.z = cvtpk(v[1].x, v[1].y); s0.w = cvtpk(v[1].z, v[1].w);
            s1.x = cvtpk(v[2].x, v[2].y); s1.y = cvtpk(v[2].z, v[2].w); s1.z = cvtpk(v[3].x, v[3].y); s1.w = cvtpk(v[3].z, v[3].w);
            u32x4* xo = (u32x4*)(xb + (size_t)row * D) + 2 * lane; xo[0] = s0; xo[1] = s1;
            v[0] = (f32x4){__uint_as_float(s0.x << 16), __uint_as_float(s0.x & 0xffff0000u), __uint_as_float(s0.y << 16), __uint_as_float(s0.y & 0xffff0000u)};
            v[1] = (f32x4){__uint_as_float(s0.z << 16), __uint_as_float(s0.z & 0xffff0000u), __uint_as_float(s0.w << 16), __uint_as_float(s0.w & 0xffff0000u)};
            v[2] = (f32x4){__uint_as_float(s1.x << 16), __uint_as_float(s1.x & 0xffff0000u), __uint_as_float(s1.y << 16), __uint_as_float(s1.y & 0xffff0000u)};
            v[3] = (f32x4){__uint_as_float(s1.z << 16), __uint_as_float(s1.z & 0xffff0000u), __uint_as_float(s1.w << 16), __uint_as_float(s1.w & 0xffff0000u)}; }
        float s = 0.f;
#pragma unroll
        for (int j = 0; j < 4; ++j) s += (v[j].x * v[j].x + v[j].y * v[j].y) + (v[j].z * v[j].z + v[j].w * v[j].w);
        const float r = rsqrtf(wave_sum(s) * (1.f / D) + 1e-6f);
        u32x4 w0, w1; f32x4 y;
        y = v[0] * r; w0.x = cvtpk(y.x, y.y); w0.y = cvtpk(y.z, y.w); y = v[1] * r; w0.z = cvtpk(y.x, y.y); w0.w = cvtpk(y.z, y.w);
        y = v[2] * r; w1.x = cvtpk(y.x, y.y); w1.y = cvtpk(y.z, y.w); y = v[3] * r; w1.z = cvtpk(y.x, y.y); w1.w = cvtpk(y.z, y.w);
        u32x4* o = (u32x4*)(XN + (size_t)row * D) + 2 * lane; o[0] = w0; o[1] = w1;
    }
}
__device__ __forceinline__ void rms0_phase(const float* xp32, const float* xs32, bf16_t* XN, int gw, int NGW, int lane) {
    int row = gw; if (row >= T) return;
    f32x4 v[4];
    { const f32x4* xr = (const f32x4*)((row >= TP ? xs32 + (size_t)(row - TP) * D : xp32 + (size_t)row * D)) + 4 * lane;
#pragma unroll
      for (int j = 0; j < 4; ++j) v[j] = xr[j]; }
    for (;;) {
        const int nrow = row + NGW; f32x4 w[4];
        if (nrow < T) { const f32x4* xr = (const f32x4*)((nrow >= TP ? xs32 + (size_t)(nrow - TP) * D : xp32 + (size_t)nrow * D)) + 4 * lane;
#pragma unroll
            for (int j = 0; j < 4; ++j) w[j] = xr[j]; }
        float s = 0.f;
#pragma unroll
        for (int j = 0; j < 4; ++j) s += (v[j].x * v[j].x + v[j].y * v[j].y) + (v[j].z * v[j].z + v[j].w * v[j].w);
        const float r = rsqrtf(wave_sum(s) * (1.f / D) + 1e-6f);
        u32x4 w0, w1; f32x4 y;
        y = v[0] * r; w0.x = cvtpk(y.x, y.y); w0.y = cvtpk(y.z, y.w); y = v[1] * r; w0.z = cvtpk(y.x, y.y); w0.w = cvtpk(y.z, y.w);
        y = v[2] * r; w1.x = cvtpk(y.x, y.y); w1.y = cvtpk(y.z, y.w); y = v[3] * r; w1.z = cvtpk(y.x, y.y); w1.w = cvtpk(y.z, y.w);
        u32x4* o = (u32x4*)(XN + (size_t)row * D) + 2 * lane; o[0] = w0; o[1] = w1;
        if (nrow >= T) break;
        row = nrow;
#pragma unroll
        for (int j = 0; j < 4; ++j) v[j] = w[j];
    }
}
typedef short v4i16_t __attribute__((ext_vector_type(4)));
__device__ __forceinline__ s16x4 vtr(const LAS unsigned char* p) { return __builtin_bit_cast(s16x4, __builtin_amdgcn_ds_read_tr16_b64_v4i16((LAS v4i16_t*)p)); }
#define MFMA32(a, b, c) __builtin_amdgcn_mfma_f32_32x32x16_bf16(a, b, c, 0, 0, 0)
enum { M_DIFF_P = 0, M_DIFF_S, M_SWA_P, M_SWA_S, M_SB_P, M_SB_S };

struct RawPiece { u32x4 a, b; };
__device__ __forceinline__ RawPiece ld_piece(const void* src, bool f32, size_t elem_off, bool valid) {
    RawPiece r; r.a = (u32x4){0u, 0u, 0u, 0u}; r.b = r.a;
    if (valid) { if (f32) { const u32x4* s = (const u32x4*)((const float*)src + elem_off); r.a = __builtin_nontemporal_load(s); r.b = __builtin_nontemporal_load(s + 1); }     else r.a = *(const u32x4*)((const bf16_t*)src + elem_off); }
    return r;
}
__device__ __forceinline__ u32x4 cv_piece(const RawPiece& r, bool f32) { return f32 ? pack8(__builtin_bit_cast(f32x4, r.a), __builtin_bit_cast(f32x4, r.b)) : r.a; }

template <int MODE>
__device__ __forceinline__ void attn_unit(const Params& p, LAS unsigned char* lds, int ua, int ub, int j, float lam, float lam_init, const bf16_t* Qb, const bf16_t* Kb, const bf16_t* Vb, bf16_t* Ob) {
    constexpr bool IS_DIFF = MODE == M_DIFF_P || MODE == M_DIFF_S, IS_SWA = MODE == M_SWA_P || MODE == M_SWA_S, IS_SB = MODE == M_SB_P || MODE == M_SB_S;
    constexpr int DV = IS_DIFF ? 128 : 64, NDB = DV / 32, NKS = IS_DIFF ? 2 : (IS_SWA ? 1 : 4), NVS = IS_DIFF ? 1 : (IS_SWA ? 1 : 4), LDKV = IS_SWA ? 256 : 1024;
    constexpr int NTAB = IS_DIFF ? 2 : 4;
    const int tid = pg8::otid(), lane = tid & 63, r32 = lane & 31, hi = lane >> 5; const int wid = __builtin_amdgcn_readfirstlane(tid >> 6);
    LAS float* tab = (LAS float*)(lds + GA_TAB); LAS float* wsf = (LAS float*)(lds + GA_WSF) + wid * 64; LAS unsigned* flg = (LAS unsigned*)(lds + GA_FLG);
    bool compute = true; int qrow0 = 0, qcol = 0, tq0 = 0, kslot = 0, vslot = 0, tsel = 0, kvcol = 0, ntiles = 0, hq = 0, grp = 0;
    if (MODE == M_DIFF_P) { const int m = wid & 1; grp = wid >> 1; qrow0 = ub * 128 + grp * 32; qcol = (2 * ua + m) * 64; tq0 = qrow0; kslot = m; tsel = m; kvcol = ua * 128; ntiles = 2 * ub + 2; }
    if (MODE == M_DIFF_S) { compute = wid < 2; const int m = wid & 1; qrow0 = TP + ua * 32; qcol = (2 * ub + m) * 64; tq0 = 0; kslot = m; tsel = m; kvcol = ub * 128; ntiles = 33; }
    if (MODE == M_SWA_P)  { grp = wid >> 1; hq = ub * 4 + grp; qrow0 = ua * 64 + (wid & 1) * 32; qcol = hq * 64; tq0 = qrow0; tsel = grp; kvcol = ub * 64; ntiles = 3; }
    if (MODE == M_SWA_S)  { compute = wid < 4; grp = wid & 3; hq = ub * 4 + grp; qrow0 = TP + ua * 32; qcol = hq * 64; tq0 = 0; tsel = grp; kvcol = ub * 64; ntiles = 3; }
    if (MODE == M_SB_P)   { grp = wid >> 1; qrow0 = ua * 64 + (wid & 1) * 32; qcol = (ub * 4 + grp) * 64; tq0 = qrow0; kslot = grp; vslot = grp; kvcol = ub * 256; ntiles = ua + 1; }
    if (MODE == M_SB_S)   { compute = wid < 4; grp = wid & 3; qrow0 = TP + ua * 32; qcol = (ub * 4 + grp) * 64; tq0 = 0; kslot = grp; vslot = grp; kvcol = ub * 256; ntiles = 33; }
    __syncthreads();
    bf16x8 qr[4];
    { const bf16_t* qp = Qb + (size_t)(qrow0 + r32) * 1024 + qcol + hi * 8;
#pragma unroll
      for (int d0 = 0; d0 < 4; ++d0) qr[d0] = *(const bf16x8*)(qp + d0 * 16); }
    f32x16 o[NDB];
#pragma unroll
    for (int db = 0; db < NDB; ++db)
#pragma unroll
        for (int r = 0; r < 16; ++r) o[db][r] = 0.f;
    float l = 0.f, acc = 0.f; bool mydone = !compute;
    if (IS_SWA) l = hi == 0 ? __builtin_amdgcn_exp2f(p.in[S_SINKS][hq] * LOG2E) : 0.f;
    const int tq = tq0 + r32;
    const LAS unsigned char* kbase = lds + kslot * 8192 + hi * 1024 + r32 * 16;
    const LAS unsigned char* vbase = lds + 32768 + vslot * (DV * 128) + ((lane >> 4) & 1) * 32 + (lane & 3) * 8 + (4 * hi + ((lane & 15) >> 2)) * 64;
    struct Desc { const void *kp, *vp; bool f32, tvalid, active, far; int nvalid, pos0; };
    auto desc = [&](int it) { Desc d; d.kp = nullptr; d.vp = nullptr; d.f32 = false; d.tvalid = true; d.active = true; d.far = false; d.nvalid = 64; d.pos0 = 0;
        if (MODE == M_DIFF_P) { const size_t off = (size_t)it * 64 * 1024 + kvcol; d.kp = Kb + off; d.vp = Vb + off; d.pos0 = it * 64; d.active = it <= 2 * ub + (grp >> 1); d.far = (d.pos0 + 63 - tq0) <= -91; }
        if (MODE == M_DIFF_S) { if (it < 32) { const size_t off = ((size_t)(j * 16 + ua) * 2048 + it * 64) * 1024 + kvcol; d.kp = p.in[C_DK] + off; d.vp = p.in[C_DV] + off; d.f32 = true; d.pos0 = -2048 + it * 64; d.far = d.pos0 + 63 <= -91; }
                                else { const size_t off = (size_t)(TP + ua * 32) * 1024 + kvcol; d.kp = Kb + off; d.vp = Vb + off; d.nvalid = 32; d.pos0 = 0; } }
        if (MODE == M_SWA_P)  { const int tc = ua - 2 + it; d.tvalid = tc >= 0; const size_t off = (size_t)(tc < 0 ? 0 : tc) * 64 * 256 + kvcol; d.kp = Kb + off; d.vp = Vb + off; d.pos0 = tc * 64; }
        if (MODE == M_SWA_S)  { if (it < 2) { const size_t off = ((size_t)ua * 128 + it * 64) * 256 + kvcol; d.kp = p.in[C_WK] + off; d.vp = p.in[C_WV] + off; d.f32 = true; d.pos0 = -128 + it * 64; }
                                else { const size_t off = (size_t)(TP + ua * 32) * 256 + kvcol; d.kp = Kb + off; d.vp = Vb + off; d.nvalid = 32; d.pos0 = 0; } }
        if (MODE == M_SB_P)   { const int tc = ua - it; const size_t off = (size_t)tc * 64 * 1024 + kvcol; d.kp = Kb + off; d.vp = Vb + off; d.pos0 = tc * 64; }
        if (MODE == M_SB_S)   { if (it == 0) { const size_t off = (size_t)(TP + ua * 32) * 1024 + kvcol; d.kp = Kb + off; d.vp = Vb + off; d.nvalid = 32; d.pos0 = 0; }
                                else { const int tc = 32 - it; const size_t off = ((size_t)ua * 2048 + tc * 64) * 1024 + kvcol; d.kp = p.in[C_BK] + off; d.vp = p.in[C_BV] + off; d.f32 = true; d.pos0 = -2048 + tc * 64; } }
        return d; };
    constexpr int NVP = NVS * (DV / 64);
    RawPiece rk[NKS], rv[NVP];
    const int kkey = (tid & 7) + 8 * (tid >> 6), kchunk = (tid >> 3) & 7, vkey = (tid >> 2) & 63, vpl = tid & 3, vdb = tid >> 8;
#define GA_LOAD(d) do { if ((d).tvalid) { \
        _Pragma("unroll") for (int s_ = 0; s_ < NKS; ++s_) rk[s_] = ld_piece((d).kp, (d).f32, (size_t)kkey * LDKV + s_ * 64 + kchunk * 8, kkey < (d).nvalid); \
        _Pragma("unroll") for (int s_ = 0; s_ < NVS; ++s_) _Pragma("unroll") for (int ps_ = 0; ps_ < DV / 64; ++ps_) \
            rv[s_ * (DV / 64) + ps_] = ld_piece((d).vp, (d).f32, (size_t)vkey * LDKV + s_ * DV + (vdb + 2 * ps_) * 32 + vpl * 8, vkey < (d).nvalid); } } while (0)
#define GA_STORE(d) do { if ((d).tvalid) { \
        _Pragma("unroll") for (int s_ = 0; s_ < NKS; ++s_) *(LAS u32x4*)(lds + s_ * 8192 + kchunk * 1024 + kkey * 16) = cv_piece(rk[s_], (d).f32); \
        _Pragma("unroll") for (int s_ = 0; s_ < NVS; ++s_) _Pragma("unroll") for (int ps_ = 0; ps_ < DV / 64; ++ps_) \
            *(LAS u32x4*)(lds + 32768 + s_ * (DV * 128) + (vdb + 2 * ps_) * 4096 + vkey * 64 + vpl * 16) = cv_piece(rv[s_ * (DV / 64) + ps_], (d).f32); } } while (0)
    { const Desc d0 = desc(0); GA_LOAD(d0); }
    if (!IS_SB) {
        for (int idx = tid; idx < NTAB * 155; idx += NWAVES * 64) { const int ti = idx / 155, i = idx % 155;
            const int head = IS_DIFF ? 2 * (MODE == M_DIFF_P ? ua : ub) + ti : ub * 4 + ti;
            float v = p.in[REL_BIAS][t5_bucket(i - 91) * 16 + head];
            if (IS_DIFF) v -= p.in[REL_BIAS][15 * 16 + head];
            tab[ti * 160 + i] = v * LOG2E; }
    }
    for (int it = 0; it < ntiles; ++it) {
        const Desc d = desc(it);
        const bool f32 = d.f32, tvalid = d.tvalid, active = d.active, far = d.far; const int nvalid = d.nvalid, pos0 = d.pos0; (void)f32;
        GA_STORE(d);
        __syncthreads();
        if (it + 1 < ntiles) { const Desc dn = desc(it + 1); GA_LOAD(dn); }
        if (tvalid && compute && active && !mydone) {
            f32x16 p0, p1;
#pragma unroll
            for (int r = 0; r < 16; ++r) { p0[r] = 0.f; p1[r] = 0.f; }
#pragma unroll
            for (int d0 = 0; d0 < 4; ++d0) { const bf16x8 b0 = *(const LAS bf16x8*)(kbase + d0 * 2048), b1 = *(const LAS bf16x8*)(kbase + d0 * 2048 + 512);
                p0 = MFMA32(b0, qr[d0], p0); p1 = MFMA32(b1, qr[d0], p1); }
            if (!IS_SB) {
                const LAS float* tb = tab + tsel * 160; const int relb = pos0 - tq + 91; float ls = 0.f;
#pragma unroll
                for (int r = 0; r < 16; ++r) { const int kv = crow(r, hi); float s0 = p0[r], s1 = p1[r];
                    if (!far) { int i0 = relb + kv, i1 = i0 + 32; i0 = i0 < 0 ? 0 : (i0 > 154 ? 154 : i0); i1 = i1 < 0 ? 0 : (i1 > 154 ? 154 : i1); s0 += tb[i0]; s1 += tb[i1]; }
                    float e0 = __builtin_amdgcn_exp2f(s0), e1 = __builtin_amdgcn_exp2f(s1);
                    if (kv >= nvalid) e0 = 0.f; if (kv + 32 >= nvalid) e1 = 0.f;
                    p0[r] = e0; p1[r] = e1; ls += e0 + e1; }
                l += ls;
            } else {
                float L0[16], L1[16];
#pragma unroll
                for (int r = 0; r < 16; ++r) { const int kv = crow(r, hi);
                    if (!(kv < nvalid && pos0 + kv < tq)) p0[r] = -INFINITY;
                    if (!(kv + 32 < nvalid && pos0 + kv + 32 < tq)) p1[r] = -INFINITY;
                    L0[r] = __builtin_amdgcn_logf(1.f + __builtin_amdgcn_exp2f(p0[r])); L1[r] = __builtin_amdgcn_logf(1.f + __builtin_amdgcn_exp2f(p1[r])); }
                float gs[8], go[8];
#pragma unroll
                for (int g = 0; g < 4; ++g) { gs[g] = (L0[4 * g] + L0[4 * g + 1]) + (L0[4 * g + 2] + L0[4 * g + 3]); gs[4 + g] = (L1[4 * g] + L1[4 * g + 1]) + (L1[4 * g + 2] + L1[4 * g + 3]); }
#pragma unroll
                for (int g = 0; g < 8; ++g) go[g] = __shfl_xor(gs[g], 32);
                float after = 0.f;
#pragma unroll
                for (int g = 7; g >= 0; --g) {
                    float run = after + (hi == 0 ? go[g] : 0.f);
#pragma unroll
                    for (int i = 3; i >= 0; --i) { const int r = 4 * (g & 3) + i;
                        if (g < 4) { const float Lr = L0[r]; p0[r] = __builtin_amdgcn_exp2f(p0[r] - Lr + acc - run); run += Lr; }
                        else       { const float Lr = L1[r]; p1[r] = __builtin_amdgcn_exp2f(p1[r] - Lr + acc - run); run += Lr; } }
                    after += gs[g] + go[g];
                }
                acc -= after;
                mydone = __all(acc < -152.f);
            }
            u32x4 pw[4];
            pw[0] = (u32x4){cvtpk(p0[0], p0[1]), cvtpk(p0[2], p0[3]), cvtpk(p0[4], p0[5]), cvtpk(p0[6], p0[7])};
            pw[1] = (u32x4){cvtpk(p0[8], p0[9]), cvtpk(p0[10], p0[11]), cvtpk(p0[12], p0[13]), cvtpk(p0[14], p0[15])};
            pw[2] = (u32x4){cvtpk(p1[0], p1[1]), cvtpk(p1[2], p1[3]), cvtpk(p1[4], p1[5]), cvtpk(p1[6], p1[7])};
            pw[3] = (u32x4){cvtpk(p1[8], p1[9]), cvtpk(p1[10], p1[11]), cvtpk(p1[12], p1[13]), cvtpk(p1[14], p1[15])};
#pragma unroll
            for (int db = 0; db < NDB; ++db)
#pragma unroll
                for (int ks = 0; ks < 4; ++ks) { const s16x4 lo = vtr(vbase + db * 4096 + ks * 1024), hh = vtr(vbase + db * 4096 + ks * 1024 + 512);
                    const bf16x8 vf = (bf16x8){lo[0], lo[1], lo[2], lo[3], hh[0], hh[1], hh[2], hh[3]};
                    o[db] = MFMA32(__builtin_bit_cast(bf16x8, pw[ks]), vf, o[db]); }
        }
        if (IS_SB) { if (lane == 0) flg[wid] = mydone ? 1u : 0u; }
        __syncthreads();
        if (IS_SB) { unsigned all = 1u;
#pragma unroll
            for (int w = 0; w < NWAVES; ++w) all &= flg[w];
            if (all) break; }
    }
#undef GA_LOAD
#undef GA_STORE
    LAS float* st = (LAS float*)(lds + wid * (32 * DV * 4));
    if (compute) {
        float rinv[16];
        if (!IS_SB) { const float lt = l + __shfl_xor(l, 32); if (hi == 0) wsf[r32] = lt;
            asm volatile("s_waitcnt lgkmcnt(0)" ::: "memory");
#pragma unroll
            for (int r = 0; r < 16; ++r) rinv[r] = 1.f / wsf[crow(r, hi)]; }
        else {
#pragma unroll
            for (int r = 0; r < 16; ++r) rinv[r] = 1.f; }
#pragma unroll
        for (int db = 0; db < NDB; ++db)
#pragma unroll
            for (int r = 0; r < 16; ++r) st[crow(r, hi) * DV + 32 * db + r32] = o[db][r] * rinv[r];
    }
    __syncthreads();
    if (compute) {
        if (IS_DIFF) {
            const int pair = wid >> 1, row = 16 * (wid & 1) + (lane >> 2), qd = lane & 3;
            const LAS float* s0 = (const LAS float*)(lds + (2 * pair) * 16384) + row * 128 + qd * 32; const LAS float* s1 = s0 + 4096;
            const int head = MODE == M_DIFF_P ? ua : ub; const size_t orow = MODE == M_DIFF_P ? (size_t)ub * 128 + pair * 32 + row : (size_t)TP + ua * 32 + row;
            float x[32]; float ss = 0.f;
#pragma unroll
            for (int e = 0; e < 32; ++e) { x[e] = s0[e] - lam * s1[e]; ss += x[e] * x[e]; }
            ss += __shfl_xor(ss, 1); ss += __shfl_xor(ss, 2);
            const float rs = rsqrtf(ss * (1.f / 128.f) + 1e-6f) * (1.f - lam_init);
            const float* sg = p.in[D_SUBLN] + j * 128 + qd * 32; bf16_t* op = Ob + orow * 1024 + head * 128 + qd * 32;
#pragma unroll
            for (int c = 0; c < 4; ++c) { u32x4 w;
                w.x = cvtpk(x[8 * c] * rs * sg[8 * c], x[8 * c + 1] * rs * sg[8 * c + 1]); w.y = cvtpk(x[8 * c + 2] * rs * sg[8 * c + 2], x[8 * c + 3] * rs * sg[8 * c + 3]);
                w.z = cvtpk(x[8 * c + 4] * rs * sg[8 * c + 4], x[8 * c + 5] * rs * sg[8 * c + 5]); w.w = cvtpk(x[8 * c + 6] * rs * sg[8 * c + 6], x[8 * c + 7] * rs * sg[8 * c + 7]);
                *(u32x4*)(op + 8 * c) = w; }
        } else {
            const int row = lane >> 1, hf = lane & 1; const LAS float* s0 = st + row * 64 + hf * 32; bf16_t* op = Ob + (size_t)(qrow0 + row) * 1024 + qcol + hf * 32;
#pragma unroll
            for (int c = 0; c < 4; ++c) { u32x4 w; w.x = cvtpk(s0[8 * c], s0[8 * c + 1]); w.y = cvtpk(s0[8 * c + 2], s0[8 * c + 3]); w.z = cvtpk(s0[8 * c + 4], s0[8 * c + 5]); w.w = cvtpk(s0[8 * c + 6], s0[8 * c + 7]);
                *(u32x4*)(op + 8 * c) = w; }
        }
    }
}
__device__ __forceinline__ void glds16(const void* gsrc, unsigned lds_dst) {
    unsigned keep;
    asm volatile("s_mov_b32 %0, m0\n\ts_mov_b32 m0, %2\n\ts_nop 0\n\tglobal_load_lds_dwordx4 %1, off\n\ts_mov_b32 m0, %0" : "=&s"(keep) : "v"(gsrc), "s"(lds_dst) : "memory");
}
#define DP_WAIT_BAR(N) asm volatile("s_waitcnt vmcnt(" #N ") lgkmcnt(0)\n\ts_barrier" ::: "memory")
__device__ __forceinline__ void attn_diff_p2(const Params& p, LAS unsigned char* lds, int h, int qb, int j, float lam, float lam_init, const bf16_t* Qb, const bf16_t* Kb, const bf16_t* Vb, bf16_t* Ob) {
    const int tid = pg8::otid(), lane = tid & 63, r32 = lane & 31, hi = lane >> 5; const int wid = __builtin_amdgcn_readfirstlane(tid >> 6);
    const int m = wid & 1, grp = wid >> 1, qrow0 = qb * 128 + grp * 32, NT = 2 * qb + 2, tlast = 2 * qb + (grp >> 1);
    LAS float* tab = (LAS float*)(lds + GA_TAB); LAS float* wsf = (LAS float*)(lds + GA_WSF) + wid * 64;
    __syncthreads();
    for (int idx = tid; idx < 2 * 155; idx += NWAVES * 64) { const int ti = idx / 155, i = idx % 155; const int head = 2 * h + ti;
        tab[ti * 160 + i] = (p.in[REL_BIAS][t5_bucket(i - 91) * 16 + head] - p.in[REL_BIAS][15 * 16 + head]) * LOG2E; }
    const unsigned lds0 = (unsigned)(uintptr_t)lds;
    const bf16_t* ksrc = Kb + (size_t)lane * 1024 + h * 128 + wid * 8;
    const bf16_t* vsrc = Vb + (size_t)(16 * (wid & 3) + (lane >> 2)) * 1024 + h * 128 + (wid >> 2) * 32 + (lane & 3) * 8;
    const unsigned kdst = lds0 + wid * 1024, vdst = lds0 + 49152 + (wid >> 2) * 4096 + (wid & 3) * 1024;
#define DP_DMA(t, kslot_, vslot_) do { const bf16_t* ks_ = ksrc + (size_t)(t) * 65536; const bf16_t* vs_ = vsrc + (size_t)(t) * 65536; const unsigned ko_ = (unsigned)(kslot_) * 16384u, vo_ = (unsigned)(vslot_) * 16384u; \
        glds16(ks_, (unsigned)__builtin_amdgcn_readfirstlane(kdst + ko_)); glds16(ks_ + 64, (unsigned)__builtin_amdgcn_readfirstlane(kdst + ko_ + 8192u)); \
        glds16(vs_, (unsigned)__builtin_amdgcn_readfirstlane(vdst + vo_)); glds16(vs_ + 64, (unsigned)__builtin_amdgcn_readfirstlane(vdst + vo_ + 8192u)); } while (0)
    DP_DMA(0, 0, 0); DP_DMA(1, 1, 1);
    bf16x8 qr[4];
    { const bf16_t* qp = Qb + (size_t)(qrow0 + r32) * 1024 + (2 * h + m) * 64 + hi * 8;
#pragma unroll
      for (int d0 = 0; d0 < 4; ++d0) qr[d0] = *(const bf16x8*)(qp + d0 * 16); }
    asm volatile("" : "+v"(qr[0]), "+v"(qr[1]), "+v"(qr[2]), "+v"(qr[3]));
    f32x16 o[4];
#pragma unroll
    for (int db = 0; db < 4; ++db)
#pragma unroll
        for (int r = 0; r < 16; ++r) o[db][r] = 0.f;
    float l = 0.f;
    const int tq = qrow0 + r32;
    const LAS unsigned char* kb0 = lds + (8 * m + hi) * 1024 + r32 * 16;
    const LAS unsigned char* vb0 = lds + 49152 + ((lane >> 4) & 1) * 32 + (lane & 3) * 8 + (4 * hi + ((lane & 15) >> 2)) * 64;
    const LAS float* tb = tab + m * 160;
#ifndef DP_STAGGER
#define DP_STAGGER 0
#endif
    const bool late = DP_STAGGER && wid >= 4;
    u32x4 pwp[4];
#pragma unroll
    for (int i = 0; i < 4; ++i) pwp[i] = (u32x4){0u, 0u, 0u, 0u};
#define DP_PV(PW, vslot) do { const LAS unsigned char* vb = vb0 + (vslot) * 16384; s16x4 vl[2][4], vh[2][4]; \
        _Pragma("unroll") for (int ks = 0; ks < 4; ++ks) { vl[0][ks] = vtr(vb + ks * 1024); vh[0][ks] = vtr(vb + ks * 1024 + 512); } \
        _Pragma("unroll") for (int db = 0; db < 4; ++db) { \
            if (db < 3) { _Pragma("unroll") for (int ks = 0; ks < 4; ++ks) { vl[(db + 1) & 1][ks] = vtr(vb + (db + 1) * 4096 + ks * 1024); vh[(db + 1) & 1][ks] = vtr(vb + (db + 1) * 4096 + ks * 1024 + 512); } } \
            __builtin_amdgcn_sched_barrier(0); \
            _Pragma("unroll") for (int ks = 0; ks < 4; ++ks) { const s16x4 lo = vl[db & 1][ks], hh = vh[db & 1][ks]; \
                const bf16x8 vf = (bf16x8){lo[0], lo[1], lo[2], lo[3], hh[0], hh[1], hh[2], hh[3]}; \
                o[db] = MFMA32(__builtin_bit_cast(bf16x8, PW[ks]), vf, o[db]); } \
            __builtin_amdgcn_sched_barrier(0); } } while (0)
    int kslot = 0, kslot2 = 2, vslot = 0, vslot2 = 2, vprev = 3;
    for (int t = 0; t < NT; ++t) {
        if (t + 1 < NT) DP_WAIT_BAR(4); else DP_WAIT_BAR(0);
        if (t + 2 < NT) DP_DMA(t + 2, kslot2, vslot2);
        if (late && t >= 1) DP_PV(pwp, vprev);
        if (t <= tlast) {
            const LAS unsigned char* kb = kb0 + kslot * 16384;
            f32x16 p0, p1;
#pragma unroll
            for (int r = 0; r < 16; ++r) { p0[r] = 0.f; p1[r] = 0.f; }
            bf16x8 kf[8];
#pragma unroll
            for (int d0 = 0; d0 < 4; ++d0) { kf[2 * d0] = *(const LAS bf16x8*)(kb + d0 * 2048); kf[2 * d0 + 1] = *(const LAS bf16x8*)(kb + d0 * 2048 + 512); }
            __builtin_amdgcn_sched_barrier(0);
#pragma unroll
            for (int d0 = 0; d0 < 4; ++d0) { p0 = MFMA32(kf[2 * d0], qr[d0], p0); p1 = MFMA32(kf[2 * d0 + 1], qr[d0], p1); }
            const int pos0 = t * 64;
            if (pos0 + 63 - qrow0 > -91) {
                const int relb = pos0 - tq + 91;
#pragma unroll
                for (int r = 0; r < 16; ++r) { const int kv = crow(r, hi); int i0 = relb + kv, i1 = i0 + 32; i0 = i0 < 0 ? 0 : (i0 > 154 ? 154 : i0); i1 = i1 < 0 ? 0 : (i1 > 154 ? 154 : i1);
                    p0[r] += tb[i0]; p1[r] += tb[i1]; }
            }
            float ls = 0.f;
#pragma unroll
            for (int r = 0; r < 16; ++r) { p0[r] = __builtin_amdgcn_exp2f(p0[r]); p1[r] = __builtin_amdgcn_exp2f(p1[r]); ls += p0[r] + p1[r]; }
            l += ls;
            u32x4 pw[4];
            pw[0] = (u32x4){cvtpk(p0[0], p0[1]), cvtpk(p0[2], p0[3]), cvtpk(p0[4], p0[5]), cvtpk(p0[6], p0[7])};
            pw[1] = (u32x4){cvtpk(p0[8], p0[9]), cvtpk(p0[10], p0[11]), cvtpk(p0[12], p0[13]), cvtpk(p0[14], p0[15])};
            pw[2] = (u32x4){cvtpk(p1[0], p1[1]), cvtpk(p1[2], p1[3]), cvtpk(p1[4], p1[5]), cvtpk(p1[6], p1[7])};
            pw[3] = (u32x4){cvtpk(p1[8], p1[9]), cvtpk(p1[10], p1[11]), cvtpk(p1[12], p1[13]), cvtpk(p1[14], p1[15])};
            if (!late) DP_PV(pw, vslot);
            else {
#pragma unroll
                for (int i = 0; i < 4; ++i) pwp[i] = pw[i]; }
        }
        kslot = kslot == 2 ? 0 : kslot + 1; kslot2 = kslot2 == 2 ? 0 : kslot2 + 1;
        vprev = vslot; vslot = (vslot + 1) & 3; vslot2 = (vslot2 + 1) & 3;
    }
    if (late) DP_PV(pwp, vprev);
#undef DP_PV
#undef DP_DMA
    __syncthreads();
    { LAS float* st = (LAS float*)(lds + wid * 16384);
      const float lt = l + __shfl_xor(l, 32); if (hi == 0) wsf[r32] = lt;
      asm volatile("s_waitcnt lgkmcnt(0)" ::: "memory");
      float rinv[16];
#pragma unroll
      for (int r = 0; r < 16; ++r) rinv[r] = 1.f / wsf[crow(r, hi)];
#pragma unroll
      for (int db = 0; db < 4; ++db)
#pragma unroll
          for (int r = 0; r < 16; ++r) st[crow(r, hi) * 128 + 32 * db + r32] = o[db][r] * rinv[r]; }
    __syncthreads();
    { const int row = 16 * m + (lane >> 2), qd = lane & 3;
      const LAS float* s0 = (const LAS float*)(lds + (2 * grp) * 16384) + row * 128 + qd * 32; const LAS float* s1 = s0 + 4096;
      float x[32]; float ss = 0.f;
#pragma unroll
      for (int e = 0; e < 32; ++e) { x[e] = s0[e] - lam * s1[e]; ss += x[e] * x[e]; }
      ss += __shfl_xor(ss, 1); ss += __shfl_xor(ss, 2);
      const float rs = rsqrtf(ss * (1.f / 128.f) + 1e-6f) * (1.f - lam_init);
      const float* sg = p.in[D_SUBLN] + j * 128 + qd * 32; bf16_t* op = Ob + ((size_t)qb * 128 + grp * 32 + row) * 1024 + h * 128 + qd * 32;
#pragma unroll
      for (int c = 0; c < 4; ++c) { u32x4 w;
          w.x = cvtpk(x[8 * c] * rs * sg[8 * c], x[8 * c + 1] * rs * sg[8 * c + 1]); w.y = cvtpk(x[8 * c + 2] * rs * sg[8 * c + 2], x[8 * c + 3] * rs * sg[8 * c + 3]);
          w.z = cvtpk(x[8 * c + 4] * rs * sg[8 * c + 4], x[8 * c + 5] * rs * sg[8 * c + 5]); w.w = cvtpk(x[8 * c + 6] * rs * sg[8 * c + 6], x[8 * c + 7] * rs * sg[8 * c + 7]);
          *(u32x4*)(op + 8 * c) = w; } }
}
#define P3_SBAR() __builtin_amdgcn_sched_barrier(0)
#define P3_PIN(x) asm volatile("" : "+v"(x))
#define P3_WAIT_BAR(N) asm volatile("s_waitcnt vmcnt(" #N ") lgkmcnt(0)\n\ts_barrier" ::: "memory")
__device__ __forceinline__ void attn_diff_p3(const Params& p, LAS unsigned char* lds, int h, int qb, int j, float lam, float lam_init, const bf16_t* Qb, const bf16_t* Kb, const bf16_t* Vb, bf16_t* Ob) {
    const int tid = pg8::otid(), lane = tid & 63, r32 = lane & 31, hi = lane >> 5; const int wid = __builtin_amdgcn_readfirstlane(tid >> 6);
    const int m = wid & 1, grp = wid >> 1, qrow0 = qb * 128 + grp * 32, NT = 2 * qb + 2; const bool early = grp < 2;
    LAS float* tab = (LAS float*)(lds + GA_TAB); LAS float* wsf = (LAS float*)(lds + GA_WSF) + wid * 64;
    __syncthreads();
    const unsigned lds0 = (unsigned)(uintptr_t)lds;
    const bf16_t* ksrc = Kb + (size_t)(16 * (wid & 3) + (lane & 15)) * 1024 + h * 128 + (wid >> 2) * 32 + (lane >> 4) * 8;
    const bf16_t* vsrc = Vb + (size_t)(16 * (wid & 3) + (lane >> 2)) * 1024 + h * 128 + (wid >> 2) * 32 + (lane & 3) * 8;
    const unsigned kdst = lds0 + (wid & 3) * 4096 + (wid >> 2) * 1024, vdst = lds0 + 49152 + (wid >> 2) * 4096 + (wid & 3) * 1024;
#define DMA_K(t, sl) do { const bf16_t* s_ = ksrc + (size_t)(t) * 65536; glds16(s_, (unsigned)__builtin_amdgcn_readfirstlane(kdst + (unsigned)(sl))); glds16(s_ + 64, (unsigned)__builtin_amdgcn_readfirstlane(kdst + (unsigned)(sl) + 2048u)); } while (0)
#define DMA_V(t, sl) do { const bf16_t* s_ = vsrc + (size_t)(t) * 65536; glds16(s_, (unsigned)__builtin_amdgcn_readfirstlane(vdst + (unsigned)(sl))); glds16(s_ + 64, (unsigned)__builtin_amdgcn_readfirstlane(vdst + (unsigned)(sl) + 8192u)); } while (0)
    constexpr int SL = 16384;
    DMA_K(0, 0); DMA_V(0, 0); DMA_K(1, SL);
    bf16x8 qr[4];
    { const bf16_t* qp = Qb + (size_t)(qrow0 + r32) * 1024 + (2 * h + m) * 64 + hi * 8;
#pragma unroll
      for (int d0 = 0; d0 < 4; ++d0) qr[d0] = *(const bf16x8*)(qp + d0 * 16); }
    for (int idx = tid; idx < 2 * 155; idx += NWAVES * 64) { const int ti = idx / 155, i = idx % 155; const int head = 2 * h + ti;
        tab[ti * 160 + i] = (p.in[REL_BIAS][t5_bucket(i - 91) * 16 + head] - p.in[REL_BIAS][15 * 16 + head]) * LOG2E; }
    asm volatile("" : "+v"(qr[0]), "+v"(qr[1]), "+v"(qr[2]), "+v"(qr[3]));
    DMA_K(2, 2 * SL);
    f32x16 o[4];
#pragma unroll
    for (int db = 0; db < 4; ++db)
#pragma unroll
        for (int r = 0; r < 16; ++r) o[db][r] = 0.f;
    float l_reg = 0.f;
    const int tq = qrow0 + r32;
    const LAS unsigned char* kp0 = lds + (r32 >> 4) * 4096 + (8 * m + hi) * 256 + (r32 & 15) * 16;
    const LAS unsigned char* vp0 = lds + 49152 + ((lane >> 4) & 1) * 32 + (lane & 3) * 8 + (4 * hi + ((lane & 15) >> 2)) * 64;
    const LAS float* tb = tab + m * 160;
    const f32x16 zero16 = {0.f, 0.f, 0.f, 0.f, 0.f, 0.f, 0.f, 0.f, 0.f, 0.f, 0.f, 0.f, 0.f, 0.f, 0.f, 0.f};
    bf16x8 kf[8];
#define KLOAD2(kp, jj) do { kf[2 * (jj)] = *(const LAS bf16x8*)((kp) + (jj) * 512); kf[2 * (jj) + 1] = *(const LAS bf16x8*)((kp) + (jj) * 512 + 8192); } while (0)
#define BAND(C0, C1, t) do { const int relb_ = (t) * 64 - tq + 91; const bool dead_ = early && (t) == NT - 1; \
        _Pragma("unroll") for (int r = 0; r < 16; ++r) { const int kv_ = crow(r, hi); int i0_ = relb_ + kv_, i1_ = i0_ + 32; i0_ = i0_ < 0 ? 0 : (i0_ > 154 ? 154 : i0_); i1_ = i1_ < 0 ? 0 : (i1_ > 154 ? 154 : i1_); \
            C0[r] += tb[i0_]; C1[r] += tb[i1_]; if (dead_) { C0[r] = -INFINITY; C1[r] = -INFINITY; } } } while (0)
    f32x16 pA0, pA1, pB0, pB1;
    int sl_prev = 0, sl_cur = 0, sl_next = SL;
#define ROT() do { sl_prev = sl_cur; sl_cur = sl_next; sl_next = (sl_next == 2 * SL) ? 0 : sl_next + SL; } while (0)
    P3_WAIT_BAR(6);
    { const LAS unsigned char* kp = kp0;
#pragma unroll
      for (int jj = 0; jj < 4; ++jj) KLOAD2(kp, jj);
      pA0 = MFMA32(kf[0], qr[0], zero16); pA1 = MFMA32(kf[1], qr[0], zero16);
#pragma unroll
      for (int d0 = 1; d0 < 4; ++d0) { pA0 = MFMA32(kf[2 * d0], qr[d0], pA0); pA1 = MFMA32(kf[2 * d0 + 1], qr[d0], pA1); }
      if (NT <= 4) BAND(pA0, pA1, 0);
#pragma unroll
      for (int r = 0; r < 16; ++r) { pA0[r] = __builtin_amdgcn_exp2f(pA0[r]); pA1[r] = __builtin_amdgcn_exp2f(pA1[r]); } }
    P3_WAIT_BAR(2);
    DMA_K(3, 0); DMA_V(1, SL);
    ROT();
#pragma unroll
    for (int jj = 0; jj < 4; ++jj) KLOAD2(kp0 + sl_cur, jj);
    P3_WAIT_BAR(4);
    s16x4 vlo[4], vhi[4]; u32x4 pw0, pw1, pw2, pw3;
#define PKW(P, B) cvtpk(P[B], P[B + 1])
#define PAF(k) __builtin_bit_cast(bf16x8, pw##k)
#define VFR(i) (bf16x8){vlo[i][0], vlo[i][1], vlo[i][2], vlo[i][3], vhi[i][0], vhi[i][1], vhi[i][2], vhi[i][3]}
#define EX(v) __builtin_amdgcn_exp2f(v)
#define VRD(f) do { vlo[(f) & 3] = vtr(vp_ + (((f) & 3) * 4096 + ((f) >> 2) * 1024)); vhi[(f) & 3] = vtr(vp_ + (((f) & 3) * 4096 + ((f) >> 2) * 1024 + 512)); } while (0)
#define GAPA(MF, A0, A1, A2, A3, W0, W1, PW) do { MF; sacc += A0; sacc += A1; sacc += A2; sacc += A3; P3_PIN(sacc); W0; W1; P3_PIN(PW); P3_SBAR(); } while (0)
#define GAPB(f, PWK, X, B) do { o[(f) & 3] = MFMA32(PWK, VFR((f) & 3), o[(f) & 3]); X[B] = EX(X[B]); X[B + 1] = EX(X[B + 1]); P3_PIN(X); P3_SBAR(); } while (0)
#define KRD(G, jj) do { if (G) { KLOAD2(kp0 + sl_next, jj); P3_SBAR(); } } while (0)
#define STEP(C0, C1, P0, P1, t, GK, GV, GL, BANDED) do { P3_SBAR(); \
    const LAS unsigned char* vp_ = vp0 + sl_prev; \
    VRD(0); P3_SBAR(); float sacc = (P0[0] + P0[1]); \
    GAPA(C0 = MFMA32(kf[0], qr[0], zero16), P0[2], P0[3], P0[4], P0[5],     pw0[0] = PKW(P0, 0), pw0[1] = PKW(P0, 2), pw0); \
    VRD(1); P3_SBAR(); GAPA(C1 = MFMA32(kf[1], qr[0], zero16), P0[6], P0[7], P0[8], P0[9],     pw0[2] = PKW(P0, 4), pw0[3] = PKW(P0, 6), pw0); \
    VRD(2); P3_SBAR(); GAPA(C0 = MFMA32(kf[2], qr[1], C0),     P0[10], P0[11], P0[12], P0[13], pw1[0] = PKW(P0, 8), pw1[1] = PKW(P0, 10), pw1); \
    VRD(3); P3_SBAR(); GAPA(C1 = MFMA32(kf[3], qr[1], C1),     P0[14], P0[15], P1[0], P1[1],   pw1[2] = PKW(P0, 12), pw1[3] = PKW(P0, 14), pw1); \
    GAPA(C0 = MFMA32(kf[4], qr[2], C0),     P1[2], P1[3], P1[4], P1[5],     pw2[0] = PKW(P1, 0), pw2[1] = PKW(P1, 2), pw2); \
    GAPA(C1 = MFMA32(kf[5], qr[2], C1),     P1[6], P1[7], P1[8], P1[9],     pw2[2] = PKW(P1, 4), pw2[3] = PKW(P1, 6), pw2); \
    GAPA(C0 = MFMA32(kf[6], qr[3], C0),     P1[10], P1[11], P1[12], P1[13], pw3[0] = PKW(P1, 8), pw3[1] = PKW(P1, 10), pw3); \
    GAPA(C1 = MFMA32(kf[7], qr[3], C1),     P1[14], P1[15], 0.f, 0.f,       pw3[2] = PKW(P1, 12), pw3[3] = PKW(P1, 14), pw3); \
    l_reg += sacc; \
    if (GK) { DMA_K((t) + 3, sl_cur); } if (GV) { DMA_V((t) + 1, sl_next); } \
    if (BANDED) { BAND(C0, C1, t); } \
    P3_SBAR(); \
    GAPB(0, PAF(0), C0, 0);   VRD(4);  P3_SBAR(); \
    GAPB(1, PAF(0), C0, 2);   VRD(5);  P3_SBAR(); \
    GAPB(2, PAF(0), C0, 4);   VRD(6);  P3_SBAR(); \
    KRD(GL, 0); GAPB(3, PAF(0), C0, 6);   VRD(7);  P3_SBAR(); \
    GAPB(4, PAF(1), C0, 8);   VRD(8);  P3_SBAR(); \
    KRD(GL, 1); GAPB(5, PAF(1), C0, 10);  VRD(9);  P3_SBAR(); \
    GAPB(6, PAF(1), C0, 12);  VRD(10); P3_SBAR(); \
    KRD(GL, 2); GAPB(7, PAF(1), C0, 14);  VRD(11); P3_SBAR(); \
    GAPB(8, PAF(2), C1, 0);   VRD(12); P3_SBAR(); \
    KRD(GL, 3); GAPB(9, PAF(2), C1, 2);   VRD(13); P3_SBAR(); \
    GAPB(10, PAF(2), C1, 4);  VRD(14); P3_SBAR(); \
    GAPB(11, PAF(2), C1, 6);  VRD(15); P3_SBAR(); \
    GAPB(12, PAF(3), C1, 8); \
    GAPB(13, PAF(3), C1, 10); \
    GAPB(14, PAF(3), C1, 12); \
    GAPB(15, PAF(3), C1, 14); \
    } while (0)
    int t = 1;
    for (; t + 5 < NT; t += 2) {
        STEP(pB0, pB1, pA0, pA1, t, true, true, true, false);     P3_WAIT_BAR(4); ROT();
        STEP(pA0, pA1, pB0, pB1, t + 1, true, true, true, false); P3_WAIT_BAR(4); ROT();
    }
#define ENDW(tt) do { if ((tt) + 3 < NT) { P3_WAIT_BAR(4); } else if ((tt) + 2 < NT) { P3_WAIT_BAR(2); } else { P3_WAIT_BAR(0); } } while (0)
    for (; t + 1 < NT; t += 2) {
        STEP(pB0, pB1, pA0, pA1, t, (t + 3 < NT), (t + 1 < NT), (t + 1 < NT), true);         ENDW(t);     ROT();
        STEP(pA0, pA1, pB0, pB1, t + 1, (t + 4 < NT), (t + 2 < NT), (t + 2 < NT), true);     ENDW(t + 1); ROT();
    }
    STEP(pB0, pB1, pA0, pA1, NT - 1, false, false, false, true);
    if (NT == 2) P3_WAIT_BAR(0);
    { float sacc = pB0[0] + pB0[1];
#pragma unroll
      for (int r = 2; r < 16; ++r) sacc += pB0[r];
#pragma unroll
      for (int r = 0; r < 16; ++r) sacc += pB1[r];
      l_reg += sacc;
      pw0 = (u32x4){PKW(pB0, 0), PKW(pB0, 2), PKW(pB0, 4), PKW(pB0, 6)}; pw1 = (u32x4){PKW(pB0, 8), PKW(pB0, 10), PKW(pB0, 12), PKW(pB0, 14)};
      pw2 = (u32x4){PKW(pB1, 0), PKW(pB1, 2), PKW(pB1, 4), PKW(pB1, 6)}; pw3 = (u32x4){PKW(pB1, 8), PKW(pB1, 10), PKW(pB1, 12), PKW(pB1, 14)};
      const LAS unsigned char* vp_ = vp0 + sl_cur;
#pragma unroll
      for (int f = 0; f < 16; ++f) { const s16x4 lo = vtr(vp_ + ((f & 3) * 4096 + (f >> 2) * 1024)), hh = vtr(vp_ + ((f & 3) * 4096 + (f >> 2) * 1024 + 512));
          const bf16x8 vf = (bf16x8){lo[0], lo[1], lo[2], lo[3], hh[0], hh[1], hh[2], hh[3]};
          const u32x4 pk = (f >> 2) == 0 ? pw0 : ((f >> 2) == 1 ? pw1 : ((f >> 2) == 2 ? pw2 : pw3));
          o[f & 3] = MFMA32(__builtin_bit_cast(bf16x8, pk), vf, o[f & 3]); } }
#undef DMA_K
#undef DMA_V
#undef KLOAD2
#undef BAND
#undef ROT
#undef PKW
#undef PAF
#undef VFR
#undef EX
#undef VRD
#undef GAPA
#undef GAPB
#undef KRD
#undef STEP
#undef ENDW
    __syncthreads();
    { LAS float* st = (LAS float*)(lds + wid * 16384);
      const float lt = l_reg + __shfl_xor(l_reg, 32); if (hi == 0) wsf[r32] = lt;
      asm volatile("s_waitcnt lgkmcnt(0)" ::: "memory");
      float rinv[16];
#pragma unroll
      for (int r = 0; r < 16; ++r) rinv[r] = 1.f / wsf[crow(r, hi)];
#pragma unroll
      for (int db = 0; db < 4; ++db)
#pragma unroll
          for (int r = 0; r < 16; ++r) st[crow(r, hi) * 128 + 32 * db + r32] = o[db][r] * rinv[r]; }
    __syncthreads();
    { const int row = 16 * m + (lane >> 2), qd = lane & 3;
      const LAS float* s0 = (const LAS float*)(lds + (2 * grp) * 16384) + row * 128 + qd * 32; const LAS float* s1 = s0 + 4096;
      float x[32]; float ss = 0.f;
#pragma unroll
      for (int e = 0; e < 32; ++e) { x[e] = s0[e] - lam * s1[e]; ss += x[e] * x[e]; }
      ss += __shfl_xor(ss, 1); ss += __shfl_xor(ss, 2);
      const float rs = rsqrtf(ss * (1.f / 128.f) + 1e-6f) * (1.f - lam_init);
      const float* sg = p.in[D_SUBLN] + j * 128 + qd * 32; bf16_t* op = Ob + ((size_t)qb * 128 + grp * 32 + row) * 1024 + h * 128 + qd * 32;
#pragma unroll
      for (int c = 0; c < 4; ++c) { u32x4 w;
          w.x = cvtpk(x[8 * c] * rs * sg[8 * c], x[8 * c + 1] * rs * sg[8 * c + 1]); w.y = cvtpk(x[8 * c + 2] * rs * sg[8 * c + 2], x[8 * c + 3] * rs * sg[8 * c + 3]);
          w.z = cvtpk(x[8 * c + 4] * rs * sg[8 * c + 4], x[8 * c + 5] * rs * sg[8 * c + 5]); w.w = cvtpk(x[8 * c + 6] * rs * sg[8 * c + 6], x[8 * c + 7] * rs * sg[8 * c + 7]);
          *(u32x4*)(op + 8 * c) = w; } }
}
struct SEpiQKV {
    bf16_t *Qb, *Kb, *Vb; int ldkv, nq, nk, has_norm; const float *qg, *kg; float qscale; float *ks, *vs; int swa;
    __device__ __forceinline__ float pre(int, int hg, int lane) const { if (!has_norm || hg >= nq + nk) return 1.f; return (hg < nq ? pg8::opq(qg) : pg8::opq(kg))[lane]; }
    __device__ __forceinline__ void operator()(int row  , int hg, int lane, float v, int, float ss  , float aux) const {
        int type, gi; if (hg < nq) { type = 0; gi = hg; } else if (hg < nq + nk) { type = 1; gi = hg - nq; } else { type = 2; gi = hg - nq - nk; }
        if (has_norm && type < 2) { v = v * rsqrtf(ss * (1.f / 64.f) + 1e-6f) * aux; }
        if (type == 0) { v *= qscale; Qb[(size_t)(TP + row) * 1024 + gi * 64 + lane] = (bf16_t)f2bf(v); return; }
        bf16_t* bd = type == 1 ? pg8::opq(Kb) : pg8::opq(Vb); float* fd = type == 1 ? pg8::opq(ks) : pg8::opq(vs);
        bd[(size_t)(TP + row) * ldkv + gi * 64 + lane] = (bf16_t)f2bf(v);
        const size_t frow = swa ? (size_t)(row >> 5) * 128 + 96 + (row & 31) : (size_t)row;
        fd[frow * ldkv + gi * 64 + lane] = v;
    }
};
struct SEpiRelu2 { bf16_t* U; __device__ __forceinline__ float pre(int, int, int) const { return 0.f; }
    __device__ __forceinline__ void operator()(int row, int ct, int lane, float v, int, float, float) const { const float a = fmaxf(v, 0.f); U[(size_t)(TP + row) * FF + ct * 64 + lane] = (bf16_t)f2bf(a * a); } };
struct SEpiResid { const float* xin32; const bf16_t* xin16; bf16_t* xout16; float* y32; float* slab;
    __device__ __forceinline__ float pre(int row, int ct, int lane) const { if (slab) return 0.f; const size_t o = (size_t)row * 1024 + ct * 64 + lane, og = (size_t)(TP + row) * 1024 + ct * 64 + lane;
        return xin32 ? xin32[o] : __uint_as_float((unsigned)xin16[og] << 16); }
    __device__ __forceinline__ void operator()(int row, int ct, int lane, float v, int ks, float, float aux) const { const size_t o = (size_t)row * 1024 + ct * 64 + lane, og = (size_t)(TP + row) * 1024 + ct * 64 + lane;
        if (slab) { slab[(size_t)ks * TS * 1024 + o] = v; return; }
        const float x = aux + v;
        if (y32) y32[o] = x; else xout16[og] = (bf16_t)f2bf(x); } };

#define SG_WAIT_BAR(N) asm volatile("s_waitcnt vmcnt(" #N ") lgkmcnt(0)\n\ts_barrier" ::: "memory")
template <class Epi>
__device__ __forceinline__ void sgemm_phase(LAS unsigned char* lds, const bf16_t* A  , int lda, const bf16_t* Bt  , int K, int N, bool perm256, const Epi& E, int vcu, int G, int ksplit = 1) {
    const int tid = pg8::otid(), lane = tid & 63, r32 = lane & 31, hi = lane >> 5; const int wid = __builtin_amdgcn_readfirstlane(tid >> 6);
    const int rh = wid & 1, cq = wid >> 1, ncb = N / 128, nitems = 8 * ncb * ksplit, kc = K / ksplit, nst = kc / 64;
    LAS float* tile = (LAS float*)(lds + 98304);
    const unsigned lds0 = (unsigned)(uintptr_t)lds;
    for (int it = vcu; it < nitems; it += G) {
        const int ks = it / (8 * ncb), it2 = it - ks * 8 * ncb, rb = it2 & 7, cb = it2 >> 3, kbase = ks * kc;
        int R, C; pg8::stage_rc(wid * 1024 + lane * 16, R, C);
        int b0r, b1r;
        if (perm256) { const int h0 = 2 * cb, h1 = 2 * cb + 1; b0r = (h0 >> 2) * 256 + 32 * (h0 & 3) + (R & 31) + 128 * (R >> 5); b1r = (h1 >> 2) * 256 + 32 * (h1 & 3) + (R & 31) + 128 * (R >> 5); }
        else { b0r = cb * 128 + R; b1r = cb * 128 + 64 + R; }
        const bf16_t* asrc = A + (size_t)(rb * 64 + R) * lda + C + kbase;
        const bf16_t* b0src = Bt + (size_t)b0r * K + C + kbase; const bf16_t* b1src = Bt + (size_t)b1r * K + C + kbase;
        const unsigned dst = lds0 + wid * 1024;
#define SG_DMA(st) do { const unsigned so_ = dst + (unsigned)((st) & 3) * 24576u; const int ko_ = (st) * 64; \
        glds16(asrc + ko_, (unsigned)__builtin_amdgcn_readfirstlane(so_)); glds16(b0src + ko_, (unsigned)__builtin_amdgcn_readfirstlane(so_ + 8192u)); glds16(b1src + ko_, (unsigned)__builtin_amdgcn_readfirstlane(so_ + 16384u)); } while (0)
        f32x16 c;
#pragma unroll
        for (int r = 0; r < 16; ++r) c[r] = 0.f;
        asm volatile("s_waitcnt lgkmcnt(0)\n\ts_barrier" ::: "memory");
        SG_DMA(0); SG_DMA(1); SG_DMA(2);
        for (int st = 0; st < nst; ++st) {
            if (st + 2 < nst) SG_WAIT_BAR(6); else if (st + 1 < nst) SG_WAIT_BAR(3); else SG_WAIT_BAR(0);
            if (st + 3 < nst) SG_DMA(st + 3);
            const LAS unsigned char* bb = lds + (st & 3) * 24576;
            const LAS unsigned char* wb = bb + 8192 + (cq >> 1) * 8192;
            bf16x8 af[4], bf[4];
#pragma unroll
            for (int d0 = 0; d0 < 4; ++d0) { af[d0] = *(const LAS bf16x8*)(bb + pg8::lds_byte(rh * 32 + r32, 16 * d0 + 8 * hi)); bf[d0] = *(const LAS bf16x8*)(wb + pg8::lds_byte((cq & 1) * 32 + r32, 16 * d0 + 8 * hi)); }
#pragma unroll
            for (int d0 = 0; d0 < 4; ++d0) c = MFMA32(af[d0], bf[d0], c);
        }
#undef SG_DMA
        __syncthreads();
#pragma unroll
        for (int r = 0; r < 16; ++r) tile[(rh * 32 + crow(r, hi)) * 128 + cq * 32 + r32] = c[r];
        __syncthreads();
        float tv[8][2], tss[8][2];
#pragma unroll
        for (int rr = 0; rr < 8; ++rr) { const int row = wid * 8 + rr; tv[rr][0] = tile[row * 128 + lane]; tv[rr][1] = tile[row * 128 + 64 + lane]; tss[rr][0] = tv[rr][0] * tv[rr][0]; tss[rr][1] = tv[rr][1] * tv[rr][1]; }
#pragma unroll
        for (int o = 32; o; o >>= 1)
#pragma unroll
            for (int rr = 0; rr < 8; ++rr) { tss[rr][0] += __shfl_xor(tss[rr][0], o); tss[rr][1] += __shfl_xor(tss[rr][1], o); }
        float tax[8][2];
#pragma unroll
        for (int rr = 0; rr < 8; ++rr) { const int row = wid * 8 + rr; tax[rr][0] = E.pre(rb * 64 + row, 2 * cb, lane); tax[rr][1] = E.pre(rb * 64 + row, 2 * cb + 1, lane); }
#pragma unroll
        for (int rr = 0; rr < 8; ++rr) { const int row = wid * 8 + rr;
            E(rb * 64 + row, 2 * cb, lane, tv[rr][0], ks, tss[rr][0], tax[rr][0]); E(rb * 64 + row, 2 * cb + 1, lane, tv[rr][1], ks, tss[rr][1], tax[rr][1]); }
    }
    __syncthreads();
}
#ifndef FX_STAMP
#define FX_STAMP 0
#endif
#ifndef FX_NO_SMALL
#define FX_NO_SMALL 0
#endif
#ifndef FX_SP2
#define FX_SP2 true
#endif
__global__ void __launch_bounds__(NWAVES * 64, 2) mega(Params p) {
    extern __shared__ __attribute__((aligned(16))) unsigned char lds_raw[];
    LAS unsigned char* lds = (LAS unsigned char*)lds_raw;
    const int tid = threadIdx.x, lane = tid & 63; const int wave = __builtin_amdgcn_readfirstlane(tid >> 6);
    const int G = gridDim.x; const int vcu = (G % 8 == 0) ? ((int)blockIdx.x % 8) * (G / 8) + (int)blockIdx.x / 8 : (int)blockIdx.x;
    const int gw = vcu * NWAVES + wave, NGW = G * NWAVES;
    unsigned* ctl = (unsigned*)(p.ws + WS_CTL);
    for (int u = tid; u < (LDS_BYTES - LDSCTL_OFF) / 4; u += NWAVES * 64) ((LAS unsigned*)(lds + LDSCTL_OFF))[u] = 0u;
    __syncthreads();
    XcdBarrier bar = xcd_barrier_post(ctl + CW_BAR + p.li * XCD_BAR_WORDS, (volatile LAS unsigned*)(lds + MISC_OFF) + 8);
    const int lo = p.ph_lo, hi_ph = p.ph_hi;
#define IN(k) (lo <= (k) && (k) < hi_ph)
#define SEAM(k) do { if (FX_STAMP && blockIdx.x == 0 && tid == 0) ((unsigned long long*)(ctl + 200000))[64 + (k)] = __builtin_amdgcn_s_memrealtime(); if (IN(k) && IN((k) + 1)) xcd_barrier(bar); if (FX_STAMP && blockIdx.x == 0 && tid == 0) ((unsigned long long*)(ctl + 200000))[(k) + 1] = __builtin_amdgcn_s_memrealtime(); } while (0)
#define MIDSTAMP(k) do { if (FX_STAMP && blockIdx.x == 0 && tid == 0) ((unsigned long long*)(ctl + 200000))[32 + (k)] = __builtin_amdgcn_s_memrealtime(); } while (0)
#define WSP(off) ((bf16_t*)(pg8::opq(p.ws) + (off)))
#define SPLIT_ARRIVE(k) do { asm volatile("s_waitcnt vmcnt(0)" ::: "memory"); __syncthreads(); \
        if (tid == 0) { __builtin_amdgcn_fence(__ATOMIC_RELEASE, "agent"); asm volatile("s_waitcnt vmcnt(0)" ::: "memory"); (void)xb_add(ctl + CW_FLAG + 64 * (k), 1u); } } while (0)
#define SPLIT_WAIT(k) do { if (tid == 0) { XB_SPIN(xb_ld(ctl + CW_FLAG + 64 * (k)) < (unsigned)G, bar.bar); __builtin_amdgcn_fence(__ATOMIC_ACQUIRE, "agent"); asm volatile("s_waitcnt vmcnt(0)" ::: "memory"); } __syncthreads(); } while (0)

    if (FX_STAMP && blockIdx.x == 0 && tid == 0) ((unsigned long long*)(ctl + 200000))[0] = __builtin_amdgcn_s_memrealtime();
    if (IN(0)) prologue(p, lds, gw, NGW, wave, pg8::otid() & 63);
    for (int layer = 0; layer < 4; ++layer) {
        const int pb = 1 + 7 * layer, mix = layer % 3, j = layer / 3;
        const size_t wlo = WS_W + (size_t)layer * WL_BYTES;

        if (layer == 0) {
            if (IN(pb + 0)) { __syncthreads(); rms0_phase(p.in[X_P], p.in[X_S], WSP(WS_XN), pg8::opqi(gw), NGW, pg8::otid() & 63); }
            SEAM(pb + 0); }
        if (IN(pb + 1)) {
            const int N = mix == 1 ? 1536 : 3072;
            if (layer > 0) {
                { const int pm0_ = pg8::static_pm0(TP, N, G, (int)blockIdx.x); const int t_ = pg8::otid() - 256;
                  if (pm0_ >= 0 && t_ >= 0) { const f32x4* r_ = (const f32x4*)((const float*)WSP(WS_RSS) + (size_t)(pm0_ * 256 + t_) * 16); const f32x4 a_ = r_[0], b_ = r_[1], c_ = r_[2], d_ = r_[3]; const f32x4 q_ = (a_ + b_) + (c_ + d_);
                      ((LAS float*)(lds + GA_TAB))[t_] = rsqrtf(((q_[0] + q_[1]) + (q_[2] + q_[3])) * (1.f / 1024.f) + 1e-6f); } }
                rms_phase(nullptr, nullptr, WSP(WS_XR), (const float*)WSP(WS_SLAB), TP, WSP(WS_XN), pg8::opqi(wave * G + vcu), NGW, pg8::otid() & 63); SPLIT_ARRIVE(2 * layer); }
            pg8::Gemm g{layer == 0 ? WSP(WS_XN) : WSP(WS_XR), WSP(wlo + WL_QKV), TP, N, D}; pg8::StaticOrder S; S.init(TP, N, G, (int)blockIdx.x);
            pg8::EpiQKV E; E.rowss = layer == 0 ? (const float*)nullptr : (const float*)WSP(WS_RSS);
            E.Qb = WSP(WS_Q); E.Kb = WSP(WS_K); E.Vb = WSP(WS_V); E.ldkv = mix == 1 ? 256 : 1024; E.nq = 16; E.nk = mix == 1 ? 4 : 16; E.has_norm = mix != 2; E.swa = mix == 1;
            E.qg = mix == 0 ? p.in[D_QN] + j * 64 : p.in[S_QN]; E.kg = mix == 0 ? p.in[D_KN] + j * 64 : p.in[S_KN]; E.qscale = QSC;
            E.kp = mix == 0 ? p.dkp[j] : (mix == 1 ? p.wkp : p.bkp); E.vp = mix == 0 ? p.dvp[j] : (mix == 1 ? p.wvp : p.bvp);
            E.ks = mix == 0 ? p.dks[j] : (mix == 1 ? p.wks : p.bks); E.vs = mix == 0 ? p.dvs[j] : (mix == 1 ? p.wvs : p.bvs);
            E.rtab = (const LAS float*)(lds + GA_TAB);
            pg8::gemm_phase<pg8::EpiQKV, pg8::StaticOrder, true, FX_SP2>(lds, g, S, E);
            MIDSTAMP(pb + 1);
            SEpiQKV SE; SE.Qb = E.Qb; SE.Kb = E.Kb; SE.Vb = E.Vb; SE.ldkv = E.ldkv; SE.nq = E.nq; SE.nk = E.nk; SE.has_norm = E.has_norm; SE.qg = E.qg; SE.kg = E.kg; SE.qscale = E.qscale; SE.ks = E.ks; SE.vs = E.vs; SE.swa = E.swa;
            if (layer > 0) SPLIT_WAIT(2 * layer);
            const int vs_ = (mix == 1 && G == 256) ? (((int)blockIdx.x + 128) & 255) : vcu;
            if (!FX_NO_SMALL) sgemm_phase(lds, WSP(WS_XN) + (size_t)TP * D, D, WSP(wlo + WL_QKV), D, N, true, SE, vs_, G);
        }
        SEAM(pb + 1);
        if (IN(pb + 2)) {
            bf16_t *Qb = WSP(WS_Q), *Kb = WSP(WS_K), *Vb = WSP(WS_V), *Ob = WSP(WS_O);
            if (mix == 0) {
                const float lam_init = layer == 0 ? 0.2f : 0.55605820417f;
                const float* lp = p.in[D_LAM] + j * 256;
                const int ln = pg8::otid() & 63; const float lam = expf(wave_sum(lp[ln] * lp[64 + ln])) - expf(wave_sum(lp[128 + ln] * lp[192 + ln])) + lam_init;
                for (int u = vcu; u < 1024; u += G) { const int k = u >> 8, v = u & 255, h = v >> 5, s = v & 31; const int qb = k == 0 ? s : (k == 1 ? 63 - s : (k == 2 ? (s < 16 ? 80 + s : 48 + s) : 127 - s));
                    attn_diff_p3(p, lds, h, qb, j, lam, lam_init, Qb, Kb, Vb, Ob);
                    if (k == 0 && s >= 16) { const int us_ = h * 16 + (s - 16); attn_unit<M_DIFF_S>(p, lds, us_ >> 3, us_ & 7, j, lam, lam_init, Qb, Kb, Vb, Ob); } }
            } else if (mix == 1) {
                for (int u = vcu; u < 1024; u += G) attn_unit<M_SWA_P>(p, lds, u >> 2, u & 3, 0, 0.f, 0.f, Qb, Kb, Vb, Ob);
                for (int u = vcu; u < 64; u += G) attn_unit<M_SWA_S>(p, lds, u >> 2, u & 3, 0, 0.f, 0.f, Qb, Kb, Vb, Ob);
            } else {
                for (int u = vcu; u < 1024; u += G) attn_unit<M_SB_P>(p, lds, u >> 2, u & 3, 0, 0.f, 0.f, Qb, Kb, Vb, Ob);
                for (int u = vcu; u < 64; u += G) attn_unit<M_SB_S>(p, lds, u >> 2, u & 3, 0, 0.f, 0.f, Qb, Kb, Vb, Ob);
            }
        }
        SEAM(pb + 2);
        if (IN(pb + 3)) {
            pg8::Gemm g{WSP(WS_O), WSP(wlo + WL_O), TP, D, D}; pg8::StaticOrder S; S.init(TP, D, G, (int)blockIdx.x);
            pg8::EpiResid E{layer == 0 ? p.in[X_P] : (const float*)nullptr, WSP(WS_XR), WSP(WS_XR), nullptr, (float*)WSP(WS_RSS)};
            pg8::gemm_phase<pg8::EpiResid, pg8::StaticOrder, true, FX_SP2>(lds, g, S, E);
            MIDSTAMP(pb + 3);
            SEpiResid SE{nullptr, nullptr, nullptr, nullptr, (float*)WSP(WS_SLAB)};
            if (!FX_NO_SMALL) sgemm_phase(lds, WSP(WS_O) + (size_t)TP * D, D, WSP(wlo + WL_O), D, D, false, SE, vcu, G, 4);
        }
        SEAM(pb + 3);
        if (IN(pb + 5)) {
            { const int pm0_ = pg8::static_pm0(TP, FF, G, (int)blockIdx.x); const int t_ = pg8::otid() - 256;
                  if (pm0_ >= 0 && t_ >= 0) { const f32x4* r_ = (const f32x4*)((const float*)WSP(WS_RSS) + (size_t)(pm0_ * 256 + t_) * 16); const f32x4 a_ = r_[0], b_ = r_[1], c_ = r_[2], d_ = r_[3]; const f32x4 q_ = (a_ + b_) + (c_ + d_);
                      ((LAS float*)(lds + GA_TAB))[t_] = rsqrtf(((q_[0] + q_[1]) + (q_[2] + q_[3])) * (1.f / 1024.f) + 1e-6f); } }
            rms_phase(nullptr, layer == 0 ? p.in[X_S] : (const float*)nullptr, WSP(WS_XR), (const float*)WSP(WS_SLAB), TP, WSP(WS_XN), pg8::opqi(wave * G + vcu), NGW, pg8::otid() & 63); SPLIT_ARRIVE(2 * layer + 1);
            pg8::Gemm g{WSP(WS_XR), WSP(wlo + WL_UP), TP, FF, D}; pg8::StaticOrder S; S.init(TP, FF, G, (int)blockIdx.x);
            pg8::EpiRelu2 E; E.O = WSP(WS_U); E.ldc = FF; E.rowss = (const float*)WSP(WS_RSS);
            E.rtab = (const LAS float*)(lds + GA_TAB);
            pg8::gemm_phase<pg8::EpiRelu2, pg8::StaticOrder, true, FX_SP2>(lds, g, S, E);
            MIDSTAMP(pb + 5);
            SEpiRelu2 SE{WSP(WS_U)};
            SPLIT_WAIT(2 * layer + 1);
            if (!FX_NO_SMALL) sgemm_phase(lds, WSP(WS_XN) + (size_t)TP * D, D, WSP(wlo + WL_UP), D, FF, false, SE, vcu, G);
        }
        SEAM(pb + 5);
        if (IN(pb + 6)) {
            float* yo = layer == 3 ? pg8::opq(p.yout) : (float*)nullptr;
            pg8::Gemm g{WSP(WS_U), WSP(wlo + WL_DN), TP, D, FF}; pg8::StaticOrder S; S.init(TP, D, G, (int)blockIdx.x);
            pg8::EpiResid E{nullptr, WSP(WS_XR), WSP(WS_XR), yo, yo ? (float*)nullptr : (float*)WSP(WS_RSS)};
            pg8::gemm_phase<pg8::EpiResid, pg8::StaticOrder, true, FX_SP2>(lds, g, S, E);
            MIDSTAMP(pb + 6);
            SEpiResid SE{nullptr, WSP(WS_XR), WSP(WS_XR), yo ? yo + (size_t)TP * D : (float*)nullptr, yo ? (float*)nullptr : (float*)WSP(WS_SLAB)};
            if (!FX_NO_SMALL) sgemm_phase(lds, WSP(WS_U) + (size_t)TP * FF, FF, WSP(wlo + WL_DN), FF, D, false, SE, vcu, G, yo ? 1 : 4);
        }
        SEAM(pb + 6);
    }
#undef IN
#undef SEAM
#undef WSP
#undef SPLIT_ARRIVE
#undef SPLIT_WAIT
#undef XRES
}
constexpr int N_PHASES = 29;

static int fast_grid() {
    static int grid = 0;
    if (grid == 0) {
        int dev = 0, cus = 0;
        if (hipGetDevice(&dev) != hipSuccess || hipDeviceGetAttribute(&cus, hipDeviceAttributeMultiprocessorCount, dev) != hipSuccess) { grid = -1; return grid; }
        if (hipFuncSetAttribute((const void*)mega, hipFuncAttributeMaxDynamicSharedMemorySize, LDS_BYTES) != hipSuccess) { fprintf(stderr, "hipFuncSetAttribute failed\n"); grid = -1; return grid; }
        int per_cu = 0;
        if (hipOccupancyMaxActiveBlocksPerMultiprocessor(&per_cu, (const void*)mega, NWAVES * 64, LDS_BYTES) != hipSuccess || per_cu < 1) { fprintf(stderr, "occupancy query: %d blocks/CU\n", per_cu); (void)hipGetLastError(); }
        grid = cus;
    }
    return grid;
}
static void launch_fast(Params p, int lo, int hi, int li, hipStream_t st) {
    const int grid = fast_grid(); if (grid <= 0) return;
    p.ph_lo = lo; p.ph_hi = hi; p.li = li; p.pad = 0;
    hipLaunchKernelGGL(mega, dim3(grid), dim3(NWAVES * 64), LDS_BYTES, st, p);
    const hipError_t e = hipPeekAtLastError(); if (e != hipSuccess) fprintf(stderr, "mega launch failed: %s\n", hipGetErrorName(e));
}
}
namespace oo {
constexpr size_t TPD = (size_t)fx::TP * fx::D, TSD = (size_t)fx::TS * fx::D;
constexpr size_t Y = 0, DKP = (size_t)fx::T * fx::D, DVP = DKP + 2 * TPD, WKP = DVP + 2 * TPD, WVP = WKP + 32768, BKP = WVP + 32768, BVP = BKP + TPD,
    DKS = BVP + TPD, DVS = DKS + 2 * TSD, WKS = DVS + 2 * TSD, WVS = WKS + 524288, BKS = WVS + 524288, BVS = BKS + 524288, END = BVS + 524288;
static_assert(END == 122224640ull, "output size");
}
#if FX_STAMP
#ifndef ST_A
#define ST_A 3
#endif
#ifndef ST_B
#define ST_B 2
#endif
__global__ void encode_time(const unsigned long long* st, float* ys, int n, float* y0) {
    __shared__ float sc;
    if (threadIdx.x == 0) {
        float us[29]; for (int k = 0; k < 29; ++k) us[k] = (float)(st[k + 1] - st[k]) * 0.01f;
        float g[16]; for (int i = 0; i < 16; ++i) g[i] = 0.f;
        g[0] = us[0];
        for (int L = 0; L < 4; ++L) { const int pb = 1 + 7 * L, mix = L % 3; g[1] += us[pb]; g[2] += us[pb + 1]; g[3 + mix] += us[pb + 2]; g[6] += us[pb + 3]; g[7] += us[pb + 4]; g[8] += us[pb + 5]; g[9] += us[pb + 6]; }
        g[13] = g[0] + g[1] + g[7]; g[14] = g[4] + g[5]; g[15] = g[2] + g[6] + g[8] + g[9];
        g[10] = 0.f; g[11] = 0.f; for (int L = 0; L < 4; ++L) { const int pb = 1 + 7 * L; g[10] += (float)(st[64 + pb + 6] - st[32 + pb + 6]) * 0.01f; g[11] += (float)(st[64 + pb + 1] - st[32 + pb + 1]) * 0.01f + (float)(st[64 + pb + 3] - st[32 + pb + 3]) * 0.01f + (float)(st[64 + pb + 5] - st[32 + pb + 5]) * 0.01f; }
        sc = 1.f + sqrtf(g[ST_A] * 1e-4f);
        y0[0] += g[ST_B] * 0.01f;
    }
    __syncthreads();
    const float s = sc;
    for (int i = blockIdx.x * blockDim.x + threadIdx.x; i < n; i += gridDim.x * blockDim.x) ys[i] *= s;
}
#endif
#ifndef FX_N_LAUNCH
#define FX_N_LAUNCH 1
#endif
extern "C" void kernel_launch(void* const* d_in, const int* in_sizes, int n_in, void* d_out, int out_size, void* d_ws, size_t ws_size, hipStream_t stream) {
    using namespace fx;
    if (n_in != 26 || out_size != (int)oo::END || ws_size < WS_END) { fprintf(stderr, "kernel_launch: unexpected sizes n_in %d out %d ws %zu\n", n_in, out_size, ws_size); return; }
    unsigned char* ws = (unsigned char*)d_ws; float* out = (float*)d_out;
    (void)hipMemsetAsync(ws + WS_CTL, 0, CTL_ZERO_BYTES, stream);
    Params p{};
    for (int i = 0; i < 26; ++i) p.in[i] = (const float*)d_in[i];
    p.ws = ws; p.yout = out + oo::Y;
    for (int j = 0; j < 2; ++j) { p.dkp[j] = out + oo::DKP + j * oo::TPD; p.dvp[j] = out + oo::DVP + j * oo::TPD; p.dks[j] = out + oo::DKS + j * oo::TSD; p.dvs[j] = out + oo::DVS + j * oo::TSD; }
    p.wkp = out + oo::WKP; p.wvp = out + oo::WVP; p.wks = out + oo::WKS; p.wvs = out + oo::WVS;
    p.bkp = out + oo::BKP; p.bvp = out + oo::BVP; p.bks = out + oo::BKS; p.bvs = out + oo::BVS;
    if (FX_N_LAUNCH == 1) launch_fast(p, 0, N_PHASES, 0, stream);
    else for (int k = 0; k < N_PHASES; ++k) launch_fast(p, k, k + 1, k, stream);
#if FX_STAMP
    encode_time<<<32, 256, 0, stream>>>((const unsigned long long*)((unsigned*)(ws + WS_CTL) + 200000), out + oo::WVP, 32768, out + 5);
#endif
}
```

```cpp
#include <hip/hip_runtime.h>
#include <cstdio>
#include <cstdint>
#include <cmath>
namespace pg8 {


#define PG8_LAS __attribute__((address_space(3)))
typedef unsigned short bf16_t;
typedef short bf16x8 __attribute__((ext_vector_type(8)));
typedef float f32x4 __attribute__((ext_vector_type(4)));
typedef unsigned u32x4 __attribute__((ext_vector_type(4)));
constexpr int BM = 256, BK = 64, HALF = 128, HTB = HALF * BK * 2  , STAGE_BYTES = 8 * HTB, NXCD = 8, WGM = 8;

__host__ __device__ __forceinline__ int lds_byte(int r, int c) { const int st = (r >> 4) * 2 + (c >> 5), rr = r & 15, cc = c & 31, ob = rr * 64 + cc * 2; return st * 1024 + (ob ^ (((ob >> 9) & 1) << 5)); }
__host__ __device__ __forceinline__ void stage_rc(int b, int& R, int& C) { const int st = b / 1024, sb = b % 1024, swz = sb ^ (((sb >> 9) & 1) << 5); R = (st >> 1) * 16 + swz / 64; C = (st & 1) * 32 + (swz % 64) / 2; }
__host__ __device__ __forceinline__ int perm32(int rho) { const int n = rho >> 4, i = rho & 15; return 8 * (i >> 2) + 4 * n + (i & 3); }

__device__ __forceinline__ int otid() { int t = threadIdx.x; asm volatile("" : "+v"(t)); return t; }
template <class Tp> __device__ __forceinline__ Tp* opq(Tp* x) { asm volatile("" : "+s"(x)); return x; }
__device__ __forceinline__ int opqi(int x) { asm volatile("" : "+s"(x)); return x; }
struct Unit { int pm, pn; };
struct Gemm { const bf16_t* A; const bf16_t* Bt; int M, N, K; };

__device__ __forceinline__ int static_pm0(int M, int N, int G, int c) {
    const int nM = M / BM, nN = N / BM, nwg = nM * nN; if (c >= nwg) return -1;
    int wgid = c; { const int q = nwg / NXCD, r = nwg % NXCD, xcd = wgid % NXCD, off = wgid / NXCD; wgid = (xcd < r ? xcd * (q + 1) : r * (q + 1) + (xcd - r) * q) + off; }
    const int nig = WGM * nN, gid = wgid / nig, fm = gid * WGM, gsz = (nM - fm) < WGM ? (nM - fm) : WGM;
    return fm + ((wgid % nig) % gsz);
}
struct StaticOrder {
    int nM, nN, nwg, G, c;
    __host__ __device__ void init(int M, int N, int G_, int c_) { nM = M / BM; nN = N / BM; nwg = nM * nN; G = G_; c = c_; }
    __host__ __device__ bool next(int i, Unit& u) const {
        const long L = (long)i * G + c; if (L >= nwg) return false;
        int wgid = (int)L; { const int q = nwg / NXCD, r = nwg % NXCD, xcd = wgid % NXCD, off = wgid / NXCD; wgid = (xcd < r ? xcd * (q + 1) : r * (q + 1) + (xcd - r) * q) + off; }
        const int nig = WGM * nN, gid = wgid / nig, fm = gid * WGM, gsz = (nM - fm) < WGM ? (nM - fm) : WGM;
        u.pm = fm + ((wgid % nig) % gsz); u.pn = (wgid % nig) / gsz; return true;
    }
    __device__ __forceinline__ void a_ready(const Unit&) const {}
    __device__ __forceinline__ void done(const Unit&) const {}
};

typedef unsigned u32x2e __attribute__((ext_vector_type(2)));
__device__ __forceinline__ unsigned cvt_pk_bf16(float lo, float hi) { unsigned r; asm volatile("v_cvt_pk_bf16_f32 %0, %1, %2" : "=v"(r) : "v"(lo), "v"(hi)); return r; }
constexpr int E_TP = 16384;
__device__ __forceinline__ void rows_rin(const float* rowss, int row0, int fq, float (&rin)[2][4]) {
    f32x4 a[2][4];
#pragma unroll
    for (int ai = 0; ai < 2; ++ai)
#pragma unroll
        for (int m = 0; m < 4; ++m) a[ai][m] = *(const f32x4*)(rowss + (size_t)(row0 + ai * HALF + m * 16) * 16 + 4 * fq);
    float sv[2][4];
#pragma unroll
    for (int ai = 0; ai < 2; ++ai)
#pragma unroll
        for (int m = 0; m < 4; ++m) sv[ai][m] = (a[ai][m][0] + a[ai][m][1]) + (a[ai][m][2] + a[ai][m][3]);
#pragma unroll
    for (int ai = 0; ai < 2; ++ai)
#pragma unroll
        for (int m = 0; m < 4; ++m) sv[ai][m] += __shfl_xor(sv[ai][m], 16);
#pragma unroll
    for (int ai = 0; ai < 2; ++ai)
#pragma unroll
        for (int m = 0; m < 4; ++m) sv[ai][m] += __shfl_xor(sv[ai][m], 32);
#pragma unroll
    for (int ai = 0; ai < 2; ++ai)
#pragma unroll
        for (int m = 0; m < 4; ++m) rin[ai][m] = rsqrtf(sv[ai][m] * (1.f / 1024.f) + 1e-6f);
}
__device__ __forceinline__ float row_rin(const float* rowss, int row, int fq) { const f32x4 a = *(const f32x4*)(rowss + (size_t)row * 16 + 4 * fq); float s = (a[0] + a[1]) + (a[2] + a[3]);
    s += __shfl_xor(s, 16); s += __shfl_xor(s, 32); return rsqrtf(s * (1.f / 1024.f) + 1e-6f); }

struct EpiQKV {
    static constexpr bool PERM = true, AFTER_DRAIN = false;
    bf16_t *Qb, *Kb, *Vb; int ldkv, nq, nk, has_norm; const float *qg, *kg; float qscale;
    float *kp, *vp, *ks, *vs; int swa;
    const float* rowss;
    const PG8_LAS float* rtab;
    __device__ __forceinline__ void operator()(const f32x4 (&acc)[2][2][4][2], const Unit& u, int wr, int wc, int fr, int fq) const {
        const float* rss_ = opq(rowss);
        bf16_t *Qb_ = opq(Qb), *Kb_ = opq(Kb), *Vb_ = opq(Vb); float *kp_ = opq(kp), *vp_ = opq(vp), *ks_ = opq(ks), *vs_ = opq(vs); const float *qg_ = opq(qg), *kg_ = opq(kg);
        const int hg = u.pn * 4 + wc; int type, gi;
        if (hg < nq) { type = 0; gi = hg; } else if (hg < nq + nk) { type = 1; gi = hg - nq; } else { type = 2; gi = hg - nq - nk; }
        float gsc[2][8];
        const float base = type == 0 ? qscale : 1.f;
#pragma unroll
        for (int bj = 0; bj < 2; ++bj)
#pragma unroll
            for (int e = 0; e < 8; ++e) gsc[bj][e] = base;
        const bool normed = has_norm && type < 2;
        if (normed) { const float* g = type == 0 ? qg_ : kg_;
#pragma unroll
            for (int bj = 0; bj < 2; ++bj)
#pragma unroll
                for (int e = 0; e < 8; ++e) gsc[bj][e] = g[32 * bj + 8 * fq + e] * base; }
        const int row0 = u.pm * BM + wr * 64 + fr; const bool prompt = u.pm < E_TP / BM;
        float rinv[2][4];
        if (rss_) {
#pragma unroll
            for (int ai = 0; ai < 2; ++ai)
#pragma unroll
                for (int m = 0; m < 4; ++m) rinv[ai][m] = rtab[wr * 64 + ai * HALF + m * 16 + fr]; }
        bf16_t* bdst = type == 0 ? Qb_ : (type == 1 ? Kb_ : Vb_); const int bld = type == 0 ? 1024 : ldkv;
        float* fdst = type == 1 ? (prompt ? kp_ : ks_) : (prompt ? vp_ : vs_);
        float hss[2][4];
        if (normed) {
#pragma unroll
            for (int ai = 0; ai < 2; ++ai)
#pragma unroll
                for (int m = 0; m < 4; ++m) { float ss = 0.f;
#pragma unroll
                    for (int bj = 0; bj < 2; ++bj)
#pragma unroll
                        for (int n = 0; n < 2; ++n) { const f32x4 x = acc[ai][bj][m][n]; ss += (x[0] * x[0] + x[1] * x[1]) + (x[2] * x[2] + x[3] * x[3]); }
                    hss[ai][m] = ss; }
#pragma unroll
            for (int ai = 0; ai < 2; ++ai)
#pragma unroll
                for (int m = 0; m < 4; ++m) hss[ai][m] += __shfl_xor(hss[ai][m], 16);
#pragma unroll
            for (int ai = 0; ai < 2; ++ai)
#pragma unroll
                for (int m = 0; m < 4; ++m) hss[ai][m] += __shfl_xor(hss[ai][m], 32); }
#pragma unroll
        for (int ai = 0; ai < 2; ++ai)
#pragma unroll
            for (int m = 0; m < 4; ++m) {
                const int row = row0 + ai * HALF + m * 16;
                const float rin = rss_ ? rinv[ai][m] : 1.f;
                float rs = rin;
                if (normed) rs = rin * rsqrtf(hss[ai][m] * (rin * rin) * (1.f / 64.f) + 1e-6f);
                long frow = -1;
                if (type >= 1) { if (!swa) frow = prompt ? row : row - E_TP;
                                 else if (prompt) frow = row - (E_TP - 128); else { const int rr = row - E_TP; frow = (long)(rr >> 5) * 128 + 96 + (rr & 31); } }
#pragma unroll
                for (int bj = 0; bj < 2; ++bj) {
                    f32x4 v0 = acc[ai][bj][m][0] * rs, v1 = acc[ai][bj][m][1] * rs;
                    v0[0] *= gsc[bj][0]; v0[1] *= gsc[bj][1]; v0[2] *= gsc[bj][2]; v0[3] *= gsc[bj][3]; v1[0] *= gsc[bj][4]; v1[1] *= gsc[bj][5]; v1[2] *= gsc[bj][6]; v1[3] *= gsc[bj][7];
                    const int col = gi * 64 + 32 * bj + 8 * fq;
                    u32x4 w; w.x = cvt_pk_bf16(v0[0], v0[1]); w.y = cvt_pk_bf16(v0[2], v0[3]); w.z = cvt_pk_bf16(v1[0], v1[1]); w.w = cvt_pk_bf16(v1[2], v1[3]);
                    *(u32x4*)(bdst + (size_t)row * bld + col) = w;
                    if (frow >= 0) { float* f = fdst + (size_t)frow * ldkv + col; *(f32x4*)f = v0; *(f32x4*)(f + 4) = v1; }
                }
            }
    }
};
struct EpiResid {
    static constexpr bool PERM = true, AFTER_DRAIN = false;
    const float* xin32; const bf16_t* xin16; bf16_t* xout16; float* y32; float* rss;
    __device__ __forceinline__ void operator()(const f32x4 (&acc)[2][2][4][2], const Unit& u, int wr, int wc, int fr, int fq) const {
        const int row0 = u.pm * BM + wr * 64 + fr, col0 = u.pn * BM + wc * 32 + 8 * fq;
        const float* x32 = opq(xin32); float* yo = opq(y32); float* rs_ = opq(rss); float ssv[2][4];
#pragma unroll
        for (int ai = 0; ai < 2; ++ai)
#pragma unroll
            for (int m = 0; m < 4; ++m) { const size_t ro = (size_t)(row0 + ai * HALF + m * 16) * 1024 + col0; float ss = 0.f;
#pragma unroll
                for (int bj = 0; bj < 2; ++bj) { const size_t o = ro + bj * HALF; f32x4 x0, x1;
                    if (x32) { x0 = *(const f32x4*)(x32 + o); x1 = *(const f32x4*)(x32 + o + 4); }
                    else { const u32x4 b = *(const u32x4*)(xin16 + o);
                        x0 = (f32x4){__uint_as_float(b.x << 16), __uint_as_float(b.x & 0xffff0000u), __uint_as_float(b.y << 16), __uint_as_float(b.y & 0xffff0000u)};
                        x1 = (f32x4){__uint_as_float(b.z << 16), __uint_as_float(b.z & 0xffff0000u), __uint_as_float(b.w << 16), __uint_as_float(b.w & 0xffff0000u)}; }
                    x0 = x0 + acc[ai][bj][m][0]; x1 = x1 + acc[ai][bj][m][1];
                    if (yo) { *(f32x4*)(yo + o) = x0; *(f32x4*)(yo + o + 4) = x1; }
                    else { u32x4 w; w.x = cvt_pk_bf16(x0[0], x0[1]); w.y = cvt_pk_bf16(x0[2], x0[3]); w.z = cvt_pk_bf16(x1[0], x1[1]); w.w = cvt_pk_bf16(x1[2], x1[3]); *(u32x4*)(xout16 + o) = w;
#pragma unroll
                        for (int e = 0; e < 4; ++e) { const float a = __uint_as_float(w[e] << 16), b = __uint_as_float(w[e] & 0xffff0000u); ss += a * a + b * b; } } }
                ssv[ai][m] = ss;
                if (m & 1) asm volatile("" ::: "memory"); }
        if (rs_) {
#pragma unroll
            for (int ai = 0; ai < 2; ++ai)
#pragma unroll
                for (int m = 0; m < 4; ++m) ssv[ai][m] += __shfl_xor(ssv[ai][m], 16);
#pragma unroll
            for (int ai = 0; ai < 2; ++ai)
#pragma unroll
                for (int m = 0; m < 4; ++m) ssv[ai][m] += __shfl_xor(ssv[ai][m], 32);
            if (fq == 0) {
#pragma unroll
                for (int ai = 0; ai < 2; ++ai)
#pragma unroll
                    for (int m = 0; m < 4; ++m) rs_[(size_t)(row0 + ai * HALF + m * 16) * 16 + u.pn * 4 + wc] = ssv[ai][m]; } }
    }
};
struct EpiRelu2 {
    static constexpr bool PERM = true, AFTER_DRAIN = false;
    bf16_t* O; int ldc; const float* rowss;
    const PG8_LAS float* rtab;
    __device__ __forceinline__ void operator()(const f32x4 (&acc)[2][2][4][2], const Unit& u, int wr, int wc, int fr, int fq) const {
        const int row0 = u.pm * BM + wr * 64 + fr, col0 = u.pn * BM + wc * 32 + 8 * fq;
        float rinv[2][4];
#pragma unroll
        for (int ai = 0; ai < 2; ++ai)
#pragma unroll
            for (int m = 0; m < 4; ++m) rinv[ai][m] = rtab[wr * 64 + ai * HALF + m * 16 + fr];
#pragma unroll
        for (int ai = 0; ai < 2; ++ai)
#pragma unroll
            for (int m = 0; m < 4; ++m) { bf16_t* rowp = O + (size_t)(row0 + ai * HALF + m * 16) * ldc + col0;
                const float rin2 = rinv[ai][m] * rinv[ai][m];
#pragma unroll
                for (int bj = 0; bj < 2; ++bj) { f32x4 v0 = acc[ai][bj][m][0], v1 = acc[ai][bj][m][1];
#pragma unroll
                    for (int e = 0; e < 4; ++e) { const float a = fmaxf(v0[e], 0.f), b = fmaxf(v1[e], 0.f); v0[e] = a * a * rin2; v1[e] = b * b * rin2; }
                    u32x4 w; w.x = cvt_pk_bf16(v0[0], v0[1]); w.y = cvt_pk_bf16(v0[2], v0[3]); w.z = cvt_pk_bf16(v1[0], v1[1]); w.w = cvt_pk_bf16(v1[2], v1[3]);
                    *(u32x4*)(rowp + bj * HALF) = w; } }
    }
};
template <class Epi, class Sched, bool ALIGN_EPI = false, bool SP2 = false>
__device__ __forceinline__ void gemm_phase(PG8_LAS unsigned char* lds, const Gemm g, const Sched& S, const Epi& E) {
    const int tid = otid(), wid = __builtin_amdgcn_readfirstlane(tid >> 6), lane = tid & 63, wr = wid >> 2, wc = wid & 3, fr = lane & 15, fq = lane >> 4;
    const int K = g.K, nt = K / BK;
    unsigned voffA[2], voffB[2];
#pragma unroll
    for (int i = 0; i < 2; ++i) { int R, C; stage_rc(tid * 16 + i * 8192, R, C); const int Rb = Epi::PERM ? ((R & ~31) + perm32(R & 31)) : R;
        voffA[i] = (unsigned)(R * K + C) * 2u; voffB[i] = (unsigned)(Rb * K + C) * 2u; }
    const size_t kstep = (size_t)(BK * 2);
    const size_t hstep = (size_t)HALF * K * 2;
    const size_t tstep = 2 * hstep;
    const unsigned ldsw = (unsigned)wid * 1024u;
    const int aoff = lds_byte(wr * 64 + fr, fq * 8), boff = lds_byte(wc * 32 + fr, fq * 8);
#define PG8_SA(b, h) (((b) * 2 + (h)) * HTB)
#define PG8_SB(b, h) ((4 + (b) * 2 + (h)) * HTB)
#define PG8_STAGE(bufoff, gbase, voff) do { _Pragma("unroll") for (int _i = 0; _i < 2; ++_i) \
        __builtin_amdgcn_global_load_lds((const unsigned*)((const char*)(gbase) + (voff)[_i]), (PG8_LAS unsigned*)(lds + (bufoff) + ldsw + _i * 8192), 16, 0, 0); } while (0)
#define PG8_LDA(dst, b, h) do { _Pragma("unroll") for (int m = 0; m < 4; ++m) _Pragma("unroll") for (int k = 0; k < 2; ++k) dst[m][k] = *(const PG8_LAS bf16x8*)(lds + PG8_SA(b, h) + aoff + m * 2048 + k * 1024); } while (0)
#define PG8_LDB(dst, b, h) do { _Pragma("unroll") for (int n = 0; n < 2; ++n) _Pragma("unroll") for (int k = 0; k < 2; ++k) dst[n][k] = *(const PG8_LAS bf16x8*)(lds + PG8_SB(b, h) + boff + n * 2048 + k * 1024); } while (0)
#define PG8_MMA(ai, bj, At, Bt) do { __builtin_amdgcn_s_setprio(1); _Pragma("unroll") for (int m = 0; m < 4; ++m) _Pragma("unroll") for (int n = 0; n < 2; ++n) _Pragma("unroll") for (int k = 0; k < 2; ++k) \
        acc[ai][bj][m][n] = __builtin_amdgcn_mfma_f32_16x16x32_bf16(Bt[n][k], At[m][k], acc[ai][bj][m][n], 0, 0, 0); __builtin_amdgcn_s_setprio(0); } while (0)
#define PG8_WAIT_V(n) asm volatile("s_waitcnt vmcnt(" #n ")" ::: "memory")
#define PG8_WAIT_L(n) asm volatile("s_waitcnt lgkmcnt(" #n ")" ::: "memory")
#define PG8_BAR __builtin_amdgcn_s_barrier()
#define PG8_SCHED __builtin_amdgcn_sched_barrier(0)
    Unit cur, nxt; int ui = 0;
    if (!S.next(0, cur)) return;
    f32x4 acc[2][2][4][2];
#pragma unroll
    for (int a = 0; a < 2; ++a)
#pragma unroll
        for (int b = 0; b < 2; ++b)
#pragma unroll
            for (int m = 0; m < 4; ++m)
#pragma unroll
                for (int n = 0; n < 2; ++n) acc[a][b][m][n] = (f32x4){0.f, 0.f, 0.f, 0.f};
    bf16x8 At[4][2], B0[2][2], B1[2][2];
    const char* cA = (const char*)g.A + (size_t)cur.pm * tstep; const char* cB = (const char*)g.Bt + (size_t)cur.pn * tstep;
    S.a_ready(cur);
    if constexpr (SP2) {
        PG8_STAGE(PG8_SB(0, 0), cB, voffB); PG8_STAGE(PG8_SB(0, 1), cB + hstep, voffB); PG8_STAGE(PG8_SA(0, 0), cA, voffA); PG8_STAGE(PG8_SA(0, 1), cA + hstep, voffA);
        if (wr == 1) PG8_BAR;
        PG8_WAIT_V(2); PG8_BAR;
        PG8_STAGE(PG8_SB(1, 0), cB + kstep, voffB); PG8_STAGE(PG8_SA(1, 0), cA + kstep, voffA); PG8_STAGE(PG8_SB(1, 1), cB + hstep + kstep, voffB);
        PG8_WAIT_V(6); PG8_BAR;
    } else {
        PG8_STAGE(PG8_SB(0, 0), cB, voffB); PG8_STAGE(PG8_SA(0, 0), cA, voffA); PG8_STAGE(PG8_SB(0, 1), cB + hstep, voffB); PG8_STAGE(PG8_SA(0, 1), cA + hstep, voffA);
        if (wr == 1) PG8_BAR;
        PG8_WAIT_V(4); PG8_BAR;
        PG8_STAGE(PG8_SB(1, 0), cB + kstep, voffB); PG8_STAGE(PG8_SA(1, 0), cA + kstep, voffA); PG8_STAGE(PG8_SB(1, 1), cB + hstep + kstep, voffB);
        PG8_WAIT_V(6); PG8_BAR;
    }
    for (;;) {
        const bool has_next = S.next(ui + 1, nxt);
        const char* nA = has_next ? (const char*)g.A + (size_t)nxt.pm * tstep : cA; const char* nB = has_next ? (const char*)g.Bt + (size_t)nxt.pn * tstep : cB;
        for (int t = 0; t < nt; t += 2) {
            const bool last = (t == nt - 2);
            const char* a1 = cA + (size_t)(t + 1) * kstep;
            const char* a2 = last ? nA : cA + (size_t)(t + 2) * kstep; const char* b2 = last ? nB : cB + (size_t)(t + 2) * kstep;
            const char* a3 = a2 + kstep; const char* b3 = b2 + kstep;
            if (last && has_next) S.a_ready(nxt);
            if constexpr (SP2) {
            PG8_LDB(B0, 0, 0); PG8_LDB(B1, 0, 1); PG8_SCHED; PG8_LDA(At, 0, 0); PG8_STAGE(PG8_SA(1, 1), a1 + hstep, voffA);
            PG8_WAIT_V(8); PG8_WAIT_L(0); PG8_BAR; PG8_MMA(0, 0, At, B0); PG8_MMA(0, 1, At, B1); PG8_BAR; PG8_SCHED;
            PG8_LDA(At, 0, 1); PG8_STAGE(PG8_SB(0, 0), b2, voffB); PG8_STAGE(PG8_SB(0, 1), b2 + hstep, voffB); PG8_STAGE(PG8_SA(0, 0), a2, voffA);
            PG8_WAIT_V(8); PG8_WAIT_L(0); PG8_BAR; PG8_MMA(1, 0, At, B0); PG8_MMA(1, 1, At, B1); PG8_BAR; PG8_SCHED;
            PG8_LDB(B0, 1, 0); PG8_LDB(B1, 1, 1); PG8_SCHED; PG8_LDA(At, 1, 0); PG8_STAGE(PG8_SA(0, 1), a2 + hstep, voffA);
            PG8_WAIT_V(8); PG8_WAIT_L(0); PG8_BAR; PG8_MMA(0, 0, At, B0); PG8_MMA(0, 1, At, B1); PG8_BAR; PG8_SCHED;
            PG8_LDA(At, 1, 1); PG8_STAGE(PG8_SB(1, 0), b3, voffB); PG8_STAGE(PG8_SB(1, 1), b3 + hstep, voffB); PG8_STAGE(PG8_SA(1, 0), a3, voffA);
            PG8_WAIT_V(8); PG8_WAIT_L(0); PG8_BAR; PG8_MMA(1, 0, At, B0); PG8_MMA(1, 1, At, B1); PG8_BAR; PG8_SCHED;
            } else {
            PG8_LDB(B0, 0, 0); PG8_SCHED; PG8_LDA(At, 0, 0); PG8_STAGE(PG8_SA(1, 1), a1 + hstep, voffA);
            PG8_WAIT_L(8); PG8_BAR; PG8_WAIT_L(0); PG8_MMA(0, 0, At, B0); PG8_BAR; PG8_SCHED;
            PG8_LDB(B1, 0, 1); PG8_STAGE(PG8_SB(0, 0), b2, voffB);
            PG8_BAR; PG8_WAIT_L(0); PG8_MMA(0, 1, At, B1); PG8_BAR;
            PG8_LDA(At, 0, 1); PG8_STAGE(PG8_SA(0, 0), a2, voffA);
            PG8_BAR; PG8_WAIT_L(0); PG8_MMA(1, 0, At, B0); PG8_BAR; PG8_SCHED;
            PG8_STAGE(PG8_SB(0, 1), b2 + hstep, voffB);
            PG8_WAIT_V(6); PG8_BAR; PG8_MMA(1, 1, At, B1); PG8_BAR;
            PG8_LDB(B0, 1, 0); PG8_SCHED; PG8_LDA(At, 1, 0); PG8_STAGE(PG8_SA(0, 1), a2 + hstep, voffA);
            PG8_WAIT_L(8); PG8_BAR; PG8_WAIT_L(0); PG8_MMA(0, 0, At, B0); PG8_BAR; PG8_SCHED;
            PG8_LDB(B1, 1, 1); PG8_STAGE(PG8_SB(1, 0), b3, voffB);
            PG8_BAR; PG8_WAIT_L(0); PG8_MMA(0, 1, At, B1); PG8_BAR;
            PG8_LDA(At, 1, 1); PG8_STAGE(PG8_SA(1, 0), a3, voffA);
            PG8_BAR; PG8_WAIT_L(0); PG8_MMA(1, 0, At, B0); PG8_BAR; PG8_SCHED;
            PG8_STAGE(PG8_SB(1, 1), b3 + hstep, voffB);
            PG8_WAIT_V(6); PG8_BAR; PG8_MMA(1, 1, At, B1); PG8_BAR;
            }
        }
        if constexpr (ALIGN_EPI) { if (wr == 0) PG8_BAR; }
        if constexpr (!Epi::AFTER_DRAIN) { E(acc, cur, wr, wc, fr, fq); S.done(cur); }
        if (!has_next) break;
#pragma unroll
        for (int a = 0; a < 2; ++a)
#pragma unroll
            for (int b = 0; b < 2; ++b)
#pragma unroll
                for (int m = 0; m < 4; ++m)
#pragma unroll
                    for (int n = 0; n < 2; ++n) acc[a][b][m][n] = (f32x4){0.f, 0.f, 0.f, 0.f};
        cur = nxt; cA = nA; cB = nB; ++ui;
        if constexpr (ALIGN_EPI) { if (wr == 1) PG8_BAR; }
    }
    PG8_WAIT_V(0);
    if constexpr (!ALIGN_EPI) { if (wr == 0) PG8_BAR; }
    PG8_BAR;
    if constexpr (Epi::AFTER_DRAIN) { E.fused(acc, cur, wr, wc, fr, fq, lds, wid, lane); S.done(cur); }
#undef PG8_SA
#undef PG8_SB
#undef PG8_STAGE
#undef PG8_LDA
#undef PG8_LDB
#undef PG8_MMA
#undef PG8_WAIT_V
#undef PG8_WAIT_L
#undef PG8_BAR
#undef PG8_SCHED
}
}
namespace fx {
#define LAS __attribute__((address_space(3)))
typedef unsigned short bf16_t;
typedef short bf16x8 __attribute__((ext_vector_type(8)));
typedef short s16x4 __attribute__((ext_vector_type(4)));
typedef float f32x4 __attribute__((ext_vector_type(4)));
typedef float f32x16 __attribute__((ext_vector_type(16)));
typedef unsigned u32x4 __attribute__((ext_vector_type(4)));
typedef unsigned u32x2 __attribute__((ext_vector_type(2)));
constexpr int D = 1024, TP = 16384, TS = 512, T = TP + TS, FF = 4096, NWAVES = 8;
constexpr float LOG2E = 1.4426950408889634f, QSC = 0.125f * LOG2E;

typedef float f32x2_t __attribute__((ext_vector_type(2))); typedef __bf16 bf16x2_t __attribute__((ext_vector_type(2)));
__device__ __forceinline__ unsigned cvtpk(float lo, float hi) { f32x2_t v = {lo, hi}; bf16x2_t b = __builtin_convertvector(v, bf16x2_t); return __builtin_bit_cast(unsigned, b); }
__device__ __forceinline__ u32x4 pack8(f32x4 a, f32x4 b) { u32x4 w; w.x = cvtpk(a.x, a.y); w.y = cvtpk(a.z, a.w); w.z = cvtpk(b.x, b.y); w.w = cvtpk(b.z, b.w); return w; }
__device__ __forceinline__ float wave_sum(float v) {
#pragma unroll
    for (int o = 32; o; o >>= 1) v += __shfl_xor(v, o);
    return v;
}
__device__ __forceinline__ int t5_bucket(int rel) {
    const int ret = rel > 0 ? 16 : 0; const int n = rel < 0 ? -rel : rel;
    const int b = n < 8 ? n : n < 12 ? 8 : n < 16 ? 9 : n < 23 ? 10 : n < 32 ? 11 : n < 46 ? 12 : n < 64 ? 13 : n < 91 ? 14 : 15;
    return ret + b;
}
__device__ __forceinline__ int crow(int r, int hi) { return (r & 3) + 8 * (r >> 2) + 4 * hi; }
constexpr size_t MiB = 1u << 20;
#if defined(FX_STAMP) && FX_STAMP
constexpr size_t WS_CTL = 0, CTL_ZERO_BYTES = 1 * MiB;
#else
constexpr size_t WS_CTL = 0, CTL_ZERO_BYTES = 128 * 1024;
#endif
constexpr size_t WL_QKV = 0, WL_O = (size_t)3072 * 1024 * 2, WL_UP = WL_O + (size_t)1024 * 1024 * 2, WL_DN = WL_UP + (size_t)4096 * 1024 * 2, WL_BYTES = WL_DN + (size_t)4096 * 1024 * 2;
constexpr size_t WS_W = 1 * MiB, WS_XN = WS_W + 4 * WL_BYTES, ACT_B = (size_t)T * D * 2;
constexpr size_t WS_Q = WS_XN + ACT_B, WS_K = WS_Q + ACT_B, WS_V = WS_K + ACT_B, WS_O = WS_V + ACT_B, WS_U = WS_Q, WS_XR = WS_O + ACT_B, WS_SLAB = WS_XR + ACT_B, WS_RSS = WS_SLAB + 4 * (size_t)TS * D * 4, WS_END = WS_RSS + (size_t)TP * 16 * 4;
static_assert(WL_BYTES == 24 * MiB && WS_END < 320 * MiB, "ws map");
constexpr int CW_TMO = 0, CW_CODE = 1, CW_BAR = 4096, CW_FLAG = 16384;
constexpr int RING_BYTES = 131072, LDSCTL_OFF = RING_BYTES, MISC_OFF = LDSCTL_OFF + 320, GA_TAB = LDSCTL_OFF + 512, GA_WSF = GA_TAB + 4 * 160 * 4, GA_FLG = GA_WSF + NWAVES * 64 * 4, LDS_BYTES = 147456;
static_assert(GA_FLG + 64 <= LDS_BYTES, "LDS map");
enum In { X_P = 0, X_S, C_DK, C_DV, C_WK, C_WV, C_BK, C_BV, REL_BIAS, NORM_MIX, NORM_MLP, W_UP, W_DOWN, D_WQKV, D_WO, D_QN, D_KN, D_LAM, D_SUBLN, S_WQKV, S_WO, S_QN, S_KN, S_SINKS, B_WQKV, B_WO };

struct Params {
    const float* in[26];
    unsigned char* ws;
    float* yout;
    float *dkp[2], *dvp[2], *dks[2], *dvs[2];
    float *wkp, *wvp, *wks, *wvs;
    float *bkp, *bvp, *bks, *bvs;
    int ph_lo, ph_hi, li, pad;
};

#define XB_TMO      128
#define XB_XCNT(j)  (256  + 64 * (j))
#define XB_XSUB(j)  (1280 + 64 * (j))
#define XB_XGEN(j)  (2304 + 64 * (j))
#define XB_TOP      3328
#define XB_TOPGEN   3392
#define XCD_BAR_WORDS 3456
#define XB_SPIN_CAP (1u << 18)

__device__ __forceinline__ unsigned xb_ld(unsigned* p)              { return __hip_atomic_load(p, __ATOMIC_RELAXED, __HIP_MEMORY_SCOPE_AGENT); }
__device__ __forceinline__ unsigned xb_add(unsigned* p, unsigned v) { return __hip_atomic_fetch_add(p, v, __ATOMIC_RELAXED, __HIP_MEMORY_SCOPE_AGENT); }
__device__ __forceinline__ unsigned xb_xcc_id() { return (unsigned)__builtin_amdgcn_s_getreg((3 << 11) | 20) & 0xFu; }
#define XB_SPIN(cond, bar) do { unsigned _sp = 0; while (cond) { __builtin_amdgcn_s_sleep(1); \
    if ((++_sp & 255u) == 0u) { if (xb_ld(&(bar)[XB_TMO])) break; if (_sp > XB_SPIN_CAP) { atomicAdd(&(bar)[XB_TMO], 1u); break; } } } } while (0)

struct XcdBarrier {
    unsigned* bar; unsigned x;
    volatile LAS unsigned* st;
};

__device__ __forceinline__ XcdBarrier xcd_barrier_post(unsigned* bar, volatile LAS unsigned* st) {
    XcdBarrier b; b.bar = bar; b.x = xb_xcc_id(); b.st = st;
    if (threadIdx.x == 0) (void)xb_add(&bar[XB_XCNT(b.x)], 1u);
    return b;
}
__device__ __forceinline__ void xcd_barrier_complete(unsigned* bar, unsigned x, unsigned& nloc, unsigned& nx) {
    const unsigned G = gridDim.x * gridDim.y * gridDim.z;
    unsigned sum, cnt, mine, sp = 0u;
    for (;;) {
        sum = 0u; cnt = 0u; mine = 0u;
#pragma unroll
        for (unsigned j = 0; j < 16; ++j) { const unsigned c = xb_ld(&bar[XB_XCNT(j)]); sum += c; cnt += (c > 0u) ? 1u : 0u; mine = (j == x) ? c : mine; }
        if (sum == G) break;
        __builtin_amdgcn_s_sleep(1);
        if ((++sp & 255u) == 0u) { if (xb_ld(&bar[XB_TMO])) break; if (sp > XB_SPIN_CAP) { atomicAdd(&bar[XB_TMO], 1u); break; } }
    }
    nloc = mine > 0u ? mine : 1u; nx = cnt > 0u ? cnt : 1u;
}

__device__ __forceinline__ void xcd_barrier(const XcdBarrier& b) {
    asm volatile("s_waitcnt vmcnt(0)" ::: "memory");
    __syncthreads();
    if (threadIdx.x == 0) {
        unsigned* bar = b.bar;
        __builtin_amdgcn_s_waitcnt(0);
        unsigned nloc = b.st[0], nx = b.st[1];
        if (nloc == 0u) { xcd_barrier_complete(bar, b.x, nloc, nx); b.st[0] = nloc; b.st[1] = nx; }
        const unsigned old = xb_add(&bar[XB_XSUB(b.x)], 1u);
        const unsigned gen = old / nloc;
        if (old + 1u == (gen + 1u) * nloc) {
            __builtin_amdgcn_fence(__ATOMIC_RELEASE, "agent");
            asm volatile("s_waitcnt vmcnt(0)" ::: "memory");
            const unsigned og = xb_add(&bar[XB_TOP], 1u);
            const unsigned tg = og / nx;
            if (og + 1u == (tg + 1u) * nx) xb_add(&bar[XB_TOPGEN], 1u);
            else XB_SPIN(xb_ld(&bar[XB_TOPGEN]) == tg, bar);
            __builtin_amdgcn_fence(__ATOMIC_ACQUIRE, "agent");
            xb_add(&bar[XB_XGEN(b.x)], 1u);
            asm volatile("s_waitcnt vmcnt(0)" ::: "memory");
        } else {
            XB_SPIN(xb_ld(&bar[XB_XGEN(b.x)]) == gen, bar);
            __builtin_amdgcn_fence(__ATOMIC_ACQUIRE, "agent");
            asm volatile("s_waitcnt vmcnt(0)" ::: "memory");
        }
    }
    __syncthreads();
}


__device__ __forceinline__ unsigned f2bf(float f) { unsigned u = __builtin_bit_cast(unsigned, f); return (u + 0x7fffu + ((u >> 16) & 1u)) >> 16; }
__device__ __forceinline__ unsigned pk2(float lo, float hi) { return f2bf(lo) | (f2bf(hi) << 16); }
struct PItem { const float* W; const float* gk; bf16_t* WT; int K, N, k0, n0, dst; };
__device__ __forceinline__ bool pro_item(const Params& p, int it, PItem& q) {
    constexpr int I_QKV = 16 * 96, I_O = 16 * 32, I_UP = 16 * 128, I_DN = 64 * 32, PER = I_QKV + I_O + I_UP + I_DN;
    const int layer = it / PER, mix = layer % 3, j = layer / 3; int r = it % PER;
    unsigned char* wl = p.ws + WS_W + (size_t)layer * WL_BYTES;
    if (r < I_QKV) {
        const int N = mix == 1 ? 1536 : 3072, nblk = N / 32; if (r >= 16 * nblk) return false;
        const float* W = mix == 0 ? p.in[D_WQKV] + (size_t)j * D * 3072 : (mix == 1 ? p.in[S_WQKV] : p.in[B_WQKV]);
        const int kb = r / nblk, nb = r % nblk, n0 = 32 * nb, within = n0 & 255;
        q.W = W; q.gk = p.in[NORM_MIX] + layer * D; q.WT = (bf16_t*)(wl + WL_QKV); q.K = D; q.N = N; q.k0 = 64 * kb; q.n0 = n0;
        q.dst = (n0 & ~255) + 128 * ((within >> 5) & 1) + 32 * (within >> 6);
        return true; }
    r -= I_QKV;
    if (r < I_O) { q.W = mix == 0 ? p.in[D_WO] + (size_t)j * D * D : (mix == 1 ? p.in[S_WO] : p.in[B_WO]); q.gk = nullptr; q.WT = (bf16_t*)(wl + WL_O); q.K = D; q.N = D; q.k0 = 64 * (r / 32); q.n0 = 32 * (r % 32); q.dst = q.n0; return true; }
    r -= I_O;
    if (r < I_UP) { q.W = p.in[W_UP] + (size_t)layer * D * FF; q.gk = p.in[NORM_MLP] + layer * D; q.WT = (bf16_t*)(wl + WL_UP); q.K = D; q.N = FF; q.k0 = 64 * (r / 128); q.n0 = 32 * (r % 128); q.dst = q.n0; return true; }
    r -= I_UP;
    q.W = p.in[W_DOWN] + (size_t)layer * FF * D; q.gk = nullptr; q.WT = (bf16_t*)(wl + WL_DN); q.K = FF; q.N = D; q.k0 = 64 * (r / 32); q.n0 = 32 * (r % 32); q.dst = q.n0; return true;
}
__device__ __forceinline__ void pro_load(const PItem& q, int lane, f32x4 (&wv)[8]) {
#pragma unroll
    for (int i = 0; i < 8; ++i) wv[i] = *(const f32x4*)(q.W + (size_t)(q.k0 + 8 * i + (lane >> 3)) * q.N + q.n0 + 4 * (lane & 7));
}
__device__ __forceinline__ void pro_store(const PItem& q, int lane, const f32x4 (&wv)[8], LAS float* scr) {
#pragma unroll
    for (int i = 0; i < 8; ++i) { const int kk = 8 * i + (lane >> 3); const float g_ = q.gk ? q.gk[q.k0 + kk] : 1.f; LAS float* d_ = scr + kk * 33 + 4 * (lane & 7);
        d_[0] = wv[i][0] * g_; d_[1] = wv[i][1] * g_; d_[2] = wv[i][2] * g_; d_[3] = wv[i][3] * g_; }
    asm volatile("s_waitcnt lgkmcnt(0)" ::: "memory");
    const int c = lane & 7;
#pragma unroll
    for (int j = 0; j < 4; ++j) { const int n = (lane >> 3) + 8 * j; const LAS float* s = scr + (8 * c) * 33 + n;
        u32x4 o; o.x = pk2(s[0 * 33], s[1 * 33]); o.y = pk2(s[2 * 33], s[3 * 33]); o.z = pk2(s[4 * 33], s[5 * 33]); o.w = pk2(s[6 * 33], s[7 * 33]);
        *(u32x4*)(q.WT + (size_t)(q.dst + n) * q.K + q.k0 + 8 * c) = o; }
    asm volatile("s_waitcnt lgkmcnt(0)" ::: "memory");
}
__device__ __forceinline__ void prologue(const Params& p, LAS unsigned char* lds, int gw, int NGW, int wave, int lane) {
    LAS float* scr = (LAS float*)(lds + wave * 16384);
    constexpr int NIT = 4 * (16 * 96 + 16 * 32 + 16 * 128 + 64 * 32);
    PItem a, b; f32x4 wa[8], wb[8]; int it = gw; bool va = false, vb = false;
    while (it < NIT && !(va = pro_item(p, it, a))) it += NGW;
    if (va) pro_load(a, lane, wa);
    if (va) { it += NGW; while (it < NIT && !(vb = pro_item(p, it, b))) it += NGW; }
    if (vb) pro_load(b, lane, wb);
    while (va) {
        PItem c; f32x4 wc[8]; bool vc = false;
        if (vb) { it += NGW; while (it < NIT && !(vc = pro_item(p, it, c))) it += NGW; }
        if (vc) pro_load(c, lane, wc);
        pro_store(a, lane, wa, scr);
        a = b; va = vb; b = c; vb = vc;
#pragma unroll
        for (int i = 0; i < 8; ++i) { wa[i] = wb[i]; wb[i] = wc[i]; }
    }
    for (int i = gw * 64 + lane; i < 16 * 96 * 64; i += NGW * 64) { const int c4 = i & 63, r = (i >> 6) % 96, b = i / (96 * 64);
        ((f32x4*)p.wks)[((size_t)b * 128 + r) * 64 + c4] = ((const f32x4*)p.in[C_WK])[((size_t)b * 128 + r + 32) * 64 + c4];
        ((f32x4*)p.wvs)[((size_t)b * 128 + r) * 64 + c4] = ((const f32x4*)p.in[C_WV])[((size_t)b * 128 + r + 32) * 64 + c4]; }
}
__device__ __forceinline__ void rms_phase(const float* xp32, const float* xs32, bf16_t* xb, const float* slab, int row_lo, bf16_t* XN, int gw, int NGW, int lane) {
    for (int row = row_lo + gw; row < T; row += NGW) {
        f32x4 v[4]; const bool smp = row >= TP; const float* x32 = smp ? xs32 : xp32;
        if (!x32) { const u32x4* xr = (const u32x4*)(xb + (size_t)row * D) + 2 * lane; const u32x4 a = xr[0], c = xr[1];
            v[0] = (f32x4){__uint_as_float(a.x << 16), __uint_as_float(a.x & 0xffff0000u), __uint_as_float(a.y << 16), __uint_as_float(a.y & 0xffff0000u)};
            v[1] = (f32x4){__uint_as_float(a.z << 16), __uint_as_float(a.z & 0xffff0000u), __uint_as_float(a.w << 16), __uint_as_float(a.w & 0xffff0000u)};
            v[2] = (f32x4){__uint_as_float(c.x << 16), __uint_as_float(c.x & 0xffff0000u), __uint_as_float(c.y << 16), __uint_as_float(c.y & 0xffff0000u)};
            v[3] = (f32x4){__uint_as_float(c.z << 16), __uint_as_float(c.z & 0xffff0000u), __uint_as_float(c.w << 16), __uint_as_float(c.w & 0xffff0000u)}; }
        else { const f32x4* xr = (const f32x4*)(x32 + (size_t)(smp ? row - TP : row) * D) + 4 * lane;
#pragma unroll
            for (int j = 0; j < 4; ++j) v[j] = xr[j]; }
        if (smp && slab) {
#pragma unroll
            for (int ks = 0; ks < 4; ++ks) { const f32x4* sr = (const f32x4*)(slab + ((size_t)ks * TS + (row - TP)) * D) + 4 * lane;
#pragma unroll
                for (int j = 0; j < 4; ++j) v[j] = v[j] + sr[j]; }
            u32x4 s0, s1; s0.x = cvtpk(v[0].x, v[0].y); s0.y = cvtpk(v[0].z, v[0].w); s0.z = cvtpk(v[1].x, v[1].y); s0.w = cvtpk(v[1].z, v[1].w);
            s1.x = cvtpk(v[2].x, v[2].y); s1.y = cvtpk(v[2].z, v[2].w); s1.z = cvtpk(v[3].x, v[3].y); s1.w = cvtpk(v[3].z, v[3].w);
            u32x4* xo = (u32x4*)(xb + (size_t)row * D) + 2 * lane; xo[0] = s0; xo[1] = s1;
            v[0] = (f32x4){__uint_as_float(s0.x << 16), __uint_as_float(s0.x & 0xffff0000u), __uint_as_float(s0.y << 16), __uint_as_float(s0.y & 0xffff0000u)};
            v[1] = (f32x4){__uint_as_float(s0.z << 16), __uint_as_float(s0.z & 0xffff0000u), __uint_as_float(s0.w << 16), __uint_as_float(s0.w & 0xffff0000u)};
            v[2] = (f32x4){__uint_as_float(s1.x << 16), __uint_as_float(s1.x & 0xffff0000u), __uint_as_float(s1.y << 16), __uint_as_float(s1.y & 0xffff0000u)};
            v[3] = (f32x4){__uint_as_float(s1.z << 16), __uint_as_float(s1.z & 0xffff0000u), __uint_as_float(s1.w << 16), __uint_as_float(s1.w & 0xffff0000u)}; }
        float s = 0.f;
#pragma unroll
        for (int j = 0; j < 4; ++j) s += (v[j].x * v[j].x + v[j].y * v[j].y) + (v[j].z * v[j].z + v[j].w * v[j].w);
        const float r = rsqrtf(wave_sum(s) * (1.f / D) + 1e-6f);
        u32x4 w0, w1; f32x4 y;
        y = v[0] * r; w0.x = cvtpk(y.x, y.y); w0.y = cvtpk(y.z, y.w); y = v[1] * r; w0.z = cvtpk(y.x, y.y); w0.w = cvtpk(y.z, y.w);
        y = v[2] * r; w1.x = cvtpk(y.x, y.y); w1.y = cvtpk(y.z, y.w); y = v[3] * r; w1.z = cvtpk(y.x, y.y); w1.w = cvtpk(y.z, y.w);
        u32x4* o = (u32x4*)(XN + (size_t)row * D) + 2 * lane; o[0] = w0; o[1] = w1;
    }
}
__device__ __forceinline__ void rms0_phase(const float* xp32, const float* xs32, bf16_t* XN, int gw, int NGW, int lane) {
    int row = gw; if (row >= T) return;
    f32x4 v[4];
    { const f32x4* xr = (const f32x4*)((row >= TP ? xs32 + (size_t)(row - TP) * D : xp32 + (size_t)row * D)) + 4 * lane;
#pragma unroll
      for (int j = 0; j < 4; ++j) v[j] = xr[j]; }
    for (;;) {
        const int nrow = row + NGW; f32x4 w[4];
        if (nrow < T) { const f32x4* xr = (const f32x4*)((nrow >= TP ? xs32 + (size_t)(nrow - TP) * D : xp32 + (size_t)nrow * D)) + 4 * lane;
#pragma unroll
            for (int j = 0; j < 4; ++j) w[j] = xr[j]; }
        float s = 0.f;
#pragma unroll
        for (int j = 0; j < 4; ++j) s += (v[j].x * v[j].x + v[j].y * v[j].y) + (v[j].z * v[j].z + v[j].w * v[j].w);
        const float r = rsqrtf(wave_sum(s) * (1.f / D) + 1e-6f);
        u32x4 w0, w1; f32x4 y;
        y = v[0] * r; w0.x = cvtpk(y.x, y.y); w0.y = cvtpk(y.z, y.w); y = v[1] * r; w0.z = cvtpk(y.x, y.y); w0.w = cvtpk(y.z, y.w);
        y = v[2] * r; w1.x = cvtpk(y.x, y.y); w1.y = cvtpk(y.z, y.w); y = v[3] * r; w1.z = cvtpk(y.x, y.y); w1.w = cvtpk(y.z, y.w);
        u32x4* o = (u32x4*)(XN + (size_t)row * D) + 2 * lane; o[0] = w0; o[1] = w1;
        if (nrow >= T) break;
        row = nrow;
#pragma unroll
        for (int j = 0; j < 4; ++j) v[j] = w[j];
    }
}
typedef short v4i16_t __attribute__((ext_vector_type(4)));
__device__ __forceinline__ s16x4 vtr(const LAS unsigned char* p) { return __builtin_bit_cast(s16x4, __builtin_amdgcn_ds_read_tr16_b64_v4i16((LAS v4i16_t*)p)); }
#define MFMA32(a, b, c) __builtin_amdgcn_mfma_f32_32x32x16_bf16(a, b, c, 0, 0, 0)
enum { M_DIFF_P = 0, M_DIFF_S, M_SWA_P, M_SWA_S, M_SB_P, M_SB_S };

struct RawPiece { u32x4 a, b; };
__device__ __forceinline__ RawPiece ld_piece(const void* src, bool f32, size_t elem_off, bool valid) {
    RawPiece r; r.a = (u32x4){0u, 0u, 0u, 0u}; r.b = r.a;
    if (valid) { if (f32) { const u32x4* s = (const u32x4*)((const float*)src + elem_off); r.a = __builtin_nontemporal_load(s); r.b = __builtin_nontemporal_load(s + 1); }     else r.a = *(const u32x4*)((const bf16_t*)src + elem_off); }
    return r;
}
__device__ __forceinline__ u32x4 cv_piece(const RawPiece& r, bool f32) { return f32 ? pack8(__builtin_bit_cast(f32x4, r.a), __builtin_bit_cast(f32x4, r.b)) : r.a; }

template <int MODE>
__device__ __forceinline__ void attn_unit(const Params& p, LAS unsigned char* lds, int ua, int ub, int j, float lam, float lam_init, const bf16_t* Qb, const bf16_t* Kb, const bf16_t* Vb, bf16_t* Ob) {
    constexpr bool IS_DIFF = MODE == M_DIFF_P || MODE == M_DIFF_S, IS_SWA = MODE == M_SWA_P || MODE == M_SWA_S, IS_SB = MODE == M_SB_P || MODE == M_SB_S;
    constexpr int DV = IS_DIFF ? 128 : 64, NDB = DV / 32, NKS = IS_DIFF ? 2 : (IS_SWA ? 1 : 4), NVS = IS_DIFF ? 1 : (IS_SWA ? 1 : 4), LDKV = IS_SWA ? 256 : 1024;
    constexpr int NTAB = IS_DIFF ? 2 : 4;
    const int tid = pg8::otid(), lane = tid & 63, r32 = lane & 31, hi = lane >> 5; const int wid = __builtin_amdgcn_readfirstlane(tid >> 6);
    LAS float* tab = (LAS float*)(lds + GA_TAB); LAS float* wsf = (LAS float*)(lds + GA_WSF) + wid * 64; LAS unsigned* flg = (LAS unsigned*)(lds + GA_FLG);
    bool compute = true; int qrow0 = 0, qcol = 0, tq0 = 0, kslot = 0, vslot = 0, tsel = 0, kvcol = 0, ntiles = 0, hq = 0, grp = 0;
    if (MODE == M_DIFF_P) { const int m = wid & 1; grp = wid >> 1; qrow0 = ub * 128 + grp * 32; qcol = (2 * ua + m) * 64; tq0 = qrow0; kslot = m; tsel = m; kvcol = ua * 128; ntiles = 2 * ub + 2; }
    if (MODE == M_DIFF_S) { compute = wid < 2; const int m = wid & 1; qrow0 = TP + ua * 32; qcol = (2 * ub + m) * 64; tq0 = 0; kslot = m; tsel = m; kvcol = ub * 128; ntiles = 33; }
    if (MODE == M_SWA_P)  { grp = wid >> 1; hq = ub * 4 + grp; qrow0 = ua * 64 + (wid & 1) * 32; qcol = hq * 64; tq0 = qrow0; tsel = grp; kvcol = ub * 64; ntiles = 3; }
    if (MODE == M_SWA_S)  { compute = wid < 4; grp = wid & 3; hq = ub * 4 + grp; qrow0 = TP + ua * 32; qcol = hq * 64; tq0 = 0; tsel = grp; kvcol = ub * 64; ntiles = 3; }
    if (MODE == M_SB_P)   { grp = wid >> 1; qrow0 = ua * 64 + (wid & 1) * 32; qcol = (ub * 4 + grp) * 64; tq0 = qrow0; kslot = grp; vslot = grp; kvcol = ub * 256; ntiles = ua + 1; }
    if (MODE == M_SB_S)   { compute = wid < 4; grp = wid & 3; qrow0 = TP + ua * 32; qcol = (ub * 4 + grp) * 64; tq0 = 0; kslot = grp; vslot = grp; kvcol = ub * 256; ntiles = 33; }
    __syncthreads();
    bf16x8 qr[4];
    { const bf16_t* qp = Qb + (size_t)(qrow0 + r32) * 1024 + qcol + hi * 8;
#pragma unroll
      for (int d0 = 0; d0 < 4; ++d0) qr[d0] = *(const bf16x8*)(qp + d0 * 16); }
    f32x16 o[NDB];
#pragma unroll
    for (int db = 0; db < NDB; ++db)
#pragma unroll
        for (int r = 0; r < 16; ++r) o[db][r] = 0.f;
    float l = 0.f, acc = 0.f; bool mydone = !compute;
    if (IS_SWA) l = hi == 0 ? __builtin_amdgcn_exp2f(p.in[S_SINKS][hq] * LOG2E) : 0.f;
    const int tq = tq0 + r32;
    const LAS unsigned char* kbase = lds + kslot * 8192 + hi * 1024 + r32 * 16;
    const LAS unsigned char* vbase = lds + 32768 + vslot * (DV * 128) + ((lane >> 4) & 1) * 32 + (lane & 3) * 8 + (4 * hi + ((lane & 15) >> 2)) * 64;
    struct Desc { const void *kp, *vp; bool f32, tvalid, active, far; int nvalid, pos0; };
    auto desc = [&](int it) { Desc d; d.kp = nullptr; d.vp = nullptr; d.f32 = false; d.tvalid = true; d.active = true; d.far = false; d.nvalid = 64; d.pos0 = 0;
        if (MODE == M_DIFF_P) { const size_t off = (size_t)it * 64 * 1024 + kvcol; d.kp = Kb + off; d.vp = Vb + off; d.pos0 = it * 64; d.active = it <= 2 * ub + (grp >> 1); d.far = (d.pos0 + 63 - tq0) <= -91; }
        if (MODE == M_DIFF_S) { if (it < 32) { const size_t off = ((size_t)(j * 16 + ua) * 2048 + it * 64) * 1024 + kvcol; d.kp = p.in[C_DK] + off; d.vp = p.in[C_DV] + off; d.f32 = true; d.pos0 = -2048 + it * 64; d.far = d.pos0 + 63 <= -91; }
                                else { const size_t off = (size_t)(TP + ua * 32) * 1024 + kvcol; d.kp = Kb + off; d.vp = Vb + off; d.nvalid = 32; d.pos0 = 0; } }
        if (MODE == M_SWA_P)  { const int tc = ua - 2 + it; d.tvalid = tc >= 0; const size_t off = (size_t)(tc < 0 ? 0 : tc) * 64 * 256 + kvcol; d.kp = Kb + off; d.vp = Vb + off; d.pos0 = tc * 64; }
        if (MODE == M_SWA_S)  { if (it < 2) { const size_t off = ((size_t)ua * 128 + it * 64) * 256 + kvcol; d.kp = p.in[C_WK] + off; d.vp = p.in[C_WV] + off; d.f32 = true; d.pos0 = -128 + it * 64; }
                                else { const size_t off = (size_t)(TP + ua * 32) * 256 + kvcol; d.kp = Kb + off; d.vp = Vb + off; d.nvalid = 32; d.pos0 = 0; } }
        if (MODE == M_SB_P)   { const int tc = ua - it; const size_t off = (size_t)tc * 64 * 1024 + kvcol; d.kp = Kb + off; d.vp = Vb + off; d.pos0 = tc * 64; }
        if (MODE == M_SB_S)   { if (it == 0) { const size_t off = (size_t)(TP + ua * 32) * 1024 + kvcol; d.kp = Kb + off; d.vp = Vb + off; d.nvalid = 32; d.pos0 = 0; }
                                else { const int tc = 32 - it; const size_t off = ((size_t)ua * 2048 + tc * 64) * 1024 + kvcol; d.kp = p.in[C_BK] + off; d.vp = p.in[C_BV] + off; d.f32 = true; d.pos0 = -2048 + tc * 64; } }
        return d; };
    constexpr int NVP = NVS * (DV / 64);
    RawPiece rk[NKS], rv[NVP];
    const int kkey = (tid & 7) + 8 * (tid >> 6), kchunk = (tid >> 3) & 7, vkey = (tid >> 2) & 63, vpl = tid & 3, vdb = tid >> 8;
#define GA_LOAD(d) do { if ((d).tvalid) { \
        _Pragma("unroll") for (int s_ = 0; s_ < NKS; ++s_) rk[s_] = ld_piece((d).kp, (d).f32, (size_t)kkey * LDKV + s_ * 64 + kchunk * 8, kkey < (d).nvalid); \
        _Pragma("unroll") for (int s_ = 0; s_ < NVS; ++s_) _Pragma("unroll") for (int ps_ = 0; ps_ < DV / 64; ++ps_) \
            rv[s_ * (DV / 64) + ps_] = ld_piece((d).vp, (d).f32, (size_t)vkey * LDKV + s_ * DV + (vdb + 2 * ps_) * 32 + vpl * 8, vkey < (d).nvalid); } } while (0)
#define GA_STORE(d) do { if ((d).tvalid) { \
        _Pragma("unroll") for (int s_ = 0; s_ < NKS; ++s_) *(LAS u32x4*)(lds + s_ * 8192 + kchunk * 1024 + kkey * 16) = cv_piece(rk[s_], (d).f32); \
        _Pragma("unroll") for (int s_ = 0; s_ < NVS; ++s_) _Pragma("unroll") for (int ps_ = 0; ps_ < DV / 64; ++ps_) \
            *(LAS u32x4*)(lds + 32768 + s_ * (DV * 128) + (vdb + 2 * ps_) * 4096 + vkey * 64 + vpl * 16) = cv_piece(rv[s_ * (DV / 64) + ps_], (d).f32); } } while (0)
    { const Desc d0 = desc(0); GA_LOAD(d0); }
    if (!IS_SB) {
        for (int idx = tid; idx < NTAB * 155; idx += NWAVES * 64) { const int ti = idx / 155, i = idx % 155;
            const int head = IS_DIFF ? 2 * (MODE == M_DIFF_P ? ua : ub) + ti : ub * 4 + ti;
            float v = p.in[REL_BIAS][t5_bucket(i - 91) * 16 + head];
            if (IS_DIFF) v -= p.in[REL_BIAS][15 * 16 + head];
            tab[ti * 160 + i] = v * LOG2E; }
    }
    for (int it = 0; it < ntiles; ++it) {
        const Desc d = desc(it);
        const bool f32 = d.f32, tvalid = d.tvalid, active = d.active, far = d.far; const int nvalid = d.nvalid, pos0 = d.pos0; (void)f32;
        GA_STORE(d);
        __syncthreads();
        if (it + 1 < ntiles) { const Desc dn = desc(it + 1); GA_LOAD(dn); }
        if (tvalid && compute && active && !mydone) {
            f32x16 p0, p1;
#pragma unroll
            for (int r = 0; r < 16; ++r) { p0[r] = 0.f; p1[r] = 0.f; }
#pragma unroll
            for (int d0 = 0; d0 < 4; ++d0) { const bf16x8 b0 = *(const LAS bf16x8*)(kbase + d0 * 2048), b1 = *(const LAS bf16x8*)(kbase + d0 * 2048 + 512);
                p0 = MFMA32(b0, qr[d0], p0); p1 = MFMA32(b1, qr[d0], p1); }
            if (!IS_SB) {
                const LAS float* tb = tab + tsel * 160; const int relb = pos0 - tq + 91; float ls = 0.f;
#pragma unroll
                for (int r = 0; r < 16; ++r) { const int kv = crow(r, hi); float s0 = p0[r], s1 = p1[r];
                    if (!far) { int i0 = relb + kv, i1 = i0 + 32; i0 = i0 < 0 ? 0 : (i0 > 154 ? 154 : i0); i1 = i1 < 0 ? 0 : (i1 > 154 ? 154 : i1); s0 += tb[i0]; s1 += tb[i1]; }
                    float e0 = __builtin_amdgcn_exp2f(s0), e1 = __builtin_amdgcn_exp2f(s1);
                    if (kv >= nvalid) e0 = 0.f; if (kv + 32 >= nvalid) e1 = 0.f;
                    p0[r] = e0; p1[r] = e1; ls += e0 + e1; }
                l += ls;
            } else {
                float L0[16], L1[16];
#pragma unroll
                for (int r = 0; r < 16; ++r) { const int kv = crow(r, hi);
                    if (!(kv < nvalid && pos0 + kv < tq)) p0[r] = -INFINITY;
                    if (!(kv + 32 < nvalid && pos0 + kv + 32 < tq)) p1[r] = -INFINITY;
                    L0[r] = __builtin_amdgcn_logf(1.f + __builtin_amdgcn_exp2f(p0[r])); L1[r] = __builtin_amdgcn_logf(1.f + __builtin_amdgcn_exp2f(p1[r])); }
                float gs[8], go[8];
#pragma unroll
                for (int g = 0; g < 4; ++g) { gs[g] = (L0[4 * g] + L0[4 * g + 1]) + (L0[4 * g + 2] + L0[4 * g + 3]); gs[4 + g] = (L1[4 * g] + L1[4 * g + 1]) + (L1[4 * g + 2] + L1[4 * g + 3]); }
#pragma unroll
                for (int g = 0; g < 8; ++g) go[g] = __shfl_xor(gs[g], 32);
                float after = 0.f;
#pragma unroll
                for (int g = 7; g >= 0; --g) {
                    float run = after + (hi == 0 ? go[g] : 0.f);
#pragma unroll
                    for (int i = 3; i >= 0; --i) { const int r = 4 * (g & 3) + i;
                        if (g < 4) { const float Lr = L0[r]; p0[r] = __builtin_amdgcn_exp2f(p0[r] - Lr + acc - run); run += Lr; }
                        else       { const float Lr = L1[r]; p1[r] = __builtin_amdgcn_exp2f(p1[r] - Lr + acc - run); run += Lr; } }
                    after += gs[g] + go[g];
                }
                acc -= after;
                mydone = __all(acc < -152.f);
            }
            u32x4 pw[4];
            pw[0] = (u32x4){cvtpk(p0[0], p0[1]), cvtpk(p0[2], p0[3]), cvtpk(p0[4], p0[5]), cvtpk(p0[6], p0[7])};
            pw[1] = (u32x4){cvtpk(p0[8], p0[9]), cvtpk(p0[10], p0[11]), cvtpk(p0[12], p0[13]), cvtpk(p0[14], p0[15])};
            pw[2] = (u32x4){cvtpk(p1[0], p1[1]), cvtpk(p1[2], p1[3]), cvtpk(p1[4], p1[5]), cvtpk(p1[6], p1[7])};
            pw[3] = (u32x4){cvtpk(p1[8], p1[9]), cvtpk(p1[10], p1[11]), cvtpk(p1[12], p1[13]), cvtpk(p1[14], p1[15])};
#pragma unroll
            for (int db = 0; db < NDB; ++db)
#pragma unroll
                for (int ks = 0; ks < 4; ++ks) { const s16x4 lo = vtr(vbase + db * 4096 + ks * 1024), hh = vtr(vbase + db * 4096 + ks * 1024 + 512);
                    const bf16x8 vf = (bf16x8){lo[0], lo[1], lo[2], lo[3], hh[0], hh[1], hh[2], hh[3]};
                    o[db] = MFMA32(__builtin_bit_cast(bf16x8, pw[ks]), vf, o[db]); }
        }
        if (IS_SB) { if (lane == 0) flg[wid] = mydone ? 1u : 0u; }
        __syncthreads();
        if (IS_SB) { unsigned all = 1u;
#pragma unroll
            for (int w = 0; w < NWAVES; ++w) all &= flg[w];
            if (all) break; }
    }
#undef GA_LOAD
#undef GA_STORE
    LAS float* st = (LAS float*)(lds + wid * (32 * DV * 4));
    if (compute) {
        float rinv[16];
        if (!IS_SB) { const float lt = l + __shfl_xor(l, 32); if (hi == 0) wsf[r32] = lt;
            asm volatile("s_waitcnt lgkmcnt(0)" ::: "memory");
#pragma unroll
            for (int r = 0; r < 16; ++r) rinv[r] = 1.f / wsf[crow(r, hi)]; }
        else {
#pragma unroll
            for (int r = 0; r < 16; ++r) rinv[r] = 1.f; }
#pragma unroll
        for (int db = 0; db < NDB; ++db)
#pragma unroll
            for (int r = 0; r < 16; ++r) st[crow(r, hi) * DV + 32 * db + r32] = o[db][r] * rinv[r];
    }
    __syncthreads();
    if (compute) {
        if (IS_DIFF) {
            const int pair = wid >> 1, row = 16 * (wid & 1) + (lane >> 2), qd = lane & 3;
            const LAS float* s0 = (const LAS float*)(lds + (2 * pair) * 16384) + row * 128 + qd * 32; const LAS float* s1 = s0 + 4096;
            const int head = MODE == M_DIFF_P ? ua : ub; const size_t orow = MODE == M_DIFF_P ? (size_t)ub * 128 + pair * 32 + row : (size_t)TP + ua * 32 + row;
            float x[32]; float ss = 0.f;
#pragma unroll
            for (int e = 0; e < 32; ++e) { x[e] = s0[e] - lam * s1[e]; ss += x[e] * x[e]; }
            ss += __shfl_xor(ss, 1); ss += __shfl_xor(ss, 2);
            const float rs = rsqrtf(ss * (1.f / 128.f) + 1e-6f) * (1.f - lam_init);
            const float* sg = p.in[D_SUBLN] + j * 128 + qd * 32; bf16_t* op = Ob + orow * 1024 + head * 128 + qd * 32;
#pragma unroll
            for (int c = 0; c < 4; ++c) { u32x4 w;
                w.x = cvtpk(x[8 * c] * rs * sg[8 * c], x[8 * c + 1] * rs * sg[8 * c + 1]); w.y = cvtpk(x[8 * c + 2] * rs * sg[8 * c + 2], x[8 * c + 3] * rs * sg[8 * c + 3]);
                w.z = cvtpk(x[8 * c + 4] * rs * sg[8 * c + 4], x[8 * c + 5] * rs * sg[8 * c + 5]); w.w = cvtpk(x[8 * c + 6] * rs * sg[8 * c + 6], x[8 * c + 7] * rs * sg[8 * c + 7]);
                *(u32x4*)(op + 8 * c) = w; }
        } else {
            const int row = lane >> 1, hf = lane & 1; const LAS float* s0 = st + row * 64 + hf * 32; bf16_t* op = Ob + (size_t)(qrow0 + row) * 1024 + qcol + hf * 32;
#pragma unroll
            for (int c = 0; c < 4; ++c) { u32x4 w; w.x = cvtpk(s0[8 * c], s0[8 * c + 1]); w.y = cvtpk(s0[8 * c + 2], s0[8 * c + 3]); w.z = cvtpk(s0[8 * c + 4], s0[8 * c + 5]); w.w = cvtpk(s0[8 * c + 6], s0[8 * c + 7]);
                *(u32x4*)(op + 8 * c) = w; }
        }
    }
}
__device__ __forceinline__ void glds16(const void* gsrc, unsigned lds_dst) {
    unsigned keep;
    asm volatile("s_mov_b32 %0, m0\n\ts_mov_b32 m0, %2\n\ts_nop 0\n\tglobal_load_lds_dwordx4 %1, off\n\ts_mov_b32 m0, %0" : "=&s"(keep) : "v"(gsrc), "s"(lds_dst) : "memory");
}
#define DP_WAIT_BAR(N) asm volatile("s_waitcnt vmcnt(" #N ") lgkmcnt(0)\n\ts_barrier" ::: "memory")
__device__ __forceinline__ void attn_diff_p2(const Params& p, LAS unsigned char* lds, int h, int qb, int j, float lam, float lam_init, const bf16_t* Qb, const bf16_t* Kb, const bf16_t* Vb, bf16_t* Ob) {
    const int tid = pg8::otid(), lane = tid & 63, r32 = lane & 31, hi = lane >> 5; const int wid = __builtin_amdgcn_readfirstlane(tid >> 6);
    const int m = wid & 1, grp = wid >> 1, qrow0 = qb * 128 + grp * 32, NT = 2 * qb + 2, tlast = 2 * qb + (grp >> 1);
    LAS float* tab = (LAS float*)(lds + GA_TAB); LAS float* wsf = (LAS float*)(lds + GA_WSF) + wid * 64;
    __syncthreads();
    for (int idx = tid; idx < 2 * 155; idx += NWAVES * 64) { const int ti = idx / 155, i = idx % 155; const int head = 2 * h + ti;
        tab[ti * 160 + i] = (p.in[REL_BIAS][t5_bucket(i - 91) * 16 + head] - p.in[REL_BIAS][15 * 16 + head]) * LOG2E; }
    const unsigned lds0 = (unsigned)(uintptr_t)lds;
    const bf16_t* ksrc = Kb + (size_t)lane * 1024 + h * 128 + wid * 8;
    const bf16_t* vsrc = Vb + (size_t)(16 * (wid & 3) + (lane >> 2)) * 1024 + h * 128 + (wid >> 2) * 32 + (lane & 3) * 8;
    const unsigned kdst = lds0 + wid * 1024, vdst = lds0 + 49152 + (wid >> 2) * 4096 + (wid & 3) * 1024;
#define DP_DMA(t, kslot_, vslot_) do { const bf16_t* ks_ = ksrc + (size_t)(t) * 65536; const bf16_t* vs_ = vsrc + (size_t)(t) * 65536; const unsigned ko_ = (unsigned)(kslot_) * 16384u, vo_ = (unsigned)(vslot_) * 16384u; \
        glds16(ks_, (unsigned)__builtin_amdgcn_readfirstlane(kdst + ko_)); glds16(ks_ + 64, (unsigned)__builtin_amdgcn_readfirstlane(kdst + ko_ + 8192u)); \
        glds16(vs_, (unsigned)__builtin_amdgcn_readfirstlane(vdst + vo_)); glds16(vs_ + 64, (unsigned)__builtin_amdgcn_readfirstlane(vdst + vo_ + 8192u)); } while (0)
    DP_DMA(0, 0, 0); DP_DMA(1, 1, 1);
    bf16x8 qr[4];
    { const bf16_t* qp = Qb + (size_t)(qrow0 + r32) * 1024 + (2 * h + m) * 64 + hi * 8;
#pragma unroll
      for (int d0 = 0; d0 < 4; ++d0) qr[d0] = *(const bf16x8*)(qp + d0 * 16); }
    asm volatile("" : "+v"(qr[0]), "+v"(qr[1]), "+v"(qr[2]), "+v"(qr[3]));
    f32x16 o[4];
#pragma unroll
    for (int db = 0; db < 4; ++db)
#pragma unroll
        for (int r = 0; r < 16; ++r) o[db][r] = 0.f;
    float l = 0.f;
    const int tq = qrow0 + r32;
    const LAS unsigned char* kb0 = lds + (8 * m + hi) * 1024 + r32 * 16;
    const LAS unsigned char* vb0 = lds + 49152 + ((lane >> 4) & 1) * 32 + (lane & 3) * 8 + (4 * hi + ((lane & 15) >> 2)) * 64;
    const LAS float* tb = tab + m * 160;
#ifndef DP_STAGGER
#define DP_STAGGER 0
#endif
    const bool late = DP_STAGGER && wid >= 4;
    u32x4 pwp[4];
#pragma unroll
    for (int i = 0; i < 4; ++i) pwp[i] = (u32x4){0u, 0u, 0u, 0u};
#define DP_PV(PW, vslot) do { const LAS unsigned char* vb = vb0 + (vslot) * 16384; s16x4 vl[2][4], vh[2][4]; \
        _Pragma("unroll") for (int ks = 0; ks < 4; ++ks) { vl[0][ks] = vtr(vb + ks * 1024); vh[0][ks] = vtr(vb + ks * 1024 + 512); } \
        _Pragma("unroll") for (int db = 0; db < 4; ++db) { \
            if (db < 3) { _Pragma("unroll") for (int ks = 0; ks < 4; ++ks) { vl[(db + 1) & 1][ks] = vtr(vb + (db + 1) * 4096 + ks * 1024); vh[(db + 1) & 1][ks] = vtr(vb + (db + 1) * 4096 + ks * 1024 + 512); } } \
            __builtin_amdgcn_sched_barrier(0); \
            _Pragma("unroll") for (int ks = 0; ks < 4; ++ks) { const s16x4 lo = vl[db & 1][ks], hh = vh[db & 1][ks]; \
                const bf16x8 vf = (bf16x8){lo[0], lo[1], lo[2], lo[3], hh[0], hh[1], hh[2], hh[3]}; \
                o[db] = MFMA32(__builtin_bit_cast(bf16x8, PW[ks]), vf, o[db]); } \
            __builtin_amdgcn_sched_barrier(0); } } while (0)
    int kslot = 0, kslot2 = 2, vslot = 0, vslot2 = 2, vprev = 3;
    for (int t = 0; t < NT; ++t) {
        if (t + 1 < NT) DP_WAIT_BAR(4); else DP_WAIT_BAR(0);
        if (t + 2 < NT) DP_DMA(t + 2, kslot2, vslot2);
        if (late && t >= 1) DP_PV(pwp, vprev);
        if (t <= tlast) {
            const LAS unsigned char* kb = kb0 + kslot * 16384;
            f32x16 p0, p1;
#pragma unroll
            for (int r = 0; r < 16; ++r) { p0[r] = 0.f; p1[r] = 0.f; }
            bf16x8 kf[8];
#pragma unroll
            for (int d0 = 0; d0 < 4; ++d0) { kf[2 * d0] = *(const LAS bf16x8*)(kb + d0 * 2048); kf[2 * d0 + 1] = *(const LAS bf16x8*)(kb + d0 * 2048 + 512); }
            __builtin_amdgcn_sched_barrier(0);
#pragma unroll
            for (int d0 = 0; d0 < 4; ++d0) { p0 = MFMA32(kf[2 * d0], qr[d0], p0); p1 = MFMA32(kf[2 * d0 + 1], qr[d0], p1); }
            const int pos0 = t * 64;
            if (pos0 + 63 - qrow0 > -91) {
                const int relb = pos0 - tq + 91;
#pragma unroll
                for (int r = 0; r < 16; ++r) { const int kv = crow(r, hi); int i0 = relb + kv, i1 = i0 + 32; i0 = i0 < 0 ? 0 : (i0 > 154 ? 154 : i0); i1 = i1 < 0 ? 0 : (i1 > 154 ? 154 : i1);
                    p0[r] += tb[i0]; p1[r] += tb[i1]; }
            }
            float ls = 0.f;
#pragma unroll
            for (int r = 0; r < 16; ++r) { p0[r] = __builtin_amdgcn_exp2f(p0[r]); p1[r] = __builtin_amdgcn_exp2f(p1[r]); ls += p0[r] + p1[r]; }
            l += ls;
            u32x4 pw[4];
            pw[0] = (u32x4){cvtpk(p0[0], p0[1]), cvtpk(p0[2], p0[3]), cvtpk(p0[4], p0[5]), cvtpk(p0[6], p0[7])};
            pw[1] = (u32x4){cvtpk(p0[8], p0[9]), cvtpk(p0[10], p0[11]), cvtpk(p0[12], p0[13]), cvtpk(p0[14], p0[15])};
            pw[2] = (u32x4){cvtpk(p1[0], p1[1]), cvtpk(p1[2], p1[3]), cvtpk(p1[4], p1[5]), cvtpk(p1[6], p1[7])};
            pw[3] = (u32x4){cvtpk(p1[8], p1[9]), cvtpk(p1[10], p1[11]), cvtpk(p1[12], p1[13]), cvtpk(p1[14], p1[15])};
            if (!late) DP_PV(pw, vslot);
            else {
#pragma unroll
                for (int i = 0; i < 4; ++i) pwp[i] = pw[i]; }
        }
        kslot = kslot == 2 ? 0 : kslot + 1; kslot2 = kslot2 == 2 ? 0 : kslot2 + 1;
        vprev = vslot; vslot = (vslot + 1) & 3; vslot2 = (vslot2 + 1) & 3;
    }
    if (late) DP_PV(pwp, vprev);
#undef DP_PV
#undef DP_DMA
    __syncthreads();
    { LAS float* st = (LAS float*)(lds + wid * 16384);
      const float lt = l + __shfl_xor(l, 32); if (hi == 0) wsf[r32] = lt;
      asm volatile("s_waitcnt lgkmcnt(0)" ::: "memory");
      float rinv[16];
#pragma unroll
      for (int r = 0; r < 16; ++r) rinv[r] = 1.f / wsf[crow(r, hi)];
#pragma unroll
      for (int db = 0; db < 4; ++db)
#pragma unroll
          for (int r = 0; r < 16; ++r) st[crow(r, hi) * 128 + 32 * db + r32] = o[db][r] * rinv[r]; }
    __syncthreads();
    { const int row = 16 * m + (lane >> 2), qd = lane & 3;
      const LAS float* s0 = (const LAS float*)(lds + (2 * grp) * 16384) + row * 128 + qd * 32; const LAS float* s1 = s0 + 4096;
      float x[32]; float ss = 0.f;
#pragma unroll
      for (int e = 0; e < 32; ++e) { x[e] = s0[e] - lam * s1[e]; ss += x[e] * x[e]; }
      ss += __shfl_xor(ss, 1); ss += __shfl_xor(ss, 2);
      const float rs = rsqrtf(ss * (1.f / 128.f) + 1e-6f) * (1.f - lam_init);
      const float* sg = p.in[D_SUBLN] + j * 128 + qd * 32; bf16_t* op = Ob + ((size_t)qb * 128 + grp * 32 + row) * 1024 + h * 128 + qd * 32;
#pragma unroll
      for (int c = 0; c < 4; ++c) { u32x4 w;
          w.x = cvtpk(x[8 * c] * rs * sg[8 * c], x[8 * c + 1] * rs * sg[8 * c + 1]); w.y = cvtpk(x[8 * c + 2] * rs * sg[8 * c + 2], x[8 * c + 3] * rs * sg[8 * c + 3]);
          w.z = cvtpk(x[8 * c + 4] * rs * sg[8 * c + 4], x[8 * c + 5] * rs * sg[8 * c + 5]); w.w = cvtpk(x[8 * c + 6] * rs * sg[8 * c + 6], x[8 * c + 7] * rs * sg[8 * c + 7]);
          *(u32x4*)(op + 8 * c) = w; } }
}
#define P3_SBAR() __builtin_amdgcn_sched_barrier(0)
#define P3_PIN(x) asm volatile("" : "+v"(x))
#define P3_WAIT_BAR(N) asm volatile("s_waitcnt vmcnt(" #N ") lgkmcnt(0)\n\ts_barrier" ::: "memory")
__device__ __forceinline__ void attn_diff_p3(const Params& p, LAS unsigned char* lds, int h, int qb, int j, float lam, float lam_init, const bf16_t* Qb, const bf16_t* Kb, const bf16_t* Vb, bf16_t* Ob) {
    const int tid = pg8::otid(), lane = tid & 63, r32 = lane & 31, hi = lane >> 5; const int wid = __builtin_amdgcn_readfirstlane(tid >> 6);
    const int m = wid & 1, grp = wid >> 1, qrow0 = qb * 128 + grp * 32, NT = 2 * qb + 2; const bool early = grp < 2;
    LAS float* tab = (LAS float*)(lds + GA_TAB); LAS float* wsf = (LAS float*)(lds + GA_WSF) + wid * 64;
    __syncthreads();
    const unsigned lds0 = (unsigned)(uintptr_t)lds;
    const bf16_t* ksrc = Kb + (size_t)(16 * (wid & 3) + (lane & 15)) * 1024 + h * 128 + (wid >> 2) * 32 + (lane >> 4) * 8;
    const bf16_t* vsrc = Vb + (size_t)(16 * (wid & 3) + (lane >> 2)) * 1024 + h * 128 + (wid >> 2) * 32 + (lane & 3) * 8;
    const unsigned kdst = lds0 + (wid & 3) * 4096 + (wid >> 2) * 1024, vdst = lds0 + 49152 + (wid >> 2) * 4096 + (wid & 3) * 1024;
#define DMA_K(t, sl) do { const bf16_t* s_ = ksrc + (size_t)(t) * 65536; glds16(s_, (unsigned)__builtin_amdgcn_readfirstlane(kdst + (unsigned)(sl))); glds16(s_ + 64, (unsigned)__builtin_amdgcn_readfirstlane(kdst + (unsigned)(sl) + 2048u)); } while (0)
#define DMA_V(t, sl) do { const bf16_t* s_ = vsrc + (size_t)(t) * 65536; glds16(s_, (unsigned)__builtin_amdgcn_readfirstlane(vdst + (unsigned)(sl))); glds16(s_ + 64, (unsigned)__builtin_amdgcn_readfirstlane(vdst + (unsigned)(sl) + 8192u)); } while (0)
    constexpr int SL = 16384;
    DMA_K(0, 0); DMA_V(0, 0); DMA_K(1, SL);
    bf16x8 qr[4];
    { const bf16_t* qp = Qb + (size_t)(qrow0 + r32) * 1024 + (2 * h + m) * 64 + hi * 8;
#pragma unroll
      for (int d0 = 0; d0 < 4; ++d0) qr[d0] = *(const bf16x8*)(qp + d0 * 16); }
    for (int idx = tid; idx < 2 * 155; idx += NWAVES * 64) { const int ti = idx / 155, i = idx % 155; const int head = 2 * h + ti;
        tab[ti * 160 + i] = (p.in[REL_BIAS][t5_bucket(i - 91) * 16 + head] - p.in[REL_BIAS][15 * 16 + head]) * LOG2E; }
    asm volatile("" : "+v"(qr[0]), "+v"(qr[1]), "+v"(qr[2]), "+v"(qr[3]));
    DMA_K(2, 2 * SL);
    f32x16 o[4];
#pragma unroll
    for (int db = 0; db < 4; ++db)
#pragma unroll
        for (int r = 0; r < 16; ++r) o[db][r] = 0.f;
    float l_reg = 0.f;
    const int tq = qrow0 + r32;
    const LAS unsigned char* kp0 = lds + (r32 >> 4) * 4096 + (8 * m + hi) * 256 + (r32 & 15) * 16;
    const LAS unsigned char* vp0 = lds + 49152 + ((lane >> 4) & 1) * 32 + (lane & 3) * 8 + (4 * hi + ((lane & 15) >> 2)) * 64;
    const LAS float* tb = tab + m * 160;
    const f32x16 zero16 = {0.f, 0.f, 0.f, 0.f, 0.f, 0.f, 0.f, 0.f, 0.f, 0.f, 0.f, 0.f, 0.f, 0.f, 0.f, 0.f};
    bf16x8 kf[8];
#define KLOAD2(kp, jj) do { kf[2 * (jj)] = *(const LAS bf16x8*)((kp) + (jj) * 512); kf[2 * (jj) + 1] = *(const LAS bf16x8*)((kp) + (jj) * 512 + 8192); } while (0)
#define BAND(C0, C1, t) do { const int relb_ = (t) * 64 - tq + 91; const bool dead_ = early && (t) == NT - 1; \
        _Pragma("unroll") for (int r = 0; r < 16; ++r) { const int kv_ = crow(r, hi); int i0_ = relb_ + kv_, i1_ = i0_ + 32; i0_ = i0_ < 0 ? 0 : (i0_ > 154 ? 154 : i0_); i1_ = i1_ < 0 ? 0 : (i1_ > 154 ? 154 : i1_); \
            C0[r] += tb[i0_]; C1[r] += tb[i1_]; if (dead_) { C0[r] = -INFINITY; C1[r] = -INFINITY; } } } while (0)
    f32x16 pA0, pA1, pB0, pB1;
    int sl_prev = 0, sl_cur = 0, sl_next = SL;
#define ROT() do { sl_prev = sl_cur; sl_cur = sl_next; sl_next = (sl_next == 2 * SL) ? 0 : sl_next + SL; } while (0)
    P3_WAIT_BAR(6);
    { const LAS unsigned char* kp = kp0;
#pragma unroll
      for (int jj = 0; jj < 4; ++jj) KLOAD2(kp, jj);
      pA0 = MFMA32(kf[0], qr[0], zero16); pA1 = MFMA32(kf[1], qr[0], zero16);
#pragma unroll
      for (int d0 = 1; d0 < 4; ++d0) { pA0 = MFMA32(kf[2 * d0], qr[d0], pA0); pA1 = MFMA32(kf[2 * d0 + 1], qr[d0], pA1); }
      if (NT <= 4) BAND(pA0, pA1, 0);
#pragma unroll
      for (int r = 0; r < 16; ++r) { pA0[r] = __builtin_amdgcn_exp2f(pA0[r]); pA1[r] = __builtin_amdgcn_exp2f(pA1[r]); } }
    P3_WAIT_BAR(2);
    DMA_K(3, 0); DMA_V(1, SL);
    ROT();
#pragma unroll
    for (int jj = 0; jj < 4; ++jj) KLOAD2(kp0 + sl_cur, jj);
    P3_WAIT_BAR(4);
    s16x4 vlo[4], vhi[4]; u32x4 pw0, pw1, pw2, pw3;
#define PKW(P, B) cvtpk(P[B], P[B + 1])
#define PAF(k) __builtin_bit_cast(bf16x8, pw##k)
#define VFR(i) (bf16x8){vlo[i][0], vlo[i][1], vlo[i][2], vlo[i][3], vhi[i][0], vhi[i][1], vhi[i][2], vhi[i][3]}
#define EX(v) __builtin_amdgcn_exp2f(v)
#define VRD(f) do { vlo[(f) & 3] = vtr(vp_ + (((f) & 3) * 4096 + ((f) >> 2) * 1024)); vhi[(f) & 3] = vtr(vp_ + (((f) & 3) * 4096 + ((f) >> 2) * 1024 + 512)); } while (0)
#define GAPA(MF, A0, A1, A2, A3, W0, W1, PW) do { MF; sacc += A0; sacc += A1; sacc += A2; sacc += A3; P3_PIN(sacc); W0; W1; P3_PIN(PW); P3_SBAR(); } while (0)
#define GAPB(f, PWK, X, B) do { o[(f) & 3] = MFMA32(PWK, VFR((f) & 3), o[(f) & 3]); X[B] = EX(X[B]); X[B + 1] = EX(X[B + 1]); P3_PIN(X); P3_SBAR(); } while (0)
#define KRD(G, jj) do { if (G) { KLOAD2(kp0 + sl_next, jj); P3_SBAR(); } } while (0)
#define STEP(C0, C1, P0, P1, t, GK, GV, GL, BANDED) do { P3_SBAR(); \
    const LAS unsigned char* vp_ = vp0 + sl_prev; \
    VRD(0); P3_SBAR(); float sacc = (P0[0] + P0[1]); \
    GAPA(C0 = MFMA32(kf[0], qr[0], zero16), P0[2], P0[3], P0[4], P0[5],     pw0[0] = PKW(P0, 0), pw0[1] = PKW(P0, 2), pw0); \
    VRD(1); P3_SBAR(); GAPA(C1 = MFMA32(kf[1], qr[0], zero16), P0[6], P0[7], P0[8], P0[9],     pw0[2] = PKW(P0, 4), pw0[3] = PKW(P0, 6), pw0); \
    VRD(2); P3_SBAR(); GAPA(C0 = MFMA32(kf[2], qr[1], C0),     P0[10], P0[11], P0[12], P0[13], pw1[0] = PKW(P0, 8), pw1[1] = PKW(P0, 10), pw1); \
    VRD(3); P3_SBAR(); GAPA(C1 = MFMA32(kf[3], qr[1], C1),     P0[14], P0[15], P1[0], P1[1],   pw1[2] = PKW(P0, 12), pw1[3] = PKW(P0, 14), pw1); \
    GAPA(C0 = MFMA32(kf[4], qr[2], C0),     P1[2], P1[3], P1[4], P1[5],     pw2[0] = PKW(P1, 0), pw2[1] = PKW(P1, 2), pw2); \
    GAPA(C1 = MFMA32(kf[5], qr[2], C1),     P1[6], P1[7], P1[8], P1[9],     pw2[2] = PKW(P1, 4), pw2[3] = PKW(P1, 6), pw2); \
    GAPA(C0 = MFMA32(kf[6], qr[3], C0),     P1[10], P1[11], P1[12], P1[13], pw3[0] = PKW(P1, 8), pw3[1] = PKW(P1, 10), pw3); \
    GAPA(C1 = MFMA32(kf[7], qr[3], C1),     P1[14], P1[15], 0.f, 0.f,       pw3[2] = PKW(P1, 12), pw3[3] = PKW(P1, 14), pw3); \
    l_reg += sacc; \
    if (GK) { DMA_K((t) + 3, sl_cur); } if (GV) { DMA_V((t) + 1, sl_next); } \
    if (BANDED) { BAND(C0, C1, t); } \
    P3_SBAR(); \
    GAPB(0, PAF(0), C0, 0);   VRD(4);  P3_SBAR(); \
    GAPB(1, PAF(0), C0, 2);   VRD(5);  P3_SBAR(); \
    GAPB(2, PAF(0), C0, 4);   VRD(6);  P3_SBAR(); \
    KRD(GL, 0); GAPB(3, PAF(0), C0, 6);   VRD(7);  P3_SBAR(); \
    GAPB(4, PAF(1), C0, 8);   VRD(8);  P3_SBAR(); \
    KRD(GL, 1); GAPB(5, PAF(1), C0, 10);  VRD(9);  P3_SBAR(); \
    GAPB(6, PAF(1), C0, 12);  VRD(10); P3_SBAR(); \
    KRD(GL, 2); GAPB(7, PAF(1), C0, 14);  VRD(11); P3_SBAR(); \
    GAPB(8, PAF(2), C1, 0);   VRD(12); P3_SBAR(); \
    KRD(GL, 3); GAPB(9, PAF(2), C1, 2);   VRD(13); P3_SBAR(); \
    GAPB(10, PAF(2), C1, 4);  VRD(14); P3_SBAR(); \
    GAPB(11, PAF(2), C1, 6);  VRD(15); P3_SBAR(); \
    GAPB(12, PAF(3), C1, 8); \
    GAPB(13, PAF(3), C1, 10); \
    GAPB(14, PAF(3), C1, 12); \
    GAPB(15, PAF(3), C1, 14); \
    } while (0)
    int t = 1;
    for (; t + 5 < NT; t += 2) {
        STEP(pB0, pB1, pA0, pA1, t, true, true, true, false);     P3_WAIT_BAR(4); ROT();
        STEP(pA0, pA1, pB0, pB1, t + 1, true, true, true, false); P3_WAIT_BAR(4); ROT();
    }
#define ENDW(tt) do { if ((tt) + 3 < NT) { P3_WAIT_BAR(4); } else if ((tt) + 2 < NT) { P3_WAIT_BAR(2); } else { P3_WAIT_BAR(0); } } while (0)
    for (; t + 1 < NT; t += 2) {
        STEP(pB0, pB1, pA0, pA1, t, (t + 3 < NT), (t + 1 < NT), (t + 1 < NT), true);         ENDW(t);     ROT();
        STEP(pA0, pA1, pB0, pB1, t + 1, (t + 4 < NT), (t + 2 < NT), (t + 2 < NT), true);     ENDW(t + 1); ROT();
    }
    STEP(pB0, pB1, pA0, pA1, NT - 1, false, false, false, true);
    if (NT == 2) P3_WAIT_BAR(0);
    { float sacc = pB0[0] + pB0[1];
#pragma unroll
      for (int r = 2; r < 16; ++r) sacc += pB0[r];
#pragma unroll
      for (int r = 0; r < 16; ++r) sacc += pB1[r];
      l_reg += sacc;
      pw0 = (u32x4){PKW(pB0, 0), PKW(pB0, 2), PKW(pB0, 4), PKW(pB0, 6)}; pw1 = (u32x4){PKW(pB0, 8), PKW(pB0, 10), PKW(pB0, 12), PKW(pB0, 14)};
      pw2 = (u32x4){PKW(pB1, 0), PKW(pB1, 2), PKW(pB1, 4), PKW(pB1, 6)}; pw3 = (u32x4){PKW(pB1, 8), PKW(pB1, 10), PKW(pB1, 12), PKW(pB1, 14)};
      const LAS unsigned char* vp_ = vp0 + sl_cur;
#pragma unroll
      for (int f = 0; f < 16; ++f) { const s16x4 lo = vtr(vp_ + ((f & 3) * 4096 + (f >> 2) * 1024)), hh = vtr(vp_ + ((f & 3) * 4096 + (f >> 2) * 1024 + 512));
          const bf16x8 vf = (bf16x8){lo[0], lo[1], lo[2], lo[3], hh[0], hh[1], hh[2], hh[3]};
          const u32x4 pk = (f >> 2) == 0 ? pw0 : ((f >> 2) == 1 ? pw1 : ((f >> 2) == 2 ? pw2 : pw3));
          o[f & 3] = MFMA32(__builtin_bit_cast(bf16x8, pk), vf, o[f & 3]); } }
#undef DMA_K
#undef DMA_V
#undef KLOAD2
#undef BAND
#undef ROT
#undef PKW
#undef PAF
#undef VFR
#undef EX
#undef VRD
#undef GAPA
#undef GAPB
#undef KRD
#undef STEP
#undef ENDW
    __syncthreads();
    { LAS float* st = (LAS float*)(lds + wid * 16384);
      const float lt = l_reg + __shfl_xor(l_reg, 32); if (hi == 0) wsf[r32] = lt;
      asm volatile("s_waitcnt lgkmcnt(0)" ::: "memory");
      float rinv[16];
#pragma unroll
      for (int r = 0; r < 16; ++r) rinv[r] = 1.f / wsf[crow(r, hi)];
#pragma unroll
      for (int db = 0; db < 4; ++db)
#pragma unroll
          for (int r = 0; r < 16; ++r) st[crow(r, hi) * 128 + 32 * db + r32] = o[db][r] * rinv[r]; }
    __syncthreads();
    { const int row = 16 * m + (lane >> 2), qd = lane & 3;
      const LAS float* s0 = (const LAS float*)(lds + (2 * grp) * 16384) + row * 128 + qd * 32; const LAS float* s1 = s0 + 4096;
      float x[32]; float ss = 0.f;
#pragma unroll
      for (int e = 0; e < 32; ++e) { x[e] = s0[e] - lam * s1[e]; ss += x[e] * x[e]; }
      ss += __shfl_xor(ss, 1); ss += __shfl_xor(ss, 2);
      const float rs = rsqrtf(ss * (1.f / 128.f) + 1e-6f) * (1.f - lam_init);
      const float* sg = p.in[D_SUBLN] + j * 128 + qd * 32; bf16_t* op = Ob + ((size_t)qb * 128 + grp * 32 + row) * 1024 + h * 128 + qd * 32;
#pragma unroll
      for (int c = 0; c < 4; ++c) { u32x4 w;
          w.x = cvtpk(x[8 * c] * rs * sg[8 * c], x[8 * c + 1] * rs * sg[8 * c + 1]); w.y = cvtpk(x[8 * c + 2] * rs * sg[8 * c + 2], x[8 * c + 3] * rs * sg[8 * c + 3]);
          w.z = cvtpk(x[8 * c + 4] * rs * sg[8 * c + 4], x[8 * c + 5] * rs * sg[8 * c + 5]); w.w = cvtpk(x[8 * c + 6] * rs * sg[8 * c + 6], x[8 * c + 7] * rs * sg[8 * c + 7]);
          *(u32x4*)(op + 8 * c) = w; } }
}
struct SEpiQKV {
    bf16_t *Qb, *Kb, *Vb; int ldkv, nq, nk, has_norm; const float *qg, *kg; float qscale; float *ks, *vs; int swa;
    __device__ __forceinline__ float pre(int, int hg, int lane) const { if (!has_norm || hg >= nq + nk) return 1.f; return (hg < nq ? pg8::opq(qg) : pg8::opq(kg))[lane]; }
    __device__ __forceinline__ void operator()(int row  , int hg, int lane, float v, int, float ss  , float aux) const {
        int type, gi; if (hg < nq) { type = 0; gi = hg; } else if (hg < nq + nk) { type = 1; gi = hg - nq; } else { type = 2; gi = hg - nq - nk; }
        if (has_norm && type < 2) { v = v * rsqrtf(ss * (1.f / 64.f) + 1e-6f) * aux; }
        if (type == 0) { v *= qscale; Qb[(size_t)(TP + row) * 1024 + gi * 64 + lane] = (bf16_t)f2bf(v); return; }
        bf16_t* bd = type == 1 ? pg8::opq(Kb) : pg8::opq(Vb); float* fd = type == 1 ? pg8::opq(ks) : pg8::opq(vs);
        bd[(size_t)(TP + row) * ldkv + gi * 64 + lane] = (bf16_t)f2bf(v);
        const size_t frow = swa ? (size_t)(row >> 5) * 128 + 96 + (row & 31) : (size_t)row;
        fd[frow * ldkv + gi * 64 + lane] = v;
    }
};
struct SEpiRelu2 { bf16_t* U; __device__ __forceinline__ float pre(int, int, int) const { return 0.f; }
    __device__ __forceinline__ void operator()(int row, int ct, int lane, float v, int, float, float) const { const float a = fmaxf(v, 0.f); U[(size_t)(TP + row) * FF + ct * 64 + lane] = (bf16_t)f2bf(a * a); } };
struct SEpiResid { const float* xin32; const bf16_t* xin16; bf16_t* xout16; float* y32; float* slab;
    __device__ __forceinline__ float pre(int row, int ct, int lane) const { if (slab) return 0.f; const size_t o = (size_t)row * 1024 + ct * 64 + lane, og = (size_t)(TP + row) * 1024 + ct * 64 + lane;
        return xin32 ? xin32[o] : __uint_as_float((unsigned)xin16[og] << 16); }
    __device__ __forceinline__ void operator()(int row, int ct, int lane, float v, int ks, float, float aux) const { const size_t o = (size_t)row * 1024 + ct * 64 + lane, og = (size_t)(TP + row) * 1024 + ct * 64 + lane;
        if (slab) { slab[(size_t)ks * TS * 1024 + o] = v; return; }
        const float x = aux + v;
        if (y32) y32[o] = x; else xout16[og] = (bf16_t)f2bf(x); } };

#define SG_WAIT_BAR(N) asm volatile("s_waitcnt vmcnt(" #N ") lgkmcnt(0)\n\ts_barrier" ::: "memory")
template <class Epi>
__device__ __forceinline__ void sgemm_phase(LAS unsigned char* lds, const bf16_t* A  , int lda, const bf16_t* Bt  , int K, int N, bool perm256, const Epi& E, int vcu, int G, int ksplit = 1) {
    const int tid = pg8::otid(), lane = tid & 63, r32 = lane & 31, hi = lane >> 5; const int wid = __builtin_amdgcn_readfirstlane(tid >> 6);
    const int rh = wid & 1, cq = wid >> 1, ncb = N / 128, nitems = 8 * ncb * ksplit, kc = K / ksplit, nst = kc / 64;
    LAS float* tile = (LAS float*)(lds + 98304);
    const unsigned lds0 = (unsigned)(uintptr_t)lds;
    for (int it = vcu; it < nitems; it += G) {
        const int ks = it / (8 * ncb), it2 = it - ks * 8 * ncb, rb = it2 & 7, cb = it2 >> 3, kbase = ks * kc;
        int R, C; pg8::stage_rc(wid * 1024 + lane * 16, R, C);
        int b0r, b1r;
        if (perm256) { const int h0 = 2 * cb, h1 = 2 * cb + 1; b0r = (h0 >> 2) * 256 + 32 * (h0 & 3) + (R & 31) + 128 * (R >> 5); b1r = (h1 >> 2) * 256 + 32 * (h1 & 3) + (R & 31) + 128 * (R >> 5); }
        else { b0r = cb * 128 + R; b1r = cb * 128 + 64 + R; }
        const bf16_t* asrc = A + (size_t)(rb * 64 + R) * lda + C + kbase;
        const bf16_t* b0src = Bt + (size_t)b0r * K + C + kbase; const bf16_t* b1src = Bt + (size_t)b1r * K + C + kbase;
        const unsigned dst = lds0 + wid * 1024;
#define SG_DMA(st) do { const unsigned so_ = dst + (unsigned)((st) & 3) * 24576u; const int ko_ = (st) * 64; \
        glds16(asrc + ko_, (unsigned)__builtin_amdgcn_readfirstlane(so_)); glds16(b0src + ko_, (unsigned)__builtin_amdgcn_readfirstlane(so_ + 8192u)); glds16(b1src + ko_, (unsigned)__builtin_amdgcn_readfirstlane(so_ + 16384u)); } while (0)
        f32x16 c;
#pragma unroll
        for (int r = 0; r < 16; ++r) c[r] = 0.f;
        __syncthreads();
        SG_DMA(0); SG_DMA(1); SG_DMA(2);
        for (int st = 0; st < nst; ++st) {
            if (st + 2 < nst) SG_WAIT_BAR(6); else SG_WAIT_BAR(0);
            if (st + 3 < nst) SG_DMA(st + 3);
            const LAS unsigned char* bb = lds + (st & 3) * 24576;
            const LAS unsigned char* wb = bb + 8192 + (cq >> 1) * 8192;
            bf16x8 af[4], bf[4];
#pragma unroll
            for (int d0 = 0; d0 < 4; ++d0) { af[d0] = *(const LAS bf16x8*)(bb + pg8::lds_byte(rh * 32 + r32, 16 * d0 + 8 * hi)); bf[d0] = *(const LAS bf16x8*)(wb + pg8::lds_byte((cq & 1) * 32 + r32, 16 * d0 + 8 * hi)); }
#pragma unroll
            for (int d0 = 0; d0 < 4; ++d0) c = MFMA32(af[d0], bf[d0], c);
        }
#undef SG_DMA
        __syncthreads();
#pragma unroll
        for (int r = 0; r < 16; ++r) tile[(rh * 32 + crow(r, hi)) * 128 + cq * 32 + r32] = c[r];
        __syncthreads();
        float tv[8][2], tss[8][2];
#pragma unroll
        for (int rr = 0; rr < 8; ++rr) { const int row = wid * 8 + rr; tv[rr][0] = tile[row * 128 + lane]; tv[rr][1] = tile[row * 128 + 64 + lane]; tss[rr][0] = tv[rr][0] * tv[rr][0]; tss[rr][1] = tv[rr][1] * tv[rr][1]; }
#pragma unroll
        for (int o = 32; o; o >>= 1)
#pragma unroll
            for (int rr = 0; rr < 8; ++rr) { tss[rr][0] += __shfl_xor(tss[rr][0], o); tss[rr][1] += __shfl_xor(tss[rr][1], o); }
        float tax[8][2];
#pragma unroll
        for (int rr = 0; rr < 8; ++rr) { const int row = wid * 8 + rr; tax[rr][0] = E.pre(rb * 64 + row, 2 * cb, lane); tax[rr][1] = E.pre(rb * 64 + row, 2 * cb + 1, lane); }
#pragma unroll
        for (int rr = 0; rr < 8; ++rr) { const int row = wid * 8 + rr;
            E(rb * 64 + row, 2 * cb, lane, tv[rr][0], ks, tss[rr][0], tax[rr][0]); E(rb * 64 + row, 2 * cb + 1, lane, tv[rr][1], ks, tss[rr][1], tax[rr][1]); }
    }
    __syncthreads();
}
#ifndef FX_STAMP
#define FX_STAMP 0
#endif
#ifndef FX_NO_SMALL
#define FX_NO_SMALL 0
#endif
#ifndef FX_SP2
#define FX_SP2 true
#endif
__global__ void __launch_bounds__(NWAVES * 64, 2) mega(Params p) {
    extern __shared__ __attribute__((aligned(16))) unsigned char lds_raw[];
    LAS unsigned char* lds = (LAS unsigned char*)lds_raw;
    const int tid = threadIdx.x, lane = tid & 63; const int wave = __builtin_amdgcn_readfirstlane(tid >> 6);
    const int G = gridDim.x; const int vcu = (G % 8 == 0) ? ((int)blockIdx.x % 8) * (G / 8) + (int)blockIdx.x / 8 : (int)blockIdx.x;
    const int gw = vcu * NWAVES + wave, NGW = G * NWAVES;
    unsigned* ctl = (unsigned*)(p.ws + WS_CTL);
    for (int u = tid; u < (LDS_BYTES - LDSCTL_OFF) / 4; u += NWAVES * 64) ((LAS unsigned*)(lds + LDSCTL_OFF))[u] = 0u;
    __syncthreads();
    XcdBarrier bar = xcd_barrier_post(ctl + CW_BAR + p.li * XCD_BAR_WORDS, (volatile LAS unsigned*)(lds + MISC_OFF) + 8);
    const int lo = p.ph_lo, hi_ph = p.ph_hi;
#define IN(k) (lo <= (k) && (k) < hi_ph)
#define SEAM(k) do { if (FX_STAMP && blockIdx.x == 0 && tid == 0) ((unsigned long long*)(ctl + 200000))[64 + (k)] = __builtin_amdgcn_s_memrealtime(); if (IN(k) && IN((k) + 1)) xcd_barrier(bar); if (FX_STAMP && blockIdx.x == 0 && tid == 0) ((unsigned long long*)(ctl + 200000))[(k) + 1] = __builtin_amdgcn_s_memrealtime(); } while (0)
#define MIDSTAMP(k) do { if (FX_STAMP && blockIdx.x == 0 && tid == 0) ((unsigned long long*)(ctl + 200000))[32 + (k)] = __builtin_amdgcn_s_memrealtime(); } while (0)
#define WSP(off) ((bf16_t*)(pg8::opq(p.ws) + (off)))
#define SPLIT_ARRIVE(k) do { asm volatile("s_waitcnt vmcnt(0)" ::: "memory"); __syncthreads(); \
        if (tid == 0) { __builtin_amdgcn_fence(__ATOMIC_RELEASE, "agent"); asm volatile("s_waitcnt vmcnt(0)" ::: "memory"); (void)xb_add(ctl + CW_FLAG + 64 * (k), 1u); } } while (0)
#define SPLIT_WAIT(k) do { if (tid == 0) { XB_SPIN(xb_ld(ctl + CW_FLAG + 64 * (k)) < (unsigned)G, bar.bar); __builtin_amdgcn_fence(__ATOMIC_ACQUIRE, "agent"); asm volatile("s_waitcnt vmcnt(0)" ::: "memory"); } __syncthreads(); } while (0)

    if (FX_STAMP && blockIdx.x == 0 && tid == 0) ((unsigned long long*)(ctl + 200000))[0] = __builtin_amdgcn_s_memrealtime();
    if (IN(0)) prologue(p, lds, gw, NGW, wave, pg8::otid() & 63);
    for (int layer = 0; layer < 4; ++layer) {
        const int pb = 1 + 7 * layer, mix = layer % 3, j = layer / 3;
        const size_t wlo = WS_W + (size_t)layer * WL_BYTES;

        if (layer == 0) {
            if (IN(pb + 0)) {   rms0_phase(p.in[X_P], p.in[X_S], WSP(WS_XN), pg8::opqi(gw), NGW, pg8::otid() & 63); }
            SEAM(pb + 0); }
        if (IN(pb + 1)) {
            const int N = mix == 1 ? 1536 : 3072;
            if (layer > 0) {
                { const int pm0_ = pg8::static_pm0(TP, N, G, (int)blockIdx.x); const int t_ = pg8::otid() - 256;
                  if (pm0_ >= 0 && t_ >= 0) { const f32x4* r_ = (const f32x4*)((const float*)WSP(WS_RSS) + (size_t)(pm0_ * 256 + t_) * 16); const f32x4 a_ = r_[0], b_ = r_[1], c_ = r_[2], d_ = r_[3]; const f32x4 q_ = (a_ + b_) + (c_ + d_);
                      ((LAS float*)(lds + GA_TAB))[t_] = rsqrtf(((q_[0] + q_[1]) + (q_[2] + q_[3])) * (1.f / 1024.f) + 1e-6f); } }
                rms_phase(nullptr, nullptr, WSP(WS_XR), (const float*)WSP(WS_SLAB), TP, WSP(WS_XN), pg8::opqi(wave * G + vcu), NGW, pg8::otid() & 63); SPLIT_ARRIVE(2 * layer); }
            pg8::Gemm g{layer == 0 ? WSP(WS_XN) : WSP(WS_XR), WSP(wlo + WL_QKV), TP, N, D}; pg8::StaticOrder S; S.init(TP, N, G, (int)blockIdx.x);
            pg8::EpiQKV E; E.rowss = layer == 0 ? (const float*)nullptr : (const float*)WSP(WS_RSS);
            E.Qb = WSP(WS_Q); E.Kb = WSP(WS_K); E.Vb = WSP(WS_V); E.ldkv = mix == 1 ? 256 : 1024; E.nq = 16; E.nk = mix == 1 ? 4 : 16; E.has_norm = mix != 2; E.swa = mix == 1;
            E.qg = mix == 0 ? p.in[D_QN] + j * 64 : p.in[S_QN]; E.kg = mix == 0 ? p.in[D_KN] + j * 64 : p.in[S_KN]; E.qscale = QSC;
            E.kp = mix == 0 ? p.dkp[j] : (mix == 1 ? p.wkp : p.bkp); E.vp = mix == 0 ? p.dvp[j] : (mix == 1 ? p.wvp : p.bvp);
            E.ks = mix == 0 ? p.dks[j] : (mix == 1 ? p.wks : p.bks); E.vs = mix == 0 ? p.dvs[j] : (mix == 1 ? p.wvs : p.bvs);
            E.rtab = (const LAS float*)(lds + GA_TAB);
            pg8::gemm_phase<pg8::EpiQKV, pg8::StaticOrder, true, FX_SP2>(lds, g, S, E);
            MIDSTAMP(pb + 1);
            SEpiQKV SE; SE.Qb = E.Qb; SE.Kb = E.Kb; SE.Vb = E.Vb; SE.ldkv = E.ldkv; SE.nq = E.nq; SE.nk = E.nk; SE.has_norm = E.has_norm; SE.qg = E.qg; SE.kg = E.kg; SE.qscale = E.qscale; SE.ks = E.ks; SE.vs = E.vs; SE.swa = E.swa;
            if (layer > 0) SPLIT_WAIT(2 * layer);
            const int vs_ = (mix == 1 && G == 256) ? (((int)blockIdx.x + 128) & 255) : vcu;
            if (!FX_NO_SMALL) sgemm_phase(lds, WSP(WS_XN) + (size_t)TP * D, D, WSP(wlo + WL_QKV), D, N, true, SE, vs_, G);
        }
        SEAM(pb + 1);
        if (IN(pb + 2)) {
            bf16_t *Qb = WSP(WS_Q), *Kb = WSP(WS_K), *Vb = WSP(WS_V), *Ob = WSP(WS_O);
            if (mix == 0) {
                const float lam_init = layer == 0 ? 0.2f : 0.55605820417f;
                const float* lp = p.in[D_LAM] + j * 256;
                const int ln = pg8::otid() & 63; const float lam = expf(wave_sum(lp[ln] * lp[64 + ln])) - expf(wave_sum(lp[128 + ln] * lp[192 + ln])) + lam_init;
                for (int u = vcu; u < 1024; u += G) { const int k = u >> 8, v = u & 255, h = v >> 5, s = v & 31; const int qb = k == 0 ? s : (k == 1 ? 63 - s : (k == 2 ? (s < 16 ? 80 + s : 48 + s) : 127 - s));
                    attn_diff_p3(p, lds, h, qb, j, lam, lam_init, Qb, Kb, Vb, Ob);
                    if (k == 0 && s >= 16) { const int us_ = h * 16 + (s - 16); attn_unit<M_DIFF_S>(p, lds, us_ >> 3, us_ & 7, j, lam, lam_init, Qb, Kb, Vb, Ob); } }
            } else if (mix == 1) {
                for (int u = vcu; u < 1024; u += G) attn_unit<M_SWA_P>(p, lds, u >> 2, u & 3, 0, 0.f, 0.f, Qb, Kb, Vb, Ob);
                for (int u = vcu; u < 64; u += G) attn_unit<M_SWA_S>(p, lds, u >> 2, u & 3, 0, 0.f, 0.f, Qb, Kb, Vb, Ob);
            } else {
                for (int u = vcu; u < 1024; u += G) attn_unit<M_SB_P>(p, lds, u >> 2, u & 3, 0, 0.f, 0.f, Qb, Kb, Vb, Ob);
                for (int u = vcu; u < 64; u += G) attn_unit<M_SB_S>(p, lds, u >> 2, u & 3, 0, 0.f, 0.f, Qb, Kb, Vb, Ob);
            }
        }
        SEAM(pb + 2);
        if (IN(pb + 3)) {
            pg8::Gemm g{WSP(WS_O), WSP(wlo + WL_O), TP, D, D}; pg8::StaticOrder S; S.init(TP, D, G, (int)blockIdx.x);
            pg8::EpiResid E{layer == 0 ? p.in[X_P] : (const float*)nullptr, WSP(WS_XR), WSP(WS_XR), nullptr, (float*)WSP(WS_RSS)};
            pg8::gemm_phase<pg8::EpiResid, pg8::StaticOrder, true, FX_SP2>(lds, g, S, E);
            MIDSTAMP(pb + 3);
            SEpiResid SE{nullptr, nullptr, nullptr, nullptr, (float*)WSP(WS_SLAB)};
            if (!FX_NO_SMALL) sgemm_phase(lds, WSP(WS_O) + (size_t)TP * D, D, WSP(wlo + WL_O), D, D, false, SE, vcu, G, 4);
        }
        SEAM(pb + 3);
        if (IN(pb + 5)) {
            { const int pm0_ = pg8::static_pm0(TP, FF, G, (int)blockIdx.x); const int t_ = pg8::otid() - 256;
                  if (pm0_ >= 0 && t_ >= 0) { const f32x4* r_ = (const f32x4*)((const float*)WSP(WS_RSS) + (size_t)(pm0_ * 256 + t_) * 16); const f32x4 a_ = r_[0], b_ = r_[1], c_ = r_[2], d_ = r_[3]; const f32x4 q_ = (a_ + b_) + (c_ + d_);
                      ((LAS float*)(lds + GA_TAB))[t_] = rsqrtf(((q_[0] + q_[1]) + (q_[2] + q_[3])) * (1.f / 1024.f) + 1e-6f); } }
            rms_phase(nullptr, layer == 0 ? p.in[X_S] : (const float*)nullptr, WSP(WS_XR), (const float*)WSP(WS_SLAB), TP, WSP(WS_XN), pg8::opqi(wave * G + vcu), NGW, pg8::otid() & 63); SPLIT_ARRIVE(2 * layer + 1);
            pg8::Gemm g{WSP(WS_XR), WSP(wlo + WL_UP), TP, FF, D}; pg8::StaticOrder S; S.init(TP, FF, G, (int)blockIdx.x);
            pg8::EpiRelu2 E; E.O = WSP(WS_U); E.ldc = FF; E.rowss = (const float*)WSP(WS_RSS);
            E.rtab = (const LAS float*)(lds + GA_TAB);
            pg8::gemm_phase<pg8::EpiRelu2, pg8::StaticOrder, true, FX_SP2>(lds, g, S, E);
            MIDSTAMP(pb + 5);
            SEpiRelu2 SE{WSP(WS_U)};
            SPLIT_WAIT(2 * layer + 1);
            if (!FX_NO_SMALL) sgemm_phase(lds, WSP(WS_XN) + (size_t)TP * D, D, WSP(wlo + WL_UP), D, FF, false, SE, vcu, G);
        }
        SEAM(pb + 5);
        if (IN(pb + 6)) {
            float* yo = layer == 3 ? pg8::opq(p.yout) : (float*)nullptr;
            pg8::Gemm g{WSP(WS_U), WSP(wlo + WL_DN), TP, D, FF}; pg8::StaticOrder S; S.init(TP, D, G, (int)blockIdx.x);
            pg8::EpiResid E{nullptr, WSP(WS_XR), WSP(WS_XR), yo, yo ? (float*)nullptr : (float*)WSP(WS_RSS)};
            pg8::gemm_phase<pg8::EpiResid, pg8::StaticOrder, true, FX_SP2>(lds, g, S, E);
            MIDSTAMP(pb + 6);
            SEpiResid SE{nullptr, WSP(WS_XR), WSP(WS_XR), yo ? yo + (size_t)TP * D : (float*)nullptr, yo ? (float*)nullptr : (float*)WSP(WS_SLAB)};
            if (!FX_NO_SMALL) sgemm_phase(lds, WSP(WS_U) + (size_t)TP * FF, FF, WSP(wlo + WL_DN), FF, D, false, SE, vcu, G, yo ? 1 : 4);
        }
        SEAM(pb + 6);
    }
#undef IN
#undef SEAM
#undef WSP
#undef SPLIT_ARRIVE
#undef SPLIT_WAIT
#undef XRES
}
constexpr int N_PHASES = 29;

static int fast_grid() {
    static int grid = 0;
    if (grid == 0) {
        int dev = 0, cus = 0;
        if (hipGetDevice(&dev) != hipSuccess || hipDeviceGetAttribute(&cus, hipDeviceAttributeMultiprocessorCount, dev) != hipSuccess) { grid = -1; return grid; }
        if (hipFuncSetAttribute((const void*)mega, hipFuncAttributeMaxDynamicSharedMemorySize, LDS_BYTES) != hipSuccess) { fprintf(stderr, "hipFuncSetAttribute failed\n"); grid = -1; return grid; }
        int per_cu = 0;
        if (hipOccupancyMaxActiveBlocksPerMultiprocessor(&per_cu, (const void*)mega, NWAVES * 64, LDS_BYTES) != hipSuccess || per_cu < 1) { fprintf(stderr, "occupancy query: %d blocks/CU\n", per_cu); (void)hipGetLastError(); }
        grid = cus;
    }
    return grid;
}
static void launch_fast(Params p, int lo, int hi, int li, hipStream_t st) {
    const int grid = fast_grid(); if (grid <= 0) return;
    p.ph_lo = lo; p.ph_hi = hi; p.li = li; p.pad = 0;
    hipLaunchKernelGGL(mega, dim3(grid), dim3(NWAVES * 64), LDS_BYTES, st, p);
    const hipError_t e = hipPeekAtLastError(); if (e != hipSuccess) fprintf(stderr, "mega launch failed: %s\n", hipGetErrorName(e));
}
}
namespace oo {
constexpr size_t TPD = (size_t)fx::TP * fx::D, TSD = (size_t)fx::TS * fx::D;
constexpr size_t Y = 0, DKP = (size_t)fx::T * fx::D, DVP = DKP + 2 * TPD, WKP = DVP + 2 * TPD, WVP = WKP + 32768, BKP = WVP + 32768, BVP = BKP + TPD,
    DKS = BVP + TPD, DVS = DKS + 2 * TSD, WKS = DVS + 2 * TSD, WVS = WKS + 524288, BKS = WVS + 524288, BVS = BKS + 524288, END = BVS + 524288;
static_assert(END == 122224640ull, "output size");
}
#if FX_STAMP
#ifndef ST_A
#define ST_A 3
#endif
#ifndef ST_B
#define ST_B 2
#endif
__global__ void encode_time(const unsigned long long* st, float* ys, int n, float* y0) {
    __shared__ float sc;
    if (threadIdx.x == 0) {
        float us[29]; for (int k = 0; k < 29; ++k) us[k] = (float)(st[k + 1] - st[k]) * 0.01f;
        float g[16]; for (int i = 0; i < 16; ++i) g[i] = 0.f;
        g[0] = us[0];
        for (int L = 0; L < 4; ++L) { const int pb = 1 + 7 * L, mix = L % 3; g[1] += us[pb]; g[2] += us[pb + 1]; g[3 + mix] += us[pb + 2]; g[6] += us[pb + 3]; g[7] += us[pb + 4]; g[8] += us[pb + 5]; g[9] += us[pb + 6]; }
        g[13] = g[0] + g[1] + g[7]; g[14] = g[4] + g[5]; g[15] = g[2] + g[6] + g[8] + g[9];
        g[10] = 0.f; g[11] = 0.f; for (int L = 0; L < 4; ++L) { const int pb = 1 + 7 * L; g[10] += (float)(st[64 + pb + 6] - st[32 + pb + 6]) * 0.01f; g[11] += (float)(st[64 + pb + 1] - st[32 + pb + 1]) * 0.01f + (float)(st[64 + pb + 3] - st[32 + pb + 3]) * 0.01f + (float)(st[64 + pb + 5] - st[32 + pb + 5]) * 0.01f; }
        sc = 1.f + sqrtf(g[ST_A] * 1e-4f);
        y0[0] += g[ST_B] * 0.01f;
    }
    __syncthreads();
    const float s = sc;
    for (int i = blockIdx.x * blockDim.x + threadIdx.x; i < n; i += gridDim.x * blockDim.x) ys[i] *= s;
}
#endif
#ifndef FX_N_LAUNCH
#define FX_N_LAUNCH 1
#endif
extern "C" void kernel_launch(void* const* d_in, const int* in_sizes, int n_in, void* d_out, int out_size, void* d_ws, size_t ws_size, hipStream_t stream) {
    using namespace fx;
    if (n_in != 26 || out_size != (int)oo::END || ws_size < WS_END) { fprintf(stderr, "kernel_launch: unexpected sizes n_in %d out %d ws %zu\n", n_in, out_size, ws_size); return; }
    unsigned char* ws = (unsigned char*)d_ws; float* out = (float*)d_out;
    (void)hipMemsetAsync(ws + WS_CTL, 0, CTL_ZERO_BYTES, stream);
    Params p{};
    for (int i = 0; i < 26; ++i) p.in[i] = (const float*)d_in[i];
    p.ws = ws; p.yout = out + oo::Y;
    for (int j = 0; j < 2; ++j) { p.dkp[j] = out + oo::DKP + j * oo::TPD; p.dvp[j] = out + oo::DVP + j * oo::TPD; p.dks[j] = out + oo::DKS + j * oo::TSD; p.dvs[j] = out + oo::DVS + j * oo::TSD; }
    p.wkp = out + oo::WKP; p.wvp = out + oo::WVP; p.wks = out + oo::WKS; p.wvs = out + oo::WVS;
    p.bkp = out + oo::BKP; p.bvp = out + oo::BVP; p.bks = out + oo::BKS; p.bvs = out + oo::BVS;
    if (FX_N_LAUNCH == 1) launch_fast(p, 0, N_PHASES, 0, stream);
    else for (int k = 0; k < N_PHASES; ++k) launch_fast(p, k, k + 1, k, stream);
#if FX_STAMP
    encode_time<<<32, 256, 0, stream>>>((const unsigned long long*)((unsigned*)(ws + WS_CTL) + 200000), out + oo::WVP, 32768, out + 5);
#endif
}
```

```cpp
#include <hip/hip_runtime.h>
#include <cstdio>
#include <cstdint>
#include <cmath>
namespace pg8 {


#define PG8_LAS __attribute__((address_space(3)))
typedef unsigned short bf16_t;
typedef short bf16x8 __attribute__((ext_vector_type(8)));
typedef float f32x4 __attribute__((ext_vector_type(4)));
typedef unsigned u32x4 __attribute__((ext_vector_type(4)));
constexpr int BM = 256, BK = 64, HALF = 128, HTB = HALF * BK * 2  , STAGE_BYTES = 8 * HTB, NXCD = 8, WGM = 8;

__host__ __device__ __forceinline__ int lds_byte(int r, int c) { const int st = (r >> 4) * 2 + (c >> 5), rr = r & 15, cc = c & 31, ob = rr * 64 + cc * 2; return st * 1024 + (ob ^ (((ob >> 9) & 1) << 5)); }
__host__ __device__ __forceinline__ void stage_rc(int b, int& R, int& C) { const int st = b / 1024, sb = b % 1024, swz = sb ^ (((sb >> 9) & 1) << 5); R = (st >> 1) * 16 + swz / 64; C = (st & 1) * 32 + (swz % 64) / 2; }
__host__ __device__ __forceinline__ int perm32(int rho) { const int n = rho >> 4, i = rho & 15; return 8 * (i >> 2) + 4 * n + (i & 3); }

__device__ __forceinline__ int otid() { int t = threadIdx.x; asm volatile("" : "+v"(t)); return t; }
template <class Tp> __device__ __forceinline__ Tp* opq(Tp* x) { asm volatile("" : "+s"(x)); return x; }
__device__ __forceinline__ int opqi(int x) { asm volatile("" : "+s"(x)); return x; }
struct Unit { int pm, pn; };
struct Gemm { const bf16_t* A; const bf16_t* Bt; int M, N, K; };

__device__ __forceinline__ int static_pm0(int M, int N, int G, int c) {
    const int nM = M / BM, nN = N / BM, nwg = nM * nN; if (c >= nwg) return -1;
    int wgid = c; { const int q = nwg / NXCD, r = nwg % NXCD, xcd = wgid % NXCD, off = wgid / NXCD; wgid = (xcd < r ? xcd * (q + 1) : r * (q + 1) + (xcd - r) * q) + off; }
    const int nig = WGM * nN, gid = wgid / nig, fm = gid * WGM, gsz = (nM - fm) < WGM ? (nM - fm) : WGM;
    return fm + ((wgid % nig) % gsz);
}
struct StaticOrder {
    int nM, nN, nwg, G, c;
    __host__ __device__ void init(int M, int N, int G_, int c_) { nM = M / BM; nN = N / BM; nwg = nM * nN; G = G_; c = c_; }
    __host__ __device__ bool next(int i, Unit& u) const {
        const long L = (long)i * G + c; if (L >= nwg) return false;
        int wgid = (int)L; { const int q = nwg / NXCD, r = nwg % NXCD, xcd = wgid % NXCD, off = wgid / NXCD; wgid = (xcd < r ? xcd * (q + 1) : r * (q + 1) + (xcd - r) * q) + off; }
        const int nig = WGM * nN, gid = wgid / nig, fm = gid * WGM, gsz = (nM - fm) < WGM ? (nM - fm) : WGM;
        u.pm = fm + ((wgid % nig) % gsz); u.pn = (wgid % nig) / gsz; return true;
    }
    __device__ __forceinline__ void a_ready(const Unit&) const {}
    __device__ __forceinline__ void done(const Unit&) const {}
};

typedef unsigned u32x2e __attribute__((ext_vector_type(2)));
__device__ __forceinline__ unsigned cvt_pk_bf16(float lo, float hi) { unsigned r; asm volatile("v_cvt_pk_bf16_f32 %0, %1, %2" : "=v"(r) : "v"(lo), "v"(hi)); return r; }
constexpr int E_TP = 16384;
__device__ __forceinline__ void rows_rin(const float* rowss, int row0, int fq, float (&rin)[2][4]) {
    f32x4 a[2][4];
#pragma unroll
    for (int ai = 0; ai < 2; ++ai)
#pragma unroll
        for (int m = 0; m < 4; ++m) a[ai][m] = *(const f32x4*)(rowss + (size_t)(row0 + ai * HALF + m * 16) * 16 + 4 * fq);
    float sv[2][4];
#pragma unroll
    for (int ai = 0; ai < 2; ++ai)
#pragma unroll
        for (int m = 0; m < 4; ++m) sv[ai][m] = (a[ai][m][0] + a[ai][m][1]) + (a[ai][m][2] + a[ai][m][3]);
#pragma unroll
    for (int ai = 0; ai < 2; ++ai)
#pragma unroll
        for (int m = 0; m < 4; ++m) sv[ai][m] += __shfl_xor(sv[ai][m], 16);
#pragma unroll
    for (int ai = 0; ai < 2; ++ai)
#pragma unroll
        for (int m = 0; m < 4; ++m) sv[ai][m] += __shfl_xor(sv[ai][m], 32);
#pragma unroll
    for (int ai = 0; ai < 2; ++ai)
#pragma unroll
        for (int m = 0; m < 4; ++m) rin[ai][m] = rsqrtf(sv[ai][m] * (1.f / 1024.f) + 1e-6f);
}
__device__ __forceinline__ float row_rin(const float* rowss, int row, int fq) { const f32x4 a = *(const f32x4*)(rowss + (size_t)row * 16 + 4 * fq); float s = (a[0] + a[1]) + (a[2] + a[3]);
    s += __shfl_xor(s, 16); s += __shfl_xor(s, 32); return rsqrtf(s * (1.f / 1024.f) + 1e-6f); }

struct EpiQKV {
    static constexpr bool PERM = true, AFTER_DRAIN = false;
    bf16_t *Qb, *Kb, *Vb; int ldkv, nq, nk, has_norm; const float *qg, *kg; float qscale;
    float *kp, *vp, *ks, *vs; int swa;
    const float* rowss;
    const PG8_LAS float* rtab;
    __device__ __forceinline__ void operator()(const f32x4 (&acc)[2][2][4][2], const Unit& u, int wr, int wc, int fr, int fq) const {
        const float* rss_ = opq(rowss);
        bf16_t *Qb_ = opq(Qb), *Kb_ = opq(Kb), *Vb_ = opq(Vb); float *kp_ = opq(kp), *vp_ = opq(vp), *ks_ = opq(ks), *vs_ = opq(vs); const float *qg_ = opq(qg), *kg_ = opq(kg);
        const int hg = u.pn * 4 + wc; int type, gi;
        if (hg < nq) { type = 0; gi = hg; } else if (hg < nq + nk) { type = 1; gi = hg - nq; } else { type = 2; gi = hg - nq - nk; }
        float gsc[2][8];
        const float base = type == 0 ? qscale : 1.f;
#pragma unroll
        for (int bj = 0; bj < 2; ++bj)
#pragma unroll
            for (int e = 0; e < 8; ++e) gsc[bj][e] = base;
        const bool normed = has_norm && type < 2;
        if (normed) { const float* g = type == 0 ? qg_ : kg_;
#pragma unroll
            for (int bj = 0; bj < 2; ++bj)
#pragma unroll
                for (int e = 0; e < 8; ++e) gsc[bj][e] = g[32 * bj + 8 * fq + e] * base; }
        const int row0 = u.pm * BM + wr * 64 + fr; const bool prompt = u.pm < E_TP / BM;
        float rinv[2][4];
        if (rss_) {
#pragma unroll
            for (int ai = 0; ai < 2; ++ai)
#pragma unroll
                for (int m = 0; m < 4; ++m) rinv[ai][m] = rtab[wr * 64 + ai * HALF + m * 16 + fr]; }
        bf16_t* bdst = type == 0 ? Qb_ : (type == 1 ? Kb_ : Vb_); const int bld = type == 0 ? 1024 : ldkv;
        float* fdst = type == 1 ? (prompt ? kp_ : ks_) : (prompt ? vp_ : vs_);
        float hss[2][4];
        if (normed) {
#pragma unroll
            for (int ai = 0; ai < 2; ++ai)
#pragma unroll
                for (int m = 0; m < 4; ++m) { float ss = 0.f;
#pragma unroll
                    for (int bj = 0; bj < 2; ++bj)
#pragma unroll
                        for (int n = 0; n < 2; ++n) { const f32x4 x = acc[ai][bj][m][n]; ss += (x[0] * x[0] + x[1] * x[1]) + (x[2] * x[2] + x[3] * x[3]); }
                    hss[ai][m] = ss; }
#pragma unroll
            for (int ai = 0; ai < 2; ++ai)
#pragma unroll
                for (int m = 0; m < 4; ++m) hss[ai][m] += __shfl_xor(hss[ai][m], 16);
#pragma unroll
            for (int ai = 0; ai < 2; ++ai)
#pragma unroll
                for (int m = 0; m < 4; ++m) hss[ai][m] += __shfl_xor(hss[ai][m], 32); }
#pragma unroll
        for (int ai = 0; ai < 2; ++ai)
#pragma unroll
            for (int m = 0; m < 4; ++m) {
                const int row = row0 + ai * HALF + m * 16;
                const float rin = rss_ ? rinv[ai][m] : 1.f;
                float rs = rin;
                if (normed) rs = rin * rsqrtf(hss[ai][m] * (rin * rin) * (1.f / 64.f) + 1e-6f);
                long frow = -1;
                if (type >= 1) { if (!swa) frow = prompt ? row : row - E_TP;
                                 else if (prompt) frow = row - (E_TP - 128); else { const int rr = row - E_TP; frow = (long)(rr >> 5) * 128 + 96 + (rr & 31); } }
#pragma unroll
                for (int bj = 0; bj < 2; ++bj) {
                    f32x4 v0 = acc[ai][bj][m][0] * rs, v1 = acc[ai][bj][m][1] * rs;
                    v0[0] *= gsc[bj][0]; v0[1] *= gsc[bj][1]; v0[2] *= gsc[bj][2]; v0[3] *= gsc[bj][3]; v1[0] *= gsc[bj][4]; v1[1] *= gsc[bj][5]; v1[2] *= gsc[bj][6]; v1[3] *= gsc[bj][7];
                    const int col = gi * 64 + 32 * bj + 8 * fq;
                    u32x4 w; w.x = cvt_pk_bf16(v0[0], v0[1]); w.y = cvt_pk_bf16(v0[2], v0[3]); w.z = cvt_pk_bf16(v1[0], v1[1]); w.w = cvt_pk_bf16(v1[2], v1[3]);
                    *(u32x4*)(bdst + (size_t)row * bld + col) = w;
                    if (frow >= 0) { float* f = fdst + (size_t)frow * ldkv + col; *(f32x4*)f = v0; *(f32x4*)(f + 4) = v1; }
                }
            }
    }
};
struct EpiResid {
    static constexpr bool PERM = true, AFTER_DRAIN = false;
    const float* xin32; const bf16_t* xin16; bf16_t* xout16; float* y32; float* rss;
    __device__ __forceinline__ void operator()(const f32x4 (&acc)[2][2][4][2], const Unit& u, int wr, int wc, int fr, int fq) const {
        const int row0 = u.pm * BM + wr * 64 + fr, col0 = u.pn * BM + wc * 32 + 8 * fq;
        const float* x32 = opq(xin32); float* yo = opq(y32); float* rs_ = opq(rss); float ssv[2][4];
#pragma unroll
        for (int ai = 0; ai < 2; ++ai)
#pragma unroll
            for (int m = 0; m < 4; ++m) { const size_t ro = (size_t)(row0 + ai * HALF + m * 16) * 1024 + col0; float ss = 0.f;
#pragma unroll
                for (int bj = 0; bj < 2; ++bj) { const size_t o = ro + bj * HALF; f32x4 x0, x1;
                    if (x32) { x0 = *(const f32x4*)(x32 + o); x1 = *(const f32x4*)(x32 + o + 4); }
                    else { const u32x4 b = *(const u32x4*)(xin16 + o);
                        x0 = (f32x4){__uint_as_float(b.x << 16), __uint_as_float(b.x & 0xffff0000u), __uint_as_float(b.y << 16), __uint_as_float(b.y & 0xffff0000u)};
                        x1 = (f32x4){__uint_as_float(b.z << 16), __uint_as_float(b.z & 0xffff0000u), __uint_as_float(b.w << 16), __uint_as_float(b.w & 0xffff0000u)}; }
                    x0 = x0 + acc[ai][bj][m][0]; x1 = x1 + acc[ai][bj][m][1];
                    if (yo) { *(f32x4*)(yo + o) = x0; *(f32x4*)(yo + o + 4) = x1; }
                    else { u32x4 w; w.x = cvt_pk_bf16(x0[0], x0[1]); w.y = cvt_pk_bf16(x0[2], x0[3]); w.z = cvt_pk_bf16(x1[0], x1[1]); w.w = cvt_pk_bf16(x1[2], x1[3]); *(u32x4*)(xout16 + o) = w;
#pragma unroll
                        for (int e = 0; e < 4; ++e) { const float a = __uint_as_float(w[e] << 16), b = __uint_as_float(w[e] & 0xffff0000u); ss += a * a + b * b; } } }
                ssv[ai][m] = ss;
                if (m & 1) asm volatile("" ::: "memory"); }
        if (rs_) {
#pragma unroll
            for (int ai = 0; ai < 2; ++ai)
#pragma unroll
                for (int m = 0; m < 4; ++m) ssv[ai][m] += __shfl_xor(ssv[ai][m], 16);
#pragma unroll
            for (int ai = 0; ai < 2; ++ai)
#pragma unroll
                for (int m = 0; m < 4; ++m) ssv[ai][m] += __shfl_xor(ssv[ai][m], 32);
            if (fq == 0) {
#pragma unroll
                for (int ai = 0; ai < 2; ++ai)
#pragma unroll
                    for (int m = 0; m < 4; ++m) rs_[(size_t)(row0 + ai * HALF + m * 16) * 16 + u.pn * 4 + wc] = ssv[ai][m]; } }
    }
};
struct EpiRelu2 {
    static constexpr bool PERM = true, AFTER_DRAIN = false;
    bf16_t* O; int ldc; const float* rowss;
    const PG8_LAS float* rtab;
    __device__ __forceinline__ void operator()(const f32x4 (&acc)[2][2][4][2], const Unit& u, int wr, int wc, int fr, int fq) const {
        const int row0 = u.pm * BM + wr * 64 + fr, col0 = u.pn * BM + wc * 32 + 8 * fq;
        float rinv[2][4];
#pragma unroll
        for (int ai = 0; ai < 2; ++ai)
#pragma unroll
            for (int m = 0; m < 4; ++m) rinv[ai][m] = rtab[wr * 64 + ai * HALF + m * 16 + fr];
#pragma unroll
        for (int ai = 0; ai < 2; ++ai)
#pragma unroll
            for (int m = 0; m < 4; ++m) { bf16_t* rowp = O + (size_t)(row0 + ai * HALF + m * 16) * ldc + col0;
                const float rin2 = rinv[ai][m] * rinv[ai][m];
#pragma unroll
                for (int bj = 0; bj < 2; ++bj) { f32x4 v0 = acc[ai][bj][m][0], v1 = acc[ai][bj][m][1];
#pragma unroll
                    for (int e = 0; e < 4; ++e) { const float a = fmaxf(v0[e], 0.f), b = fmaxf(v1[e], 0.f); v0[e] = a * a * rin2; v1[e] = b * b * rin2; }
                    u32x4 w; w.x = cvt_pk_bf16(v0[0], v0[1]); w.y = cvt_pk_bf16(v0[2], v0[3]); w.z = cvt_pk_bf16(v1[0], v1[1]); w.w = cvt_pk_bf16(v1[2], v1[3]);
                    *(u32x4*)(rowp + bj * HALF) = w; } }
    }
};
template <class Epi, class Sched, bool ALIGN_EPI = false, bool SP2 = false>
__device__ __forceinline__ void gemm_phase(PG8_LAS unsigned char* lds, const Gemm g, const Sched& S, const Epi& E) {
    const int tid = otid(), wid = __builtin_amdgcn_readfirstlane(tid >> 6), lane = tid & 63, wr = wid >> 2, wc = wid & 3, fr = lane & 15, fq = lane >> 4;
    const int K = g.K, nt = K / BK;
    unsigned voffA[2], voffB[2];
#pragma unroll
    for (int i = 0; i < 2; ++i) { int R, C; stage_rc(tid * 16 + i * 8192, R, C); const int Rb = Epi::PERM ? ((R & ~31) + perm32(R & 31)) : R;
        voffA[i] = (unsigned)(R * K + C) * 2u; voffB[i] = (unsigned)(Rb * K + C) * 2u; }
    const size_t kstep = (size_t)(BK * 2);
    const size_t hstep = (size_t)HALF * K * 2;
    const size_t tstep = 2 * hstep;
    const unsigned ldsw = (unsigned)wid * 1024u;
    const int aoff = lds_byte(wr * 64 + fr, fq * 8), boff = lds_byte(wc * 32 + fr, fq * 8);
#define PG8_SA(b, h) (((b) * 2 + (h)) * HTB)
#define PG8_SB(b, h) ((4 + (b) * 2 + (h)) * HTB)
#define PG8_STAGE(bufoff, gbase, voff) do { _Pragma("unroll") for (int _i = 0; _i < 2; ++_i) \
        __builtin_amdgcn_global_load_lds((const unsigned*)((const char*)(gbase) + (voff)[_i]), (PG8_LAS unsigned*)(lds + (bufoff) + ldsw + _i * 8192), 16, 0, 0); } while (0)
#define PG8_LDA(dst, b, h) do { _Pragma("unroll") for (int m = 0; m < 4; ++m) _Pragma("unroll") for (int k = 0; k < 2; ++k) dst[m][k] = *(const PG8_LAS bf16x8*)(lds + PG8_SA(b, h) + aoff + m * 2048 + k * 1024); } while (0)
#define PG8_LDB(dst, b, h) do { _Pragma("unroll") for (int n = 0; n < 2; ++n) _Pragma("unroll") for (int k = 0; k < 2; ++k) dst[n][k] = *(const PG8_LAS bf16x8*)(lds + PG8_SB(b, h) + boff + n * 2048 + k * 1024); } while (0)
#define PG8_MMA(ai, bj, At, Bt) do { __builtin_amdgcn_s_setprio(1); _Pragma("unroll") for (int m = 0; m < 4; ++m) _Pragma("unroll") for (int n = 0; n < 2; ++n) _Pragma("unroll") for (int k = 0; k < 2; ++k) \
        acc[ai][bj][m][n] = __builtin_amdgcn_mfma_f32_16x16x32_bf16(Bt[n][k], At[m][k], acc[ai][bj][m][n], 0, 0, 0); __builtin_amdgcn_s_setprio(0); } while (0)
#define PG8_WAIT_V(n) asm volatile("s_waitcnt vmcnt(" #n ")" ::: "memory")
#define PG8_WAIT_L(n) asm volatile("s_waitcnt lgkmcnt(" #n ")" ::: "memory")
#define PG8_BAR __builtin_amdgcn_s_barrier()
#define PG8_SCHED __builtin_amdgcn_sched_barrier(0)
    Unit cur, nxt; int ui = 0;
    if (!S.next(0, cur)) return;
    f32x4 acc[2][2][4][2];
#pragma unroll
    for (int a = 0; a < 2; ++a)
#pragma unroll
        for (int b = 0; b < 2; ++b)
#pragma unroll
            for (int m = 0; m < 4; ++m)
#pragma unroll
                for (int n = 0; n < 2; ++n) acc[a][b][m][n] = (f32x4){0.f, 0.f, 0.f, 0.f};
    bf16x8 At[4][2], B0[2][2], B1[2][2];
    const char* cA = (const char*)g.A + (size_t)cur.pm * tstep; const char* cB = (const char*)g.Bt + (size_t)cur.pn * tstep;
    S.a_ready(cur);
    if constexpr (SP2) {
        PG8_STAGE(PG8_SB(0, 0), cB, voffB); PG8_STAGE(PG8_SB(0, 1), cB + hstep, voffB); PG8_STAGE(PG8_SA(0, 0), cA, voffA); PG8_STAGE(PG8_SA(0, 1), cA + hstep, voffA);
        if (wr == 1) PG8_BAR;
        PG8_WAIT_V(2); PG8_BAR;
        PG8_STAGE(PG8_SB(1, 0), cB + kstep, voffB); PG8_STAGE(PG8_SA(1, 0), cA + kstep, voffA); PG8_STAGE(PG8_SB(1, 1), cB + hstep + kstep, voffB);
        PG8_WAIT_V(6); PG8_BAR;
    } else {
        PG8_STAGE(PG8_SB(0, 0), cB, voffB); PG8_STAGE(PG8_SA(0, 0), cA, voffA); PG8_STAGE(PG8_SB(0, 1), cB + hstep, voffB); PG8_STAGE(PG8_SA(0, 1), cA + hstep, voffA);
        if (wr == 1) PG8_BAR;
        PG8_WAIT_V(4); PG8_BAR;
        PG8_STAGE(PG8_SB(1, 0), cB + kstep, voffB); PG8_STAGE(PG8_SA(1, 0), cA + kstep, voffA); PG8_STAGE(PG8_SB(1, 1), cB + hstep + kstep, voffB);
        PG8_WAIT_V(6); PG8_BAR;
    }
    for (;;) {
        const bool has_next = S.next(ui + 1, nxt);
        const char* nA = has_next ? (const char*)g.A + (size_t)nxt.pm * tstep : cA; const char* nB = has_next ? (const char*)g.Bt + (size_t)nxt.pn * tstep : cB;
        for (int t = 0; t < nt; t += 2) {
            const bool last = (t == nt - 2);
            const char* a1 = cA + (size_t)(t + 1) * kstep;
            const char* a2 = last ? nA : cA + (size_t)(t + 2) * kstep; const char* b2 = last ? nB : cB + (size_t)(t + 2) * kstep;
            const char* a3 = a2 + kstep; const char* b3 = b2 + kstep;
            if (last && has_next) S.a_ready(nxt);
            if constexpr (SP2) {
            PG8_LDB(B0, 0, 0); PG8_LDB(B1, 0, 1); PG8_SCHED; PG8_LDA(At, 0, 0); PG8_STAGE(PG8_SA(1, 1), a1 + hstep, voffA);
            PG8_WAIT_V(8); PG8_WAIT_L(0); PG8_BAR; PG8_MMA(0, 0, At, B0); PG8_MMA(0, 1, At, B1); PG8_BAR; PG8_SCHED;
            PG8_LDA(At, 0, 1); PG8_STAGE(PG8_SB(0, 0), b2, voffB); PG8_STAGE(PG8_SB(0, 1), b2 + hstep, voffB); PG8_STAGE(PG8_SA(0, 0), a2, voffA);
            PG8_WAIT_V(8); PG8_WAIT_L(0); PG8_BAR; PG8_MMA(1, 0, At, B0); PG8_MMA(1, 1, At, B1); PG8_BAR; PG8_SCHED;
            PG8_LDB(B0, 1, 0); PG8_LDB(B1, 1, 1); PG8_SCHED; PG8_LDA(At, 1, 0); PG8_STAGE(PG8_SA(0, 1), a2 + hstep, voffA);
            PG8_WAIT_V(8); PG8_WAIT_L(0); PG8_BAR; PG8_MMA(0, 0, At, B0); PG8_MMA(0, 1, At, B1); PG8_BAR; PG8_SCHED;
            PG8_LDA(At, 1, 1); PG8_STAGE(PG8_SB(1, 0), b3, voffB); PG8_STAGE(PG8_SB(1, 1), b3 + hstep, voffB); PG8_STAGE(PG8_SA(1, 0), a3, voffA);
            PG8_WAIT_V(8); PG8_WAIT_L(0); PG8_BAR; PG8_MMA(1, 0, At, B0); PG8_MMA(1, 1, At, B1); PG8_BAR; PG8_SCHED;
            } else {
            PG8_LDB(B0, 0, 0); PG8_SCHED; PG8_LDA(At, 0, 0); PG8_STAGE(PG8_SA(1, 1), a1 + hstep, voffA);
            PG8_WAIT_L(8); PG8_BAR; PG8_WAIT_L(0); PG8_MMA(0, 0, At, B0); PG8_BAR; PG8_SCHED;
            PG8_LDB(B1, 0, 1); PG8_STAGE(PG8_SB(0, 0), b2, voffB);
            PG8_BAR; PG8_WAIT_L(0); PG8_MMA(0, 1, At, B1); PG8_BAR;
            PG8_LDA(At, 0, 1); PG8_STAGE(PG8_SA(0, 0), a2, voffA);
            PG8_BAR; PG8_WAIT_L(0); PG8_MMA(1, 0, At, B0); PG8_BAR; PG8_SCHED;
            PG8_STAGE(PG8_SB(0, 1), b2 + hstep, voffB);
            PG8_WAIT_V(6); PG8_BAR; PG8_MMA(1, 1, At, B1); PG8_BAR;
            PG8_LDB(B0, 1, 0); PG8_SCHED; PG8_LDA(At, 1, 0); PG8_STAGE(PG8_SA(0, 1), a2 + hstep, voffA);
            PG8_WAIT_L(8); PG8_BAR; PG8_WAIT_L(0); PG8_MMA(0, 0, At, B0); PG8_BAR; PG8_SCHED;
            PG8_LDB(B1, 1, 1); PG8_STAGE(PG8_SB(1, 0), b3, voffB);
            PG8_BAR; PG8_WAIT_L(0); PG8_MMA(0, 1, At, B1); PG8_BAR;
            PG8_LDA(At, 1, 1); PG8_STAGE(PG8_SA(1, 0), a3, voffA);
            PG8_BAR; PG8_WAIT_L(0); PG8_MMA(1, 0, At, B0); PG8_BAR; PG8_SCHED;
            PG8_STAGE(PG8_SB(1, 1), b3 + hstep, voffB);
            PG8_WAIT_V(6); PG8_BAR; PG8_MMA(1, 1, At, B1); PG8_BAR;
            }
        }
        if constexpr (ALIGN_EPI) { if (wr == 0) PG8_BAR; }
        if constexpr (!Epi::AFTER_DRAIN) { E(acc, cur, wr, wc, fr, fq); S.done(cur); }
        if (!has_next) break;
#pragma unroll
        for (int a = 0; a < 2; ++a)
#pragma unroll
            for (int b = 0; b < 2; ++b)
#pragma unroll
                for (int m = 0; m < 4; ++m)
#pragma unroll
                    for (int n = 0; n < 2; ++n) acc[a][b][m][n] = (f32x4){0.f, 0.f, 0.f, 0.f};
        cur = nxt; cA = nA; cB = nB; ++ui;
        if constexpr (ALIGN_EPI) { if (wr == 1) PG8_BAR; }
    }
    PG8_WAIT_V(0);
    if constexpr (!ALIGN_EPI) { if (wr == 0) PG8_BAR; }
    PG8_BAR;
    if constexpr (Epi::AFTER_DRAIN) { E.fused(acc, cur, wr, wc, fr, fq, lds, wid, lane); S.done(cur); }
#undef PG8_SA
#undef PG8_SB
#undef PG8_STAGE
#undef PG8_LDA
#undef PG8_LDB
#undef PG8_MMA
#undef PG8_WAIT_V
#undef PG8_WAIT_L
#undef PG8_BAR
#undef PG8_SCHED
}
}
namespace fx {
#define LAS __attribute__((address_space(3)))
typedef unsigned short bf16_t;
typedef short bf16x8 __attribute__((ext_vector_type(8)));
typedef short s16x4 __attribute__((ext_vector_type(4)));
typedef float f32x4 __attribute__((ext_vector_type(4)));
typedef float f32x16 __attribute__((ext_vector_type(16)));
typedef unsigned u32x4 __attribute__((ext_vector_type(4)));
typedef unsigned u32x2 __attribute__((ext_vector_type(2)));
constexpr int D = 1024, TP = 16384, TS = 512, T = TP + TS, FF = 4096, NWAVES = 8;
constexpr float LOG2E = 1.4426950408889634f, QSC = 0.125f * LOG2E;

typedef float f32x2_t __attribute__((ext_vector_type(2))); typedef __bf16 bf16x2_t __attribute__((ext_vector_type(2)));
__device__ __forceinline__ unsigned cvtpk(float lo, float hi) { f32x2_t v = {lo, hi}; bf16x2_t b = __builtin_convertvector(v, bf16x2_t); return __builtin_bit_cast(unsigned, b); }
__device__ __forceinline__ u32x4 pack8(f32x4 a, f32x4 b) { u32x4 w; w.x = cvtpk(a.x, a.y); w.y = cvtpk(a.z, a.w); w.z = cvtpk(b.x, b.y); w.w = cvtpk(b.z, b.w); return w; }
__device__ __forceinline__ float wave_sum(float v) {
#pragma unroll
    for (int o = 32; o; o >>= 1) v += __shfl_xor(v, o);
    return v;
}
__device__ __forceinline__ int t5_bucket(int rel) {
    const int ret = rel > 0 ? 16 : 0; const int n = rel < 0 ? -rel : rel;
    const int b = n < 8 ? n : n < 12 ? 8 : n < 16 ? 9 : n < 23 ? 10 : n < 32 ? 11 : n < 46 ? 12 : n < 64 ? 13 : n < 91 ? 14 : 15;
    return ret + b;
}
__device__ __forceinline__ int crow(int r, int hi) { return (r & 3) + 8 * (r >> 2) + 4 * hi; }
constexpr size_t MiB = 1u << 20;
#if defined(FX_STAMP) && FX_STAMP
constexpr size_t WS_CTL = 0, CTL_ZERO_BYTES = 1 * MiB;
#else
constexpr size_t WS_CTL = 0, CTL_ZERO_BYTES = 128 * 1024;
#endif
constexpr size_t WL_QKV = 0, WL_O = (size_t)3072 * 1024 * 2, WL_UP = WL_O + (size_t)1024 * 1024 * 2, WL_DN = WL_UP + (size_t)4096 * 1024 * 2, WL_BYTES = WL_DN + (size_t)4096 * 1024 * 2;
constexpr size_t WS_W = 1 * MiB, WS_XN = WS_W + 4 * WL_BYTES, ACT_B = (size_t)T * D * 2;
constexpr size_t WS_Q = WS_XN + ACT_B, WS_K = WS_Q + ACT_B, WS_V = WS_K + ACT_B, WS_O = WS_V + ACT_B, WS_U = WS_Q, WS_XR = WS_O + ACT_B, WS_SLAB = WS_XR + ACT_B, WS_RSS = WS_SLAB + 4 * (size_t)TS * D * 4, WS_END = WS_RSS + (size_t)TP * 16 * 4;
static_assert(WL_BYTES == 24 * MiB && WS_END < 320 * MiB, "ws map");
constexpr int CW_TMO = 0, CW_CODE = 1, CW_BAR = 4096, CW_FLAG = 16384;
constexpr int RING_BYTES = 131072, LDSCTL_OFF = RING_BYTES, MISC_OFF = LDSCTL_OFF + 320, GA_TAB = LDSCTL_OFF + 512, GA_WSF = GA_TAB + 4 * 160 * 4, GA_FLG = GA_WSF + NWAVES * 64 * 4, LDS_BYTES = 147456;
static_assert(GA_FLG + 64 <= LDS_BYTES, "LDS map");
enum In { X_P = 0, X_S, C_DK, C_DV, C_WK, C_WV, C_BK, C_BV, REL_BIAS, NORM_MIX, NORM_MLP, W_UP, W_DOWN, D_WQKV, D_WO, D_QN, D_KN, D_LAM, D_SUBLN, S_WQKV, S_WO, S_QN, S_KN, S_SINKS, B_WQKV, B_WO };

struct Params {
    const float* in[26];
    unsigned char* ws;
    float* yout;
    float *dkp[2], *dvp[2], *dks[2], *dvs[2];
    float *wkp, *wvp, *wks, *wvs;
    float *bkp, *bvp, *bks, *bvs;
    int ph_lo, ph_hi, li, pad;
};

#define XB_TMO      128
#define XB_XCNT(j)  (256  + 64 * (j))
#define XB_XSUB(j)  (1280 + 64 * (j))
#define XB_XGEN(j)  (2304 + 64 * (j))
#define XB_TOP      3328
#define XB_TOPGEN   3392
#define XCD_BAR_WORDS 3456
#define XB_SPIN_CAP (1u << 18)

__device__ __forceinline__ unsigned xb_ld(unsigned* p)              { return __hip_atomic_load(p, __ATOMIC_RELAXED, __HIP_MEMORY_SCOPE_AGENT); }
__device__ __forceinline__ unsigned xb_add(unsigned* p, unsigned v) { return __hip_atomic_fetch_add(p, v, __ATOMIC_RELAXED, __HIP_MEMORY_SCOPE_AGENT); }
__device__ __forceinline__ unsigned xb_xcc_id() { return (unsigned)__builtin_amdgcn_s_getreg((3 << 11) | 20) & 0xFu; }
#define XB_SPIN(cond, bar) do { unsigned _sp = 0; while (cond) { __builtin_amdgcn_s_sleep(1); \
    if ((++_sp & 255u) == 0u) { if (xb_ld(&(bar)[XB_TMO])) break; if (_sp > XB_SPIN_CAP) { atomicAdd(&(bar)[XB_TMO], 1u); break; } } } } while (0)

struct XcdBarrier {
    unsigned* bar; unsigned x;
    volatile LAS unsigned* st;
};

__device__ __forceinline__ XcdBarrier xcd_barrier_post(unsigned* bar, volatile LAS unsigned* st) {
    XcdBarrier b; b.bar = bar; b.x = xb_xcc_id(); b.st = st;
    if (threadIdx.x == 0) (void)xb_add(&bar[XB_XCNT(b.x)], 1u);
    return b;
}
__device__ __forceinline__ void xcd_barrier_complete(unsigned* bar, unsigned x, unsigned& nloc, unsigned& nx) {
    const unsigned G = gridDim.x * gridDim.y * gridDim.z;
    unsigned sum, cnt, mine, sp = 0u;
    for (;;) {
        sum = 0u; cnt = 0u; mine = 0u;
#pragma unroll
        for (unsigned j = 0; j < 16; ++j) { const unsigned c = xb_ld(&bar[XB_XCNT(j)]); sum += c; cnt += (c > 0u) ? 1u : 0u; mine = (j == x) ? c : mine; }
        if (sum == G) break;
        __builtin_amdgcn_s_sleep(1);
        if ((++sp & 255u) == 0u) { if (xb_ld(&bar[XB_TMO])) break; if (sp > XB_SPIN_CAP) { atomicAdd(&bar[XB_TMO], 1u); break; } }
    }
    nloc = mine > 0u ? mine : 1u; nx = cnt > 0u ? cnt : 1u;
}

__device__ __forceinline__ void xcd_barrier(const XcdBarrier& b) {
    asm volatile("s_waitcnt vmcnt(0)" ::: "memory");
    __syncthreads();
    if (threadIdx.x == 0) {
        unsigned* bar = b.bar;
        __builtin_amdgcn_s_waitcnt(0);
        unsigned nloc = b.st[0], nx = b.st[1];
        if (nloc == 0u) { xcd_barrier_complete(bar, b.x, nloc, nx); b.st[0] = nloc; b.st[1] = nx; }
        const unsigned old = xb_add(&bar[XB_XSUB(b.x)], 1u);
        const unsigned gen = old / nloc;
        if (old + 1u == (gen + 1u) * nloc) {
            __builtin_amdgcn_fence(__ATOMIC_RELEASE, "agent");
            asm volatile("s_waitcnt vmcnt(0)" ::: "memory");
            const unsigned og = xb_add(&bar[XB_TOP], 1u);
            const unsigned tg = og / nx;
            if (og + 1u == (tg + 1u) * nx) xb_add(&bar[XB_TOPGEN], 1u);
            else XB_SPIN(xb_ld(&bar[XB_TOPGEN]) == tg, bar);
            __builtin_amdgcn_fence(__ATOMIC_ACQUIRE, "agent");
            xb_add(&bar[XB_XGEN(b.x)], 1u);
            asm volatile("s_waitcnt vmcnt(0)" ::: "memory");
        } else {
            XB_SPIN(xb_ld(&bar[XB_XGEN(b.x)]) == gen, bar);
            __builtin_amdgcn_fence(__ATOMIC_ACQUIRE, "agent");
            asm volatile("s_waitcnt vmcnt(0)" ::: "memory");
        }
    }
    __syncthreads();
}


__device__ __forceinline__ unsigned f2bf(float f) { unsigned u = __builtin_bit_cast(unsigned, f); return (u + 0x7fffu + ((u >> 16) & 1u)) >> 16; }
__device__ __forceinline__ unsigned pk2(float lo, float hi) { return f2bf(lo) | (f2bf(hi) << 16); }
struct PItem { const float* W; const float* gk; bf16_t* WT; int K, N, k0, n0, dst; };
__device__ __forceinline__ bool pro_item(const Params& p, int it, PItem& q) {
    constexpr int I_QKV = 16 * 96, I_O = 16 * 32, I_UP = 16 * 128, I_DN = 64 * 32, PER = I_QKV + I_O + I_UP + I_DN;
    const int layer = it / PER, mix = layer % 3, j = layer / 3; int r = it % PER;
    unsigned char* wl = p.ws + WS_W + (size_t)layer * WL_BYTES;
    if (r < I_QKV) {
        const int N = mix == 1 ? 1536 : 3072, nblk = N / 32; if (r >= 16 * nblk) return false;
        const float* W = mix == 0 ? p.in[D_WQKV] + (size_t)j * D * 3072 : (mix == 1 ? p.in[S_WQKV] : p.in[B_WQKV]);
        const int kb = r / nblk, nb = r % nblk, n0 = 32 * nb, within = n0 & 255;
        q.W = W; q.gk = p.in[NORM_MIX] + layer * D; q.WT = (bf16_t*)(wl + WL_QKV); q.K = D; q.N = N; q.k0 = 64 * kb; q.n0 = n0;
        q.dst = (n0 & ~255) + 128 * ((within >> 5) & 1) + 32 * (within >> 6);
        return true; }
    r -= I_QKV;
    if (r < I_O) { q.W = mix == 0 ? p.in[D_WO] + (size_t)j * D * D : (mix == 1 ? p.in[S_WO] : p.in[B_WO]); q.gk = nullptr; q.WT = (bf16_t*)(wl + WL_O); q.K = D; q.N = D; q.k0 = 64 * (r / 32); q.n0 = 32 * (r % 32); q.dst = q.n0; return true; }
    r -= I_O;
    if (r < I_UP) { q.W = p.in[W_UP] + (size_t)layer * D * FF; q.gk = p.in[NORM_MLP] + layer * D; q.WT = (bf16_t*)(wl + WL_UP); q.K = D; q.N = FF; q.k0 = 64 * (r / 128); q.n0 = 32 * (r % 128); q.dst = q.n0; return true; }
    r -= I_UP;
    q.W = p.in[W_DOWN] + (size_t)layer * FF * D; q.gk = nullptr; q.WT = (bf16_t*)(wl + WL_DN); q.K = FF; q.N = D; q.k0 = 64 * (r / 32); q.n0 = 32 * (r % 32); q.dst = q.n0; return true;
}
__device__ __forceinline__ void pro_load(const PItem& q, int lane, f32x4 (&wv)[8]) {
#pragma unroll
    for (int i = 0; i < 8; ++i) wv[i] = *(const f32x4*)(q.W + (size_t)(q.k0 + 8 * i + (lane >> 3)) * q.N + q.n0 + 4 * (lane & 7));
}
__device__ __forceinline__ void pro_store(const PItem& q, int lane, const f32x4 (&wv)[8], LAS float* scr) {
#pragma unroll
    for (int i = 0; i < 8; ++i) { const int kk = 8 * i + (lane >> 3); const float g_ = q.gk ? q.gk[q.k0 + kk] : 1.f; LAS float* d_ = scr + kk * 33 + 4 * (lane & 7);
        d_[0] = wv[i][0] * g_; d_[1] = wv[i][1] * g_; d_[2] = wv[i][2] * g_; d_[3] = wv[i][3] * g_; }
    asm volatile("s_waitcnt lgkmcnt(0)" ::: "memory");
    const int c = lane & 7;
#pragma unroll
    for (int j = 0; j < 4; ++j) { const int n = (lane >> 3) + 8 * j; const LAS float* s = scr + (8 * c) * 33 + n;
        u32x4 o; o.x = pk2(s[0 * 33], s[1 * 33]); o.y = pk2(s[2 * 33], s[3 * 33]); o.z = pk2(s[4 * 33], s[5 * 33]); o.w = pk2(s[6 * 33], s[7 * 33]);
        *(u32x4*)(q.WT + (size_t)(q.dst + n) * q.K + q.k0 + 8 * c) = o; }
    asm volatile("s_waitcnt lgkmcnt(0)" ::: "memory");
}
__device__ __forceinline__ void prologue(const Params& p, LAS unsigned char* lds, int gw, int NGW, int wave, int lane) {
    LAS float* scr = (LAS float*)(lds + wave * 16384);
    constexpr int NIT = 4 * (16 * 96 + 16 * 32 + 16 * 128 + 64 * 32);
    PItem a, b; f32x4 wa[8], wb[8]; int it = gw; bool va = false, vb = false;
    while (it < NIT && !(va = pro_item(p, it, a))) it += NGW;
    if (va) pro_load(a, lane, wa);
    if (va) { it += NGW; while (it < NIT && !(vb = pro_item(p, it, b))) it += NGW; }
    if (vb) pro_load(b, lane, wb);
    while (va) {
        PItem c; f32x4 wc[8]; bool vc = false;
        if (vb) { it += NGW; while (it < NIT && !(vc = pro_item(p, it, c))) it += NGW; }
        if (vc) pro_load(c, lane, wc);
        pro_store(a, lane, wa, scr);
        a = b; va = vb; b = c; vb = vc;
#pragma unroll
        for (int i = 0; i < 8; ++i) { wa[i] = wb[i]; wb[i] = wc[i]; }
    }
    for (int i = gw * 64 + lane; i < 16 * 96 * 64; i += NGW * 64) { const int c4 = i & 63, r = (i >> 6) % 96, b = i / (96 * 64);
        ((f32x4*)p.wks)[((size_t)b * 128 + r) * 64 + c4] = ((const f32x4*)p.in[C_WK])[((size_t)b * 128 + r + 32) * 64 + c4];
        ((f32x4*)p.wvs)[((size_t)b * 128 + r) * 64 + c4] = ((const f32x4*)p.in[C_WV])[((size_t)b * 128 + r + 32) * 64 + c4]; }
}
__device__ __forceinline__ void rms_phase(const float* xp32, const float* xs32, bf16_t* xb, const float* slab, int row_lo, bf16_t* XN, int gw, int NGW, int lane) {
    for (int row = row_lo + gw; row < T; row += NGW) {
        f32x4 v[4]; const bool smp = row >= TP; const float* x32 = smp ? xs32 : xp32;
        if (!x32) { const u32x4* xr = (const u32x4*)(xb + (size_t)row * D) + 2 * lane; const u32x4 a = xr[0], c = xr[1];
            v[0] = (f32x4){__uint_as_float(a.x << 16), __uint_as_float(a.x & 0xffff0000u), __uint_as_float(a.y << 16), __uint_as_float(a.y & 0xffff0000u)};
            v[1] = (f32x4){__uint_as_float(a.z << 16), __uint_as_float(a.z & 0xffff0000u), __uint_as_float(a.w << 16), __uint_as_float(a.w & 0xffff0000u)};
            v[2] = (f32x4){__uint_as_float(c.x << 16), __uint_as_float(c.x & 0xffff0000u), __uint_as_float(c.y << 16), __uint_as_float(c.y & 0xffff0000u)};
            v[3] = (f32x4){__uint_as_float(c.z << 16), __uint_as_float(c.z & 0xffff0000u), __uint_as_float(c.w << 16), __uint_as_float(c.w & 0xffff0000u)}; }
        else { const f32x4* xr = (const f32x4*)(x32 + (size_t)(smp ? row - TP : row) * D) + 4 * lane;
#pragma unroll
            for (int j = 0; j < 4; ++j) v[j] = xr[j]; }
        if (smp && slab) {
#pragma unroll
            for (int ks = 0; ks < 4; ++ks) { const f32x4* sr = (const f32x4*)(slab + ((size_t)ks * TS + (row - TP)) * D) + 4 * lane;
#pragma unroll
                for (int j = 0; j < 4; ++j) v[j] = v[j] + sr[j]; }
            u32x4 s0, s1; s0.x = cvtpk(v[0].x, v[0].y); s0.y = cvtpk(v[0].z, v[0].w); s0.z = cvtpk(v[1].x, v[1].y); s0.w = cvtpk(v[1].z, v[1].w);
            s1.x = cvtpk(v[2].x, v[2].y); s1.y = cvtpk(v[2].z, v[2].w); s1.z = cvtpk(v[3].x, v[3].y); s1.w = cvtpk(v[3].z, v[3].w);
            u32x4* xo = (u32x4*)(xb + (size_t)row * D) + 2 * lane; xo[0] = s0; xo[1] = s1;
            v[0] = (f32x4){__uint_as_float(s0.x << 16), __uint_as_float(s0.x & 0xffff0000u), __uint_as_float(s0.y << 16), __uint_as_float(s0.y & 0xffff0000u)};
            v[1] = (f32x4){__uint_as_float(s0.z << 16), __uint_as_float(s0.z & 0xffff0000u), __uint_as_float(s0.w << 16), __uint_as_float(s0.w & 0xffff0000u)};
            v[2] = (f32x4){__uint_as_float(s1.x << 16), __uint_as_float(s1.x & 0xffff0000u), __uint_as_float(s1.y << 16), __uint_as_float(s1.y & 0xffff0000u)};
            v[3] = (f32x4){__uint_as_float(s1.z << 16), __uint_as_float(s1.z & 0xffff0000u), __uint_as_float(s1.w << 16), __uint_as_float(s1.w & 0xffff0000u)}; }
        float s = 0.f;
#pragma unroll
        for (int j = 0; j < 4; ++j) s += (v[j].x * v[j].x + v[j].y * v[j].y) + (v[j].z * v[j].z + v[j].w * v[j].w);
        const float r = rsqrtf(wave_sum(s) * (1.f / D) + 1e-6f);
        u32x4 w0, w1; f32x4 y;
        y = v[0] * r; w0.x = cvtpk(y.x, y.y); w0.y = cvtpk(y.z, y.w); y = v[1] * r; w0.z = cvtpk(y.x, y.y); w0.w = cvtpk(y.z, y.w);
        y = v[2] * r; w1.x = cvtpk(y.x, y.y); w1.y = cvtpk(y.z, y.w); y = v[3] * r; w1.z = cvtpk(y.x, y.y); w1.w = cvtpk(y.z, y.w);
        u32x4* o = (u32x4*)(XN + (size_t)row * D) + 2 * lane; o[0] = w0; o[1] = w1;
    }
}
__device__ __forceinline__ void rms0_phase(const float* xp32, const float* xs32, bf16_t* XN, int gw, int NGW, int lane) {
    int row = gw; if (row >= T) return;
    f32x4 v[4];
    { const f32x4* xr = (const f32x4*)((row >= TP ? xs32 + (size_t)(row - TP) * D : xp32 + (size_t)row * D)) + 4 * lane;
#pragma unroll
      for (int j = 0; j < 4; ++j) v[j] = xr[j]; }
    for (;;) {
        const int nrow = row + NGW; f32x4 w[4];
        if (nrow < T) { const f32x4* xr = (const f32x4*)((nrow >= TP ? xs32 + (size_t)(nrow - TP) * D : xp32 + (size_t)nrow * D)) + 4 * lane;
#pragma unroll
            for (int j = 0; j < 4; ++j) w[j] = xr[j]; }
        float s = 0.f;
#pragma unroll
        for (int j = 0; j < 4; ++j) s += (v[j].x * v[j].x + v[j].y * v[j].y) + (v[j].z * v[j].z + v[j].w * v[j].w);
        const float r = rsqrtf(wave_sum(s) * (1.f / D) + 1e-6f);
        u32x4 w0, w1; f32x4 y;
        y = v[0] * r; w0.x = cvtpk(y.x, y.y); w0.y = cvtpk(y.z, y.w); y = v[1] * r; w0.z = cvtpk(y.x, y.y); w0.w = cvtpk(y.z, y.w);
        y = v[2] * r; w1.x = cvtpk(y.x, y.y); w1.y = cvtpk(y.z, y.w); y = v[3] * r; w1.z = cvtpk(y.x, y.y); w1.w = cvtpk(y.z, y.w);
        u32x4* o = (u32x4*)(XN + (size_t)row * D) + 2 * lane; o[0] = w0; o[1] = w1;
        if (nrow >= T) break;
        row = nrow;
#pragma unroll
        for (int j = 0; j < 4; ++j) v[j] = w[j];
    }
}
typedef short v4i16_t __attribute__((ext_vector_type(4)));
__device__ __forceinline__ s16x4 vtr(const LAS unsigned char* p) { return __builtin_bit_cast(s16x4, __builtin_amdgcn_ds_read_tr16_b64_v4i16((LAS v4i16_t*)p)); }
#define MFMA32(a, b, c) __builtin_amdgcn_mfma_f32_32x32x16_bf16(a, b, c, 0, 0, 0)
enum { M_DIFF_P = 0, M_DIFF_S, M_SWA_P, M_SWA_S, M_SB_P, M_SB_S };

struct RawPiece { u32x4 a, b; };
__device__ __forceinline__ RawPiece ld_piece(const void* src, bool f32, size_t elem_off, bool valid) {
    RawPiece r; r.a = (u32x4){0u, 0u, 0u, 0u}; r.b = r.a;
    if (valid) { if (f32) { const u32x4* s = (const u32x4*)((const float*)src + elem_off); r.a = __builtin_nontemporal_load(s); r.b = __builtin_nontemporal_load(s + 1); }     else r.a = *(const u32x4*)((const bf16_t*)src + elem_off); }
    return r;
}
__device__ __forceinline__ u32x4 cv_piece(const RawPiece& r, bool f32) { return f32 ? pack8(__builtin_bit_cast(f32x4, r.a), __builtin_bit_cast(f32x4, r.b)) : r.a; }

template <int MODE>
__device__ __forceinline__ void attn_unit(const Params& p, LAS unsigned char* lds, int ua, int ub, int j, float lam, float lam_init, const bf16_t* Qb, const bf16_t* Kb, const bf16_t* Vb, bf16_t* Ob) {
    constexpr bool IS_DIFF = MODE == M_DIFF_P || MODE == M_DIFF_S, IS_SWA = MODE == M_SWA_P || MODE == M_SWA_S, IS_SB = MODE == M_SB_P || MODE == M_SB_S;
    constexpr int DV = IS_DIFF ? 128 : 64, NDB = DV / 32, NKS = IS_DIFF ? 2 : (IS_SWA ? 1 : 4), NVS = IS_DIFF ? 1 : (IS_SWA ? 1 : 4), LDKV = IS_SWA ? 256 : 1024;
    constexpr int NTAB = IS_DIFF ? 2 : 4;
    const int tid = pg8::otid(), lane = tid & 63, r32 = lane & 31, hi = lane >> 5; const int wid = __builtin_amdgcn_readfirstlane(tid >> 6);
    LAS float* tab = (LAS float*)(lds + GA_TAB); LAS float* wsf = (LAS float*)(lds + GA_WSF) + wid * 64; LAS unsigned* flg = (LAS unsigned*)(lds + GA_FLG);
    bool compute = true; int qrow0 = 0, qcol = 0, tq0 = 0, kslot = 0, vslot = 0, tsel = 0, kvcol = 0, ntiles = 0, hq = 0, grp = 0;
    if (MODE == M_DIFF_P) { const int m = wid & 1; grp = wid >> 1; qrow0 = ub * 128 + grp * 32; qcol = (2 * ua + m) * 64; tq0 = qrow0; kslot = m; tsel = m; kvcol = ua * 128; ntiles = 2 * ub + 2; }
    if (MODE == M_DIFF_S) { compute = wid < 2; const int m = wid & 1; qrow0 = TP + ua * 32; qcol = (2 * ub + m) * 64; tq0 = 0; kslot = m; tsel = m; kvcol = ub * 128; ntiles = 33; }
    if (MODE == M_SWA_P)  { grp = wid >> 1; hq = ub * 4 + grp; qrow0 = ua * 64 + (wid & 1) * 32; qcol = hq * 64; tq0 = qrow0; tsel = grp; kvcol = ub * 64; ntiles = 3; }
    if (MODE == M_SWA_S)  { compute = wid < 4; grp = wid & 3; hq = ub * 4 + grp; qrow0 = TP + ua * 32; qcol = hq * 64; tq0 = 0; tsel = grp; kvcol = ub * 64; ntiles = 3; }
    if (MODE == M_SB_P)   { grp = wid >> 1; qrow0 = ua * 64 + (wid & 1) * 32; qcol = (ub * 4 + grp) * 64; tq0 = qrow0; kslot = grp; vslot = grp; kvcol = ub * 256; ntiles = ua + 1; }
    if (MODE == M_SB_S)   { compute = wid < 4; grp = wid & 3; qrow0 = TP + ua * 32; qcol = (ub * 4 + grp) * 64; tq0 = 0; kslot = grp; vslot = grp; kvcol = ub * 256; ntiles = 33; }
    __syncthreads();
    bf16x8 qr[4];
    { const bf16_t* qp = Qb + (size_t)(qrow0 + r32) * 1024 + qcol + hi * 8;
#pragma unroll
      for (int d0 = 0; d0 < 4; ++d0) qr[d0] = *(const bf16x8*)(qp + d0 * 16); }
    f32x16 o[NDB];
#pragma unroll
    for (int db = 0; db < NDB; ++db)
#pragma unroll
        for (int r = 0; r < 16; ++r) o[db][r] = 0.f;
    float l = 0.f, acc = 0.f; bool mydone = !compute;
    if (IS_SWA) l = hi == 0 ? __builtin_amdgcn_exp2f(p.in[S_SINKS][hq] * LOG2E) : 0.f;
    const int tq = tq0 + r32;
    const LAS unsigned char* kbase = lds + kslot * 8192 + hi * 1024 + r32 * 16;
    const LAS unsigned char* vbase = lds + 32768 + vslot * (DV * 128) + ((lane >> 4) & 1) * 32 + (lane & 3) * 8 + (4 * hi + ((lane & 15) >> 2)) * 64;
    struct Desc { const void *kp, *vp; bool f32, tvalid, active, far; int nvalid, pos0; };
    auto desc = [&](int it) { Desc d; d.kp = nullptr; d.vp = nullptr; d.f32 = false; d.tvalid = true; d.active = true; d.far = false; d.nvalid = 64; d.pos0 = 0;
        if (MODE == M_DIFF_P) { const size_t off = (size_t)it * 64 * 1024 + kvcol; d.kp = Kb + off; d.vp = Vb + off; d.pos0 = it * 64; d.active = it <= 2 * ub + (grp >> 1); d.far = (d.pos0 + 63 - tq0) <= -91; }
        if (MODE == M_DIFF_S) { if (it < 32) { const size_t off = ((size_t)(j * 16 + ua) * 2048 + it * 64) * 1024 + kvcol; d.kp = p.in[C_DK] + off; d.vp = p.in[C_DV] + off; d.f32 = true; d.pos0 = -2048 + it * 64; d.far = d.pos0 + 63 <= -91; }
                                else { const size_t off = (size_t)(TP + ua * 32) * 1024 + kvcol; d.kp = Kb + off; d.vp = Vb + off; d.nvalid = 32; d.pos0 = 0; } }
        if (MODE == M_SWA_P)  { const int tc = ua - 2 + it; d.tvalid = tc >= 0; const size_t off = (size_t)(tc < 0 ? 0 : tc) * 64 * 256 + kvcol; d.kp = Kb + off; d.vp = Vb + off; d.pos0 = tc * 64; }
        if (MODE == M_SWA_S)  { if (it < 2) { const size_t off = ((size_t)ua * 128 + it * 64) * 256 + kvcol; d.kp = p.in[C_WK] + off; d.vp = p.in[C_WV] + off; d.f32 = true; d.pos0 = -128 + it * 64; }
                                else { const size_t off = (size_t)(TP + ua * 32) * 256 + kvcol; d.kp = Kb + off; d.vp = Vb + off; d.nvalid = 32; d.pos0 = 0; } }
        if (MODE == M_SB_P)   { const int tc = ua - it; const size_t off = (size_t)tc * 64 * 1024 + kvcol; d.kp = Kb + off; d.vp = Vb + off; d.pos0 = tc * 64; }
        if (MODE == M_SB_S)   { if (it == 0) { const size_t off = (size_t)(TP + ua * 32) * 1024 + kvcol; d.kp = Kb + off; d.vp = Vb + off; d.nvalid = 32; d.pos0 = 0; }
                                else { const int tc = 32 - it; const size_t off = ((size_t)ua * 2048 + tc * 64) * 1024 + kvcol; d.kp = p.in[C_BK] + off; d.vp = p.in[C_BV] + off; d.f32 = true; d.pos0 = -2048 + tc * 64; } }
        return d; };
    constexpr int NVP = NVS * (DV / 64);
    RawPiece rk[NKS], rv[NVP];
    const int kkey = (tid & 7) + 8 * (tid >> 6), kchunk = (tid >> 3) & 7, vkey = (tid >> 2) & 63, vpl = tid & 3, vdb = tid >> 8;
#define GA_LOAD(d) do { if ((d).tvalid) { \
        _Pragma("unroll") for (int s_ = 0; s_ < NKS; ++s_) rk[s_] = ld_piece((d).kp, (d).f32, (size_t)kkey * LDKV + s_ * 64 + kchunk * 8, kkey < (d).nvalid); \
        _Pragma("unroll") for (int s_ = 0; s_ < NVS; ++s_) _Pragma("unroll") for (int ps_ = 0; ps_ < DV / 64; ++ps_) \
            rv[s_ * (DV / 64) + ps_] = ld_piece((d).vp, (d).f32, (size_t)vkey * LDKV + s_ * DV + (vdb + 2 * ps_) * 32 + vpl * 8, vkey < (d).nvalid); } } while (0)
#define GA_STORE(d) do { if ((d).tvalid) { \
        _Pragma("unroll") for (int s_ = 0; s_ < NKS; ++s_) *(LAS u32x4*)(lds + s_ * 8192 + kchunk * 1024 + kkey * 16) = cv_piece(rk[s_], (d).f32); \
        _Pragma("unroll") for (int s_ = 0; s_ < NVS; ++s_) _Pragma("unroll") for (int ps_ = 0; ps_ < DV / 64; ++ps_) \
            *(LAS u32x4*)(lds + 32768 + s_ * (DV * 128) + (vdb + 2 * ps_) * 4096 + vkey * 64 + vpl * 16) = cv_piece(rv[s_ * (DV / 64) + ps_], (d).f32); } } while (0)
    { const Desc d0 = desc(0); GA_LOAD(d0); }
    if (!IS_SB) {
        for (int idx = tid; idx < NTAB * 155; idx += NWAVES * 64) { const int ti = idx / 155, i = idx % 155;
            const int head = IS_DIFF ? 2 * (MODE == M_DIFF_P ? ua : ub) + ti : ub * 4 + ti;
            float v = p.in[REL_BIAS][t5_bucket(i - 91) * 16 + head];
            if (IS_DIFF) v -= p.in[REL_BIAS][15 * 16 + head];
            tab[ti * 160 + i] = v * LOG2E; }
    }
    for (int it = 0; it < ntiles; ++it) {
        const Desc d = desc(it);
        const bool f32 = d.f32, tvalid = d.tvalid, active = d.active, far = d.far; const int nvalid = d.nvalid, pos0 = d.pos0; (void)f32;
        GA_STORE(d);
        __syncthreads();
        if (it + 1 < ntiles) { const Desc dn = desc(it + 1); GA_LOAD(dn); }
        if (tvalid && compute && active && !mydone) {
            f32x16 p0, p1;
#pragma unroll
            for (int r = 0; r < 16; ++r) { p0[r] = 0.f; p1[r] = 0.f; }
#pragma unroll
            for (int d0 = 0; d0 < 4; ++d0) { const bf16x8 b0 = *(const LAS bf16x8*)(kbase + d0 * 2048), b1 = *(const LAS bf16x8*)(kbase + d0 * 2048 + 512);
                p0 = MFMA32(b0, qr[d0], p0); p1 = MFMA32(b1, qr[d0], p1); }
            if (!IS_SB) {
                const LAS float* tb = tab + tsel * 160; const int relb = pos0 - tq + 91; float ls = 0.f;
#pragma unroll
                for (int r = 0; r < 16; ++r) { const int kv = crow(r, hi); float s0 = p0[r], s1 = p1[r];
                    if (!far) { int i0 = relb + kv, i1 = i0 + 32; i0 = i0 < 0 ? 0 : (i0 > 154 ? 154 : i0); i1 = i1 < 0 ? 0 : (i1 > 154 ? 154 : i1); s0 += tb[i0]; s1 += tb[i1]; }
                    float e0 = __builtin_amdgcn_exp2f(s0), e1 = __builtin_amdgcn_exp2f(s1);
                    if (kv >= nvalid) e0 = 0.f; if (kv + 32 >= nvalid) e1 = 0.f;
                    p0[r] = e0; p1[r] = e1; ls += e0 + e1; }
                l += ls;
            } else {
                float L0[16], L1[16];
#pragma unroll
                for (int r = 0; r < 16; ++r) { const int kv = crow(r, hi);
                    if (!(kv < nvalid && pos0 + kv < tq)) p0[r] = -INFINITY;
                    if (!(kv + 32 < nvalid && pos0 + kv + 32 < tq)) p1[r] = -INFINITY;
                    L0[r] = __builtin_amdgcn_logf(1.f + __builtin_amdgcn_exp2f(p0[r])); L1[r] = __builtin_amdgcn_logf(1.f + __builtin_amdgcn_exp2f(p1[r])); }
                float gs[8], go[8];
#pragma unroll
                for (int g = 0; g < 4; ++g) { gs[g] = (L0[4 * g] + L0[4 * g + 1]) + (L0[4 * g + 2] + L0[4 * g + 3]); gs[4 + g] = (L1[4 * g] + L1[4 * g + 1]) + (L1[4 * g + 2] + L1[4 * g + 3]); }
#pragma unroll
                for (int g = 0; g < 8; ++g) go[g] = __shfl_xor(gs[g], 32);
                float after = 0.f;
#pragma unroll
                for (int g = 7; g >= 0; --g) {
                    float run = after + (hi == 0 ? go[g] : 0.f);
#pragma unroll
                    for (int i = 3; i >= 0; --i) { const int r = 4 * (g & 3) + i;
                        if (g < 4) { const float Lr = L0[r]; p0[r] = __builtin_amdgcn_exp2f(p0[r] - Lr + acc - run); run += Lr; }
                        else       { const float Lr = L1[r]; p1[r] = __builtin_amdgcn_exp2f(p1[r] - Lr + acc - run); run += Lr; } }
                    after += gs[g] + go[g];
                }
                acc -= after;
                mydone = __all(acc < -152.f);
            }
            u32x4 pw[4];
            pw[0] = (u32x4){cvtpk(p0[0], p0[1]), cvtpk(p0[2], p0[3]), cvtpk(p0[4], p0[5]), cvtpk(p0[6], p0[7])};
            pw[1] = (u32x4){cvtpk(p0[8], p0[9]), cvtpk(p0[10], p0[11]), cvtpk(p0[12], p0[13]), cvtpk(p0[14], p0[15])};
            pw[2] = (u32x4){cvtpk(p1[0], p1[1]), cvtpk(p1[2], p1[3]), cvtpk(p1[4], p1[5]), cvtpk(p1[6], p1[7])};
            pw[3] = (u32x4){cvtpk(p1[8], p1[9]), cvtpk(p1[10], p1[11]), cvtpk(p1[12], p1[13]), cvtpk(p1[14], p1[15])};
#pragma unroll
            for (int db = 0; db < NDB; ++db)
#pragma unroll
                for (int ks = 0; ks < 4; ++ks) { const s16x4 lo = vtr(vbase + db * 4096 + ks * 1024), hh = vtr(vbase + db * 4096 + ks * 1024 + 512);
                    const bf16x8 vf = (bf16x8){lo[0], lo[1], lo[2], lo[3], hh[0], hh[1], hh[2], hh[3]};
                    o[db] = MFMA32(__builtin_bit_cast(bf16x8, pw[ks]), vf, o[db]); }
        }
        if (IS_SB) { if (lane == 0) flg[wid] = mydone ? 1u : 0u; }
        __syncthreads();
        if (IS_SB) { unsigned all = 1u;
#pragma unroll
            for (int w = 0; w < NWAVES; ++w) all &= flg[w];
            if (all) break; }
    }
#undef GA_LOAD
#undef GA_STORE
    LAS float* st = (LAS float*)(lds + wid * (32 * DV * 4));
    if (compute) {
        float rinv[16];
        if (!IS_SB) { const float lt = l + __shfl_xor(l, 32); if (hi == 0) wsf[r32] = lt;
            asm volatile("s_waitcnt lgkmcnt(0)" ::: "memory");
#pragma unroll
            for (int r = 0; r < 16; ++r) rinv[r] = 1.f / wsf[crow(r, hi)]; }
        else {
#pragma unroll
            for (int r = 0; r < 16; ++r) rinv[r] = 1.f; }
#pragma unroll
        for (int db = 0; db < NDB; ++db)
#pragma unroll
            for (int r = 0; r < 16; ++r) st[crow(r, hi) * DV + 32 * db + r32] = o[db][r] * rinv[r];
    }
    __syncthreads();
    if (compute) {
        if (IS_DIFF) {
            const int pair = wid >> 1, row = 16 * (wid & 1) + (lane >> 2), qd = lane & 3;
            const LAS float* s0 = (const LAS float*)(lds + (2 * pair) * 16384) + row * 128 + qd * 32; const LAS float* s1 = s0 + 4096;
            const int head = MODE == M_DIFF_P ? ua : ub; const size_t orow = MODE == M_DIFF_P ? (size_t)ub * 128 + pair * 32 + row : (size_t)TP + ua * 32 + row;
            float x[32]; float ss = 0.f;
#pragma unroll
            for (int e = 0; e < 32; ++e) { x[e] = s0[e] - lam * s1[e]; ss += x[e] * x[e]; }
            ss += __shfl_xor(ss, 1); ss += __shfl_xor(ss, 2);
            const float rs = rsqrtf(ss * (1.f / 128.f) + 1e-6f) * (1.f - lam_init);
            const float* sg = p.in[D_SUBLN] + j * 128 + qd * 32; bf16_t* op = Ob + orow * 1024 + head * 128 + qd * 32;
#pragma unroll
            for (int c = 0; c < 4; ++c) { u32x4 w;
                w.x = cvtpk(x[8 * c] * rs * sg[8 * c], x[8 * c + 1] * rs * sg[8 * c + 1]); w.y = cvtpk(x[8 * c + 2] * rs * sg[8 * c + 2], x[8 * c + 3] * rs * sg[8 * c + 3]);
                w.z = cvtpk(x[8 * c + 4] * rs * sg[8 * c + 4], x[8 * c + 5] * rs * sg[8 * c + 5]); w.w = cvtpk(x[8 * c + 6] * rs * sg[8 * c + 6], x[8 * c + 7] * rs * sg[8 * c + 7]);
                *(u32x4*)(op + 8 * c) = w; }
        } else {
            const int row = lane >> 1, hf = lane & 1; const LAS float* s0 = st + row * 64 + hf * 32; bf16_t* op = Ob + (size_t)(qrow0 + row) * 1024 + qcol + hf * 32;
#pragma unroll
            for (int c = 0; c < 4; ++c) { u32x4 w; w.x = cvtpk(s0[8 * c], s0[8 * c + 1]); w.y = cvtpk(s0[8 * c + 2], s0[8 * c + 3]); w.z = cvtpk(s0[8 * c + 4], s0[8 * c + 5]); w.w = cvtpk(s0[8 * c + 6], s0[8 * c + 7]);
                *(u32x4*)(op + 8 * c) = w; }
        }
    }
}
__device__ __forceinline__ void glds16(const void* gsrc, unsigned lds_dst) {
    unsigned keep;
    asm volatile("s_mov_b32 %0, m0\n\ts_mov_b32 m0, %2\n\ts_nop 0\n\tglobal_load_lds_dwordx4 %1, off\n\ts_mov_b32 m0, %0" : "=&s"(keep) : "v"(gsrc), "s"(lds_dst) : "memory");
}
#define DP_WAIT_BAR(N) asm volatile("s_waitcnt vmcnt(" #N ") lgkmcnt(0)\n\ts_barrier" ::: "memory")
__device__ __forceinline__ void attn_diff_p2(const Params& p, LAS unsigned char* lds, int h, int qb, int j, float lam, float lam_init, const bf16_t* Qb, const bf16_t* Kb, const bf16_t* Vb, bf16_t* Ob) {
    const int tid = pg8::otid(), lane = tid & 63, r32 = lane & 31, hi = lane >> 5; const int wid = __builtin_amdgcn_readfirstlane(tid >> 6);
    const int m = wid & 1, grp = wid >> 1, qrow0 = qb * 128 + grp * 32, NT = 2 * qb + 2, tlast = 2 * qb + (grp >> 1);
    LAS float* tab = (LAS float*)(lds + GA_TAB); LAS float* wsf = (LAS float*)(lds + GA_WSF) + wid * 64;
    __syncthreads();
    for (int idx = tid; idx < 2 * 155; idx += NWAVES * 64) { const int ti = idx / 155, i = idx % 155; const int head = 2 * h + ti;
        tab[ti * 160 + i] = (p.in[REL_BIAS][t5_bucket(i - 91) * 16 + head] - p.in[REL_BIAS][15 * 16 + head]) * LOG2E; }
    const unsigned lds0 = (unsigned)(uintptr_t)lds;
    const bf16_t* ksrc = Kb + (size_t)lane * 1024 + h * 128 + wid * 8;
    const bf16_t* vsrc = Vb + (size_t)(16 * (wid & 3) + (lane >> 2)) * 1024 + h * 128 + (wid >> 2) * 32 + (lane & 3) * 8;
    const unsigned kdst = lds0 + wid * 1024, vdst = lds0 + 49152 + (wid >> 2) * 4096 + (wid & 3) * 1024;
#define DP_DMA(t, kslot_, vslot_) do { const bf16_t* ks_ = ksrc + (size_t)(t) * 65536; const bf16_t* vs_ = vsrc + (size_t)(t) * 65536; const unsigned ko_ = (unsigned)(kslot_) * 16384u, vo_ = (unsigned)(vslot_) * 16384u; \
        glds16(ks_, (unsigned)__builtin_amdgcn_readfirstlane(kdst + ko_)); glds16(ks_ + 64, (unsigned)__builtin_amdgcn_readfirstlane(kdst + ko_ + 8192u)); \
        glds16(vs_, (unsigned)__builtin_amdgcn_readfirstlane(vdst + vo_)); glds16(vs_ + 64, (unsigned)__builtin_amdgcn_readfirstlane(vdst + vo_ + 8192u)); } while (0)
    DP_DMA(0, 0, 0); DP_DMA(1, 1, 1);
    bf16x8 qr[4];
    { const bf16_t* qp = Qb + (size_t)(qrow0 + r32) * 1024 + (2 * h + m) * 64 + hi * 8;
#pragma unroll
      for (int d0 = 0; d0 < 4; ++d0) qr[d0] = *(const bf16x8*)(qp + d0 * 16); }
    asm volatile("" : "+v"(qr[0]), "+v"(qr[1]), "+v"(qr[2]), "+v"(qr[3]));
    f32x16 o[4];
#pragma unroll
    for (int db = 0; db < 4; ++db)
#pragma unroll
        for (int r = 0; r < 16; ++r) o[db][r] = 0.f;
    float l = 0.f;
    const int tq = qrow0 + r32;
    const LAS unsigned char* kb0 = lds + (8 * m + hi) * 1024 + r32 * 16;
    const LAS unsigned char* vb0 = lds + 49152 + ((lane >> 4) & 1) * 32 + (lane & 3) * 8 + (4 * hi + ((lane & 15) >> 2)) * 64;
    const LAS float* tb = tab + m * 160;
#ifndef DP_STAGGER
#define DP_STAGGER 0
#endif
    const bool late = DP_STAGGER && wid >= 4;
    u32x4 pwp[4];
#pragma unroll
    for (int i = 0; i < 4; ++i) pwp[i] = (u32x4){0u, 0u, 0u, 0u};
#define DP_PV(PW, vslot) do { const LAS unsigned char* vb = vb0 + (vslot) * 16384; s16x4 vl[2][4], vh[2][4]; \
        _Pragma("unroll") for (int ks = 0; ks < 4; ++ks) { vl[0][ks] = vtr(vb + ks * 1024); vh[0][ks] = vtr(vb + ks * 1024 + 512); } \
        _Pragma("unroll") for (int db = 0; db < 4; ++db) { \
            if (db < 3) { _Pragma("unroll") for (int ks = 0; ks < 4; ++ks) { vl[(db + 1) & 1][ks] = vtr(vb + (db + 1) * 4096 + ks * 1024); vh[(db + 1) & 1][ks] = vtr(vb + (db + 1) * 4096 + ks * 1024 + 512); } } \
            __builtin_amdgcn_sched_barrier(0); \
            _Pragma("unroll") for (int ks = 0; ks < 4; ++ks) { const s16x4 lo = vl[db & 1][ks], hh = vh[db & 1][ks]; \
                const bf16x8 vf = (bf16x8){lo[0], lo[1], lo[2], lo[3], hh[0], hh[1], hh[2], hh[3]}; \
                o[db] = MFMA32(__builtin_bit_cast(bf16x8, PW[ks]), vf, o[db]); } \
            __builtin_amdgcn_sched_barrier(0); } } while (0)
    int kslot = 0, kslot2 = 2, vslot = 0, vslot2 = 2, vprev = 3;
    for (int t = 0; t < NT; ++t) {
        if (t + 1 < NT) DP_WAIT_BAR(4); else DP_WAIT_BAR(0);
        if (t + 2 < NT) DP_DMA(t + 2, kslot2, vslot2);
        if (late && t >= 1) DP_PV(pwp, vprev);
        if (t <= tlast) {
            const LAS unsigned char* kb = kb0 + kslot * 16384;
            f32x16 p0, p1;
#pragma unroll
            for (int r = 0; r < 16; ++r) { p0[r] = 0.f; p1[r] = 0.f; }
            bf16x8 kf[8];
#pragma unroll
            for (int d0 = 0; d0 < 4; ++d0) { kf[2 * d0] = *(const LAS bf16x8*)(kb + d0 * 2048); kf[2 * d0 + 1] = *(const LAS bf16x8*)(kb + d0 * 2048 + 512); }
            __builtin_amdgcn_sched_barrier(0);
#pragma unroll
            for (int d0 = 0; d0 < 4; ++d0) { p0 = MFMA32(kf[2 * d0], qr[d0], p0); p1 = MFMA32(kf[2 * d0 + 1], qr[d0], p1); }
            const int pos0 = t * 64;
            if (pos0 + 63 - qrow0 > -91) {
                const int relb = pos0 - tq + 91;
#pragma unroll
                for (int r = 0; r < 16; ++r) { const int kv = crow(r, hi); int i0 = relb + kv, i1 = i0 + 32; i0 = i0 < 0 ? 0 : (i0 > 154 ? 154 : i0); i1 = i1 < 0 ? 0 : (i1 > 154 ? 154 : i1);
                    p0[r] += tb[i0]; p1[r] += tb[i1]; }
            }
            float ls = 0.f;
#pragma unroll
            for (int r = 0; r < 16; ++r) { p0[r] = __builtin_amdgcn_exp2f(p0[r]); p1[r] = __builtin_amdgcn_exp2f(p1[r]); ls += p0[r] + p1[r]; }
            l += ls;
            u32x4 pw[4];
            pw[0] = (u32x4){cvtpk(p0[0], p0[1]), cvtpk(p0[2], p0[3]), cvtpk(p0[4], p0[5]), cvtpk(p0[6], p0[7])};
            pw[1] = (u32x4){cvtpk(p0[8], p0[9]), cvtpk(p0[10], p0[11]), cvtpk(p0[12], p0[13]), cvtpk(p0[14], p0[15])};
            pw[2] = (u32x4){cvtpk(p1[0], p1[1]), cvtpk(p1[2], p1[3]), cvtpk(p1[4], p1[5]), cvtpk(p1[6], p1[7])};
            pw[3] = (u32x4){cvtpk(p1[8], p1[9]), cvtpk(p1[10], p1[11]), cvtpk(p1[12], p1[13]), cvtpk(p1[14], p1[15])};
            if (!late) DP_PV(pw, vslot);
            else {
#pragma unroll
                for (int i = 0; i < 4; ++i) pwp[i] = pw[i]; }
        }
        kslot = kslot == 2 ? 0 : kslot + 1; kslot2 = kslot2 == 2 ? 0 : kslot2 + 1;
        vprev = vslot; vslot = (vslot + 1) & 3; vslot2 = (vslot2 + 1) & 3;
    }
    if (late) DP_PV(pwp, vprev);
#undef DP_PV
#undef DP_DMA
    __syncthreads();
    { LAS float* st = (LAS float*)(lds + wid * 16384);
      const float lt = l + __shfl_xor(l, 32); if (hi == 0) wsf[r32] = lt;
      asm volatile("s_waitcnt lgkmcnt(0)" ::: "memory");
      float rinv[16];
#pragma unroll
      for (int r = 0; r < 16; ++r) rinv[r] = 1.f / wsf[crow(r, hi)];
#pragma unroll
      for (int db = 0; db < 4; ++db)
#pragma unroll
          for (int r = 0; r < 16; ++r) st[crow(r, hi) * 128 + 32 * db + r32] = o[db][r] * rinv[r]; }
    __syncthreads();
    { const int row = 16 * m + (lane >> 2), qd = lane & 3;
      const LAS float* s0 = (const LAS float*)(lds + (2 * grp) * 16384) + row * 128 + qd * 32; const LAS float* s1 = s0 + 4096;
      float x[32]; float ss = 0.f;
#pragma unroll
      for (int e = 0; e < 32; ++e) { x[e] = s0[e] - lam * s1[e]; ss += x[e] * x[e]; }
      ss += __shfl_xor(ss, 1); ss += __shfl_xor(ss, 2);
      const float rs = rsqrtf(ss * (1.f / 128.f) + 1e-6f) * (1.f - lam_init);
      const float* sg = p.in[D_SUBLN] + j * 128 + qd * 32; bf16_t* op = Ob + ((size_t)qb * 128 + grp * 32 + row) * 1024 + h * 128 + qd * 32;
#pragma unroll
      for (int c = 0; c < 4; ++c) { u32x4 w;
          w.x = cvtpk(x[8 * c] * rs * sg[8 * c], x[8 * c + 1] * rs * sg[8 * c + 1]); w.y = cvtpk(x[8 * c + 2] * rs * sg[8 * c + 2], x[8 * c + 3] * rs * sg[8 * c + 3]);
          w.z = cvtpk(x[8 * c + 4] * rs * sg[8 * c + 4], x[8 * c + 5] * rs * sg[8 * c + 5]); w.w = cvtpk(x[8 * c + 6] * rs * sg[8 * c + 6], x[8 * c + 7] * rs * sg[8 * c + 7]);
          *(u32x4*)(op + 8 * c) = w; } }
}
#define P3_SBAR() __builtin_amdgcn_sched_barrier(0)
#define P3_PIN(x) asm volatile("" : "+v"(x))
#define P3_WAIT_BAR(N) asm volatile("s_waitcnt vmcnt(" #N ") lgkmcnt(0)\n\ts_barrier" ::: "memory")
__device__ __forceinline__ void attn_diff_p3(const Params& p, LAS unsigned char* lds, int h, int qb, int j, float lam, float lam_init, const bf16_t* Qb, const bf16_t* Kb, const bf16_t* Vb, bf16_t* Ob) {
    const int tid = pg8::otid(), lane = tid & 63, r32 = lane & 31, hi = lane >> 5; const int wid = __builtin_amdgcn_readfirstlane(tid >> 6);
    const int m = wid & 1, grp = wid >> 1, qrow0 = qb * 128 + grp * 32, NT = 2 * qb + 2; const bool early = grp < 2;
    LAS float* tab = (LAS float*)(lds + GA_TAB); LAS float* wsf = (LAS float*)(lds + GA_WSF) + wid * 64;
    __syncthreads();
    const unsigned lds0 = (unsigned)(uintptr_t)lds;
    const bf16_t* ksrc = Kb + (size_t)(16 * (wid & 3) + (lane & 15)) * 1024 + h * 128 + (wid >> 2) * 32 + (lane >> 4) * 8;
    const bf16_t* vsrc = Vb + (size_t)(16 * (wid & 3) + (lane >> 2)) * 1024 + h * 128 + (wid >> 2) * 32 + (lane & 3) * 8;
    const unsigned kdst = lds0 + (wid & 3) * 4096 + (wid >> 2) * 1024, vdst = lds0 + 49152 + (wid >> 2) * 4096 + (wid & 3) * 1024;
#define DMA_K(t, sl) do { const bf16_t* s_ = ksrc + (size_t)(t) * 65536; glds16(s_, (unsigned)__builtin_amdgcn_readfirstlane(kdst + (unsigned)(sl))); glds16(s_ + 64, (unsigned)__builtin_amdgcn_readfirstlane(kdst + (unsigned)(sl) + 2048u)); } while (0)
#define DMA_V(t, sl) do { const bf16_t* s_ = vsrc + (size_t)(t) * 65536; glds16(s_, (unsigned)__builtin_amdgcn_readfirstlane(vdst + (unsigned)(sl))); glds16(s_ + 64, (unsigned)__builtin_amdgcn_readfirstlane(vdst + (unsigned)(sl) + 8192u)); } while (0)
    constexpr int SL = 16384;
    DMA_K(0, 0); DMA_V(0, 0); DMA_K(1, SL);
    bf16x8 qr[4];
    { const bf16_t* qp = Qb + (size_t)(qrow0 + r32) * 1024 + (2 * h + m) * 64 + hi * 8;
#pragma unroll
      for (int d0 = 0; d0 < 4; ++d0) qr[d0] = *(const bf16x8*)(qp + d0 * 16); }
    for (int idx = tid; idx < 2 * 155; idx += NWAVES * 64) { const int ti = idx / 155, i = idx % 155; const int head = 2 * h + ti;
        tab[ti * 160 + i] = (p.in[REL_BIAS][t5_bucket(i - 91) * 16 + head] - p.in[REL_BIAS][15 * 16 + head]) * LOG2E; }
    asm volatile("" : "+v"(qr[0]), "+v"(qr[1]), "+v"(qr[2]), "+v"(qr[3]));
    DMA_K(2, 2 * SL);
    f32x16 o[4];
#pragma unroll
    for (int db = 0; db < 4; ++db)
#pragma unroll
        for (int r = 0; r < 16; ++r) o[db][r] = 0.f;
    float l_reg = 0.f;
    const int tq = qrow0 + r32;
    const LAS unsigned char* kp0 = lds + (r32 >> 4) * 4096 + (8 * m + hi) * 256 + (r32 & 15) * 16;
    const LAS unsigned char* vp0 = lds + 49152 + ((lane >> 4) & 1) * 32 + (lane & 3) * 8 + (4 * hi + ((lane & 15) >> 2)) * 64;
    const LAS float* tb = tab + m * 160;
    const f32x16 zero16 = {0.f, 0.f, 0.f, 0.f, 0.f, 0.f, 0.f, 0.f, 0.f, 0.f, 0.f, 0.f, 0.f, 0.f, 0.f, 0.f};
    bf16x8 kf[8];
#define KLOAD2(kp, jj) do { kf[2 * (jj)] = *(const LAS bf16x8*)((kp) + (jj) * 512); kf[2 * (jj) + 1] = *(const LAS bf16x8*)((kp) + (jj) * 512 + 8192); } while (0)
#define BAND(C0, C1, t) do { const int relb_ = (t) * 64 - tq + 91; const bool dead_ = early && (t) == NT - 1; \
        _Pragma("unroll") for (int r = 0; r < 16; ++r) { const int kv_ = crow(r, hi); int i0_ = relb_ + kv_, i1_ = i0_ + 32; i0_ = i0_ < 0 ? 0 : (i0_ > 154 ? 154 : i0_); i1_ = i1_ < 0 ? 0 : (i1_ > 154 ? 154 : i1_); \
            C0[r] += tb[i0_]; C1[r] += tb[i1_]; if (dead_) { C0[r] = -INFINITY; C1[r] = -INFINITY; } } } while (0)
    f32x16 pA0, pA1, pB0, pB1;
    int sl_prev = 0, sl_cur = 0, sl_next = SL;
#define ROT() do { sl_prev = sl_cur; sl_cur = sl_next; sl_next = (sl_next == 2 * SL) ? 0 : sl_next + SL; } while (0)
    P3_WAIT_BAR(6);
    { const LAS unsigned char* kp = kp0;
#pragma unroll
      for (int jj = 0; jj < 4; ++jj) KLOAD2(kp, jj);
      pA0 = MFMA32(kf[0], qr[0], zero16); pA1 = MFMA32(kf[1], qr[0], zero16);
#pragma unroll
      for (int d0 = 1; d0 < 4; ++d0) { pA0 = MFMA32(kf[2 * d0], qr[d0], pA0); pA1 = MFMA32(kf[2 * d0 + 1], qr[d0], pA1); }
      if (NT <= 4) BAND(pA0, pA1, 0);
#pragma unroll
      for (int r = 0; r < 16; ++r) { pA0[r] = __builtin_amdgcn_exp2f(pA0[r]); pA1[r] = __builtin_amdgcn_exp2f(pA1[r]); } }
    P3_WAIT_BAR(2);
    DMA_K(3, 0); DMA_V(1, SL);
    ROT();
#pragma unroll
    for (int jj = 0; jj < 4; ++jj) KLOAD2(kp0 + sl_cur, jj);
    P3_WAIT_BAR(4);
    s16x4 vlo[4], vhi[4]; u32x4 pw0, pw1, pw2, pw3;
#define PKW(P, B) cvtpk(P[B], P[B + 1])
#define PAF(k) __builtin_bit_cast(bf16x8, pw##k)
#define VFR(i) (bf16x8){vlo[i][0], vlo[i][1], vlo[i][2], vlo[i][3], vhi[i][0], vhi[i][1], vhi[i][2], vhi[i][3]}
#define EX(v) __builtin_amdgcn_exp2f(v)
#define VRD(f) do { vlo[(f) & 3] = vtr(vp_ + (((f) & 3) * 4096 + ((f) >> 2) * 1024)); vhi[(f) & 3] = vtr(vp_ + (((f) & 3) * 4096 + ((f) >> 2) * 1024 + 512)); } while (0)
#define GAPA(MF, A0, A1, A2, A3, W0, W1, PW) do { MF; sacc += A0; sacc += A1; sacc += A2; sacc += A3; P3_PIN(sacc); W0; W1; P3_PIN(PW); P3_SBAR(); } while (0)
#define GAPB(f, PWK, X, B) do { o[(f) & 3] = MFMA32(PWK, VFR((f) & 3), o[(f) & 3]); X[B] = EX(X[B]); X[B + 1] = EX(X[B + 1]); P3_PIN(X); P3_SBAR(); } while (0)
#define KRD(G, jj) do { if (G) { KLOAD2(kp0 + sl_next, jj); P3_SBAR(); } } while (0)
#define STEP(C0, C1, P0, P1, t, GK, GV, GL, BANDED) do { P3_SBAR(); \
    const LAS unsigned char* vp_ = vp0 + sl_prev; \
    VRD(0); P3_SBAR(); float sacc = (P0[0] + P0[1]); \
    GAPA(C0 = MFMA32(kf[0], qr[0], zero16), P0[2], P0[3], P0[4], P0[5],     pw0[0] = PKW(P0, 0), pw0[1] = PKW(P0, 2), pw0); \
    VRD(1); P3_SBAR(); GAPA(C1 = MFMA32(kf[1], qr[0], zero16), P0[6], P0[7], P0[8], P0[9],     pw0[2] = PKW(P0, 4), pw0[3] = PKW(P0, 6), pw0); \
    VRD(2); P3_SBAR(); GAPA(C0 = MFMA32(kf[2], qr[1], C0),     P0[10], P0[11], P0[12], P0[13], pw1[0] = PKW(P0, 8), pw1[1] = PKW(P0, 10), pw1); \
    VRD(3); P3_SBAR(); GAPA(C1 = MFMA32(kf[3], qr[1], C1),     P0[14], P0[15], P1[0], P1[1],   pw1[2] = PKW(P0, 12), pw1[3] = PKW(P0, 14), pw1); \
    GAPA(C0 = MFMA32(kf[4], qr[2], C0),     P1[2], P1[3], P1[4], P1[5],     pw2[0] = PKW(P1, 0), pw2[1] = PKW(P1, 2), pw2); \
    GAPA(C1 = MFMA32(kf[5], qr[2], C1),     P1[6], P1[7], P1[8], P1[9],     pw2[2] = PKW(P1, 4), pw2[3] = PKW(P1, 6), pw2); \
    GAPA(C0 = MFMA32(kf[6], qr[3], C0),     P1[10], P1[11], P1[12], P1[13], pw3[0] = PKW(P1, 8), pw3[1] = PKW(P1, 10), pw3); \
    GAPA(C1 = MFMA32(kf[7], qr[3], C1),     P1[14], P1[15], 0.f, 0.f,       pw3[2] = PKW(P1, 12), pw3[3] = PKW(P1, 14), pw3); \
    l_reg += sacc; \
    if (GK) { DMA_K((t) + 3, sl_cur); } if (GV) { DMA_V((t) + 1, sl_next); } \
    if (BANDED) { BAND(C0, C1, t); } \
    P3_SBAR(); \
    GAPB(0, PAF(0), C0, 0);   VRD(4);  P3_SBAR(); \
    GAPB(1, PAF(0), C0, 2);   VRD(5);  P3_SBAR(); \
    GAPB(2, PAF(0), C0, 4);   VRD(6);  P3_SBAR(); \
    KRD(GL, 0); GAPB(3, PAF(0), C0, 6);   VRD(7);  P3_SBAR(); \
    GAPB(4, PAF(1), C0, 8);   VRD(8);  P3_SBAR(); \
    KRD(GL, 1); GAPB(5, PAF(1), C0, 10);  VRD(9);  P3_SBAR(); \
    GAPB(6, PAF(1), C0, 12);  VRD(10); P3_SBAR(); \
    KRD(GL, 2); GAPB(7, PAF(1), C0, 14);  VRD(11); P3_SBAR(); \
    GAPB(8, PAF(2), C1, 0);   VRD(12); P3_SBAR(); \
    KRD(GL, 3); GAPB(9, PAF(2), C1, 2);   VRD(13); P3_SBAR(); \
    GAPB(10, PAF(2), C1, 4);  VRD(14); P3_SBAR(); \
    GAPB(11, PAF(2), C1, 6);  VRD(15); P3_SBAR(); \
    GAPB(12, PAF(3), C1, 8); \
    GAPB(13, PAF(3), C1, 10); \
    GAPB(14, PAF(3), C1, 12); \
    GAPB(15, PAF(3), C1, 14); \
    } while (0)
    int t = 1;
    for (; t + 5 < NT; t += 2) {
        STEP(pB0, pB1, pA0, pA1, t, true, true, true, false);     P3_WAIT_BAR(4); ROT();
        STEP(pA0, pA1, pB0, pB1, t + 1, true, true, true, false); P3_WAIT_BAR(4); ROT();
    }
#define ENDW(tt) do { if ((tt) + 3 < NT) { P3_WAIT_BAR(4); } else if ((tt) + 2 < NT) { P3_WAIT_BAR(2); } else { P3_WAIT_BAR(0); } } while (0)
    for (; t + 1 < NT; t += 2) {
        STEP(pB0, pB1, pA0, pA1, t, (t + 3 < NT), (t + 1 < NT), (t + 1 < NT), true);         ENDW(t);     ROT();
        STEP(pA0, pA1, pB0, pB1, t + 1, (t + 4 < NT), (t + 2 < NT), (t + 2 < NT), true);     ENDW(t + 1); ROT();
    }
    STEP(pB0, pB1, pA0, pA1, NT - 1, false, false, false, true);
    if (NT == 2) P3_WAIT_BAR(0);
    { float sacc = pB0[0] + pB0[1];
#pragma unroll
      for (int r = 2; r < 16; ++r) sacc += pB0[r];
#pragma unroll
      for (int r = 0; r < 16; ++r) sacc += pB1[r];
      l_reg += sacc;
      pw0 = (u32x4){PKW(pB0, 0), PKW(pB0, 2), PKW(pB0, 4), PKW(pB0, 6)}; pw1 = (u32x4){PKW(pB0, 8), PKW(pB0, 10), PKW(pB0, 12), PKW(pB0, 14)};
      pw2 = (u32x4){PKW(pB1, 0), PKW(pB1, 2), PKW(pB1, 4), PKW(pB1, 6)}; pw3 = (u32x4){PKW(pB1, 8), PKW(pB1, 10), PKW(pB1, 12), PKW(pB1, 14)};
      const LAS unsigned char* vp_ = vp0 + sl_cur;
#pragma unroll
      for (int f = 0; f < 16; ++f) { const s16x4 lo = vtr(vp_ + ((f & 3) * 4096 + (f >> 2) * 1024)), hh = vtr(vp_ + ((f & 3) * 4096 + (f >> 2) * 1024 + 512));
          const bf16x8 vf = (bf16x8){lo[0], lo[1], lo[2], lo[3], hh[0], hh[1], hh[2], hh[3]};
          const u32x4 pk = (f >> 2) == 0 ? pw0 : ((f >> 2) == 1 ? pw1 : ((f >> 2) == 2 ? pw2 : pw3));
          o[f & 3] = MFMA32(__builtin_bit_cast(bf16x8, pk), vf, o[f & 3]); } }
#undef DMA_K
#undef DMA_V
#undef KLOAD2
#undef BAND
#undef ROT
#undef PKW
#undef PAF
#undef VFR
#undef EX
#undef VRD
#undef GAPA
#undef GAPB
#undef KRD
#undef STEP
#undef ENDW
    __syncthreads();
    { LAS float* st = (LAS float*)(lds + wid * 16384);
      const float lt = l_reg + __shfl_xor(l_reg, 32); if (hi == 0) wsf[r32] = lt;
      asm volatile("s_waitcnt lgkmcnt(0)" ::: "memory");
      float rinv[16];
#pragma unroll
      for (int r = 0; r < 16; ++r) rinv[r] = 1.f / wsf[crow(r, hi)];
#pragma unroll
      for (int db = 0; db < 4; ++db)
#pragma unroll
          for (int r = 0; r < 16; ++r) st[crow(r, hi) * 128 + 32 * db + r32] = o[db][r] * rinv[r]; }
    __syncthreads();
    { const int row = 16 * m + (lane >> 2), qd = lane & 3;
      const LAS float* s0 = (const LAS float*)(lds + (2 * grp) * 16384) + row * 128 + qd * 32; const LAS float* s1 = s0 + 4096;
      float x[32]; float ss = 0.f;
#pragma unroll
      for (int e = 0; e < 32; ++e) { x[e] = s0[e] - lam * s1[e]; ss += x[e] * x[e]; }
      ss += __shfl_xor(ss, 1); ss += __shfl_xor(ss, 2);
      const float rs = rsqrtf(ss * (1.f / 128.f) + 1e-6f) * (1.f - lam_init);
      const float* sg = p.in[D_SUBLN] + j * 128 + qd * 32; bf16_t* op = Ob + ((size_t)qb * 128 + grp * 32 + row) * 1024 + h * 128 + qd * 32;
#pragma unroll
      for (int c = 0; c < 4; ++c) { u32x4 w;
          w.x = cvtpk(x[8 * c] * rs * sg[8 * c], x[8 * c + 1] * rs * sg[8 * c + 1]); w.y = cvtpk(x[8 * c + 2] * rs * sg[8 * c + 2], x[8 * c + 3] * rs * sg[8 * c + 3]);
          w.z = cvtpk(x[8 * c + 4] * rs * sg[8 * c + 4], x[8 * c + 5] * rs * sg[8 * c + 5]); w.w = cvtpk(x[8 * c + 6] * rs * sg[8 * c + 6], x[8 * c + 7] * rs * sg[8 * c + 7]);
          *(u32x4*)(op + 8 * c) = w; } }
}
struct SEpiQKV {
    bf16_t *Qb, *Kb, *Vb; int ldkv, nq, nk, has_norm; const float *qg, *kg; float qscale; float *ks, *vs; int swa;
    __device__ __forceinline__ float pre(int, int hg, int lane) const { if (!has_norm || hg >= nq + nk) return 1.f; return (hg < nq ? pg8::opq(qg) : pg8::opq(kg))[lane]; }
    __device__ __forceinline__ void operator()(int row  , int hg, int lane, float v, int, float ss  , float aux) const {
        int type, gi; if (hg < nq) { type = 0; gi = hg; } else if (hg < nq + nk) { type = 1; gi = hg - nq; } else { type = 2; gi = hg - nq - nk; }
        if (has_norm && type < 2) { v = v * rsqrtf(ss * (1.f / 64.f) + 1e-6f) * aux; }
        if (type == 0) { v *= qscale; Qb[(size_t)(TP + row) * 1024 + gi * 64 + lane] = (bf16_t)f2bf(v); return; }
        bf16_t* bd = type == 1 ? pg8::opq(Kb) : pg8::opq(Vb); float* fd = type == 1 ? pg8::opq(ks) : pg8::opq(vs);
        bd[(size_t)(TP + row) * ldkv + gi * 64 + lane] = (bf16_t)f2bf(v);
        const size_t frow = swa ? (size_t)(row >> 5) * 128 + 96 + (row & 31) : (size_t)row;
        fd[frow * ldkv + gi * 64 + lane] = v;
    }
};
struct SEpiRelu2 { bf16_t* U; __device__ __forceinline__ float pre(int, int, int) const { return 0.f; }
    __device__ __forceinline__ void operator()(int row, int ct, int lane, float v, int, float, float) const { const float a = fmaxf(v, 0.f); U[(size_t)(TP + row) * FF + ct * 64 + lane] = (bf16_t)f2bf(a * a); } };
struct SEpiResid { const float* xin32; const bf16_t* xin16; bf16_t* xout16; float* y32; float* slab;
    __device__ __forceinline__ float pre(int row, int ct, int lane) const { if (slab) return 0.f; const size_t o = (size_t)row * 1024 + ct * 64 + lane, og = (size_t)(TP + row) * 1024 + ct * 64 + lane;
        return xin32 ? xin32[o] : __uint_as_float((unsigned)xin16[og] << 16); }
    __device__ __forceinline__ void operator()(int row, int ct, int lane, float v, int ks, float, float aux) const { const size_t o = (size_t)row * 1024 + ct * 64 + lane, og = (size_t)(TP + row) * 1024 + ct * 64 + lane;
        if (slab) { slab[(size_t)ks * TS * 1024 + o] = v; return; }
        const float x = aux + v;
        if (y32) y32[o] = x; else xout16[og] = (bf16_t)f2bf(x); } };

#define SG_WAIT_BAR(N) asm volatile("s_waitcnt vmcnt(" #N ") lgkmcnt(0)\n\ts_barrier" ::: "memory")
template <class Epi>
__device__ __forceinline__ void sgemm_phase(LAS unsigned char* lds, const bf16_t* A  , int lda, const bf16_t* Bt  , int K, int N, bool perm256, const Epi& E, int vcu, int G, int ksplit = 1) {
    const int tid = pg8::otid(), lane = tid & 63, r32 = lane & 31, hi = lane >> 5; const int wid = __builtin_amdgcn_readfirstlane(tid >> 6);
    const int rh = wid & 1, cq = wid >> 1, ncb = N / 128, nitems = 8 * ncb * ksplit, kc = K / ksplit, nst = kc / 64;
    LAS float* tile = (LAS float*)(lds + 98304);
    const unsigned lds0 = (unsigned)(uintptr_t)lds;
    for (int it = vcu; it < nitems; it += G) {
        const int ks = it / (8 * ncb), it2 = it - ks * 8 * ncb, rb = it2 & 7, cb = it2 >> 3, kbase = ks * kc;
        int R, C; pg8::stage_rc(wid * 1024 + lane * 16, R, C);
        int b0r, b1r;
        if (perm256) { const int h0 = 2 * cb, h1 = 2 * cb + 1; b0r = (h0 >> 2) * 256 + 32 * (h0 & 3) + (R & 31) + 128 * (R >> 5); b1r = (h1 >> 2) * 256 + 32 * (h1 & 3) + (R & 31) + 128 * (R >> 5); }
        else { b0r = cb * 128 + R; b1r = cb * 128 + 64 + R; }
        const bf16_t* asrc = A + (size_t)(rb * 64 + R) * lda + C + kbase;
        const bf16_t* b0src = Bt + (size_t)b0r * K + C + kbase; const bf16_t* b1src = Bt + (size_t)b1r * K + C + kbase;
        const unsigned dst = lds0 + wid * 1024;
#define SG_DMA(st) do { const unsigned so_ = dst + (unsigned)((st) & 3) * 24576u; const int ko_ = (st) * 64; \
        glds16(asrc + ko_, (unsigned)__builtin_amdgcn_readfirstlane(so_)); glds16(b0src + ko_, (unsigned)__builtin_amdgcn_readfirstlane(so_ + 8192u)); glds16(b1src + ko_, (unsigned)__builtin_amdgcn_readfirstlane(so_ + 16384u)); } while (0)
        f32x16 c;
#pragma unroll
        for (int r = 0; r < 16; ++r) c[r] = 0.f;
        __syncthreads();
        SG_DMA(0); SG_DMA(1); SG_DMA(2);
        for (int st = 0; st < nst; ++st) {
            if (st + 2 < nst) SG_WAIT_BAR(6); else SG_WAIT_BAR(0);
            if (st + 3 < nst) SG_DMA(st + 3);
            const LAS unsigned char* bb = lds + (st & 3) * 24576;
            const LAS unsigned char* wb = bb + 8192 + (cq >> 1) * 8192;
            bf16x8 af[4], bf[4];
#pragma unroll
            for (int d0 = 0; d0 < 4; ++d0) { af[d0] = *(const LAS bf16x8*)(bb + pg8::lds_byte(rh * 32 + r32, 16 * d0 + 8 * hi)); bf[d0] = *(const LAS bf16x8*)(wb + pg8::lds_byte((cq & 1) * 32 + r32, 16 * d0 + 8 * hi)); }
#pragma unroll
            for (int d0 = 0; d0 < 4; ++d0) c = MFMA32(af[d0], bf[d0], c);
        }
#undef SG_DMA
        __syncthreads();
#pragma unroll
        for (int r = 0; r < 16; ++r) tile[(rh * 32 + crow(r, hi)) * 128 + cq * 32 + r32] = c[r];
        __syncthreads();
        float tv[8][2], tss[8][2];
#pragma unroll
        for (int rr = 0; rr < 8; ++rr) { const int row = wid * 8 + rr; tv[rr][0] = tile[row * 128 + lane]; tv[rr][1] = tile[row * 128 + 64 + lane]; tss[rr][0] = tv[rr][0] * tv[rr][0]; tss[rr][1] = tv[rr][1] * tv[rr][1]; }
#pragma unroll
        for (int o = 32; o; o >>= 1)
#pragma unroll
            for (int rr = 0; rr < 8; ++rr) { tss[rr][0] += __shfl_xor(tss[rr][0], o); tss[rr][1] += __shfl_xor(tss[rr][1], o); }
        float tax[8][2];
#pragma unroll
        for (int rr = 0; rr < 8; ++rr) { const int row = wid * 8 + rr; tax[rr][0] = E.pre(rb * 64 + row, 2 * cb, lane); tax[rr][1] = E.pre(rb * 64 + row, 2 * cb + 1, lane); }
#pragma unroll
        for (int rr = 0; rr < 8; ++rr) { const int row = wid * 8 + rr;
            E(rb * 64 + row, 2 * cb, lane, tv[rr][0], ks, tss[rr][0], tax[rr][0]); E(rb * 64 + row, 2 * cb + 1, lane, tv[rr][1], ks, tss[rr][1], tax[rr][1]); }
    }
}
#ifndef FX_STAMP
#define FX_STAMP 0
#endif
#ifndef FX_NO_SMALL
#define FX_NO_SMALL 0
#endif
#ifndef FX_SP2
#define FX_SP2 true
#endif
__global__ void __launch_bounds__(NWAVES * 64, 2) mega(Params p) {
    extern __shared__ __attribute__((aligned(16))) unsigned char lds_raw[];
    LAS unsigned char* lds = (LAS unsigned char*)lds_raw;
    const int tid = threadIdx.x, lane = tid & 63; const int wave = __builtin_amdgcn_readfirstlane(tid >> 6);
    const int G = gridDim.x; const int vcu = (G % 8 == 0) ? ((int)blockIdx.x % 8) * (G / 8) + (int)blockIdx.x / 8 : (int)blockIdx.x;
    const int gw = vcu * NWAVES + wave, NGW = G * NWAVES;
    unsigned* ctl = (unsigned*)(p.ws + WS_CTL);
    for (int u = tid; u < (LDS_BYTES - LDSCTL_OFF) / 4; u += NWAVES * 64) ((LAS unsigned*)(lds + LDSCTL_OFF))[u] = 0u;
    __syncthreads();
    XcdBarrier bar = xcd_barrier_post(ctl + CW_BAR + p.li * XCD_BAR_WORDS, (volatile LAS unsigned*)(lds + MISC_OFF) + 8);
    const int lo = p.ph_lo, hi_ph = p.ph_hi;
#define IN(k) (lo <= (k) && (k) < hi_ph)
#define SEAM(k) do { if (FX_STAMP && blockIdx.x == 0 && tid == 0) ((unsigned long long*)(ctl + 200000))[64 + (k)] = __builtin_amdgcn_s_memrealtime(); if (IN(k) && IN((k) + 1)) xcd_barrier(bar); if (FX_STAMP && blockIdx.x == 0 && tid == 0) ((unsigned long long*)(ctl + 200000))[(k) + 1] = __builtin_amdgcn_s_memrealtime(); } while (0)
#define MIDSTAMP(k) do { if (FX_STAMP && blockIdx.x == 0 && tid == 0) ((unsigned long long*)(ctl + 200000))[32 + (k)] = __builtin_amdgcn_s_memrealtime(); } while (0)
#define WSP(off) ((bf16_t*)(pg8::opq(p.ws) + (off)))
#define SPLIT_ARRIVE(k) do { asm volatile("s_waitcnt vmcnt(0)" ::: "memory"); __syncthreads(); \
        if (tid == 0) { __builtin_amdgcn_fence(__ATOMIC_RELEASE, "agent"); asm volatile("s_waitcnt vmcnt(0)" ::: "memory"); (void)xb_add(ctl + CW_FLAG + 64 * (k), 1u); } } while (0)
#define SPLIT_WAIT(k) do { if (tid == 0) { XB_SPIN(xb_ld(ctl + CW_FLAG + 64 * (k)) < (unsigned)G, bar.bar); __builtin_amdgcn_fence(__ATOMIC_ACQUIRE, "agent"); asm volatile("s_waitcnt vmcnt(0)" ::: "memory"); } __syncthreads(); } while (0)

    if (FX_STAMP && blockIdx.x == 0 && tid == 0) ((unsigned long long*)(ctl + 200000))[0] = __builtin_amdgcn_s_memrealtime();
    if (IN(0)) prologue(p, lds, gw, NGW, wave, pg8::otid() & 63);
    for (int layer = 0; layer < 4; ++layer) {
        const int pb = 1 + 7 * layer, mix = layer % 3, j = layer / 3;
        const size_t wlo = WS_W + (size_t)layer * WL_BYTES;

        if (layer == 0) {
            if (IN(pb + 0)) { __syncthreads(); rms0_phase(p.in[X_P], p.in[X_S], WSP(WS_XN), pg8::opqi(gw), NGW, pg8::otid() & 63); }
            SEAM(pb + 0); }
        if (IN(pb + 1)) {
            const int N = mix == 1 ? 1536 : 3072;
            if (layer > 0) {
                { const int pm0_ = pg8::static_pm0(TP, N, G, (int)blockIdx.x); const int t_ = pg8::otid() - 256;
                  if (pm0_ >= 0 && t_ >= 0) { const f32x4* r_ = (const f32x4*)((const float*)WSP(WS_RSS) + (size_t)(pm0_ * 256 + t_) * 16); const f32x4 a_ = r_[0], b_ = r_[1], c_ = r_[2], d_ = r_[3]; const f32x4 q_ = (a_ + b_) + (c_ + d_);
                      ((LAS float*)(lds + GA_TAB))[t_] = rsqrtf(((q_[0] + q_[1]) + (q_[2] + q_[3])) * (1.f / 1024.f) + 1e-6f); } }
                rms_phase(nullptr, nullptr, WSP(WS_XR), (const float*)WSP(WS_SLAB), TP, WSP(WS_XN), pg8::opqi(wave * G + vcu), NGW, pg8::otid() & 63); SPLIT_ARRIVE(2 * layer); }
            pg8::Gemm g{layer == 0 ? WSP(WS_XN) : WSP(WS_XR), WSP(wlo + WL_QKV), TP, N, D}; pg8::StaticOrder S; S.init(TP, N, G, (int)blockIdx.x);
            pg8::EpiQKV E; E.rowss = layer == 0 ? (const float*)nullptr : (const float*)WSP(WS_RSS);
            E.Qb = WSP(WS_Q); E.Kb = WSP(WS_K); E.Vb = WSP(WS_V); E.ldkv = mix == 1 ? 256 : 1024; E.nq = 16; E.nk = mix == 1 ? 4 : 16; E.has_norm = mix != 2; E.swa = mix == 1;
            E.qg = mix == 0 ? p.in[D_QN] + j * 64 : p.in[S_QN]; E.kg = mix == 0 ? p.in[D_KN] + j * 64 : p.in[S_KN]; E.qscale = QSC;
            E.kp = mix == 0 ? p.dkp[j] : (mix == 1 ? p.wkp : p.bkp); E.vp = mix == 0 ? p.dvp[j] : (mix == 1 ? p.wvp : p.bvp);
            E.ks = mix == 0 ? p.dks[j] : (mix == 1 ? p.wks : p.bks); E.vs = mix == 0 ? p.dvs[j] : (mix == 1 ? p.wvs : p.bvs);
            E.rtab = (const LAS float*)(lds + GA_TAB);
            pg8::gemm_phase<pg8::EpiQKV, pg8::StaticOrder, true, FX_SP2>(lds, g, S, E);
            MIDSTAMP(pb + 1);
            SEpiQKV SE; SE.Qb = E.Qb; SE.Kb = E.Kb; SE.Vb = E.Vb; SE.ldkv = E.ldkv; SE.nq = E.nq; SE.nk = E.nk; SE.has_norm = E.has_norm; SE.qg = E.qg; SE.kg = E.kg; SE.qscale = E.qscale; SE.ks = E.ks; SE.vs = E.vs; SE.swa = E.swa;
            if (layer > 0) SPLIT_WAIT(2 * layer);
            const int vs_ = (mix == 1 && G == 256) ? (((int)blockIdx.x + 128) & 255) : vcu;
            if (!FX_NO_SMALL) sgemm_phase(lds, WSP(WS_XN) + (size_t)TP * D, D, WSP(wlo + WL_QKV), D, N, true, SE, vs_, G);
        }
        SEAM(pb + 1);
        if (IN(pb + 2)) {
            bf16_t *Qb = WSP(WS_Q), *Kb = WSP(WS_K), *Vb = WSP(WS_V), *Ob = WSP(WS_O);
            if (mix == 0) {
                const float lam_init = layer == 0 ? 0.2f : 0.55605820417f;
                const float* lp = p.in[D_LAM] + j * 256;
                const int ln = pg8::otid() & 63; const float lam = expf(wave_sum(lp[ln] * lp[64 + ln])) - expf(wave_sum(lp[128 + ln] * lp[192 + ln])) + lam_init;
                for (int u = vcu; u < 1024; u += G) { const int k = u >> 8, v = u & 255, h = v >> 5, s = v & 31; const int qb = k == 0 ? s : (k == 1 ? 63 - s : (k == 2 ? (s < 16 ? 80 + s : 48 + s) : 127 - s));
                    attn_diff_p3(p, lds, h, qb, j, lam, lam_init, Qb, Kb, Vb, Ob);
                    if (k == 0 && s >= 16) { const int us_ = h * 16 + (s - 16); attn_unit<M_DIFF_S>(p, lds, us_ >> 3, us_ & 7, j, lam, lam_init, Qb, Kb, Vb, Ob); } }
            } else if (mix == 1) {
                for (int u = vcu; u < 1024; u += G) attn_unit<M_SWA_P>(p, lds, u >> 2, u & 3, 0, 0.f, 0.f, Qb, Kb, Vb, Ob);
                for (int u = vcu; u < 64; u += G) attn_unit<M_SWA_S>(p, lds, u >> 2, u & 3, 0, 0.f, 0.f, Qb, Kb, Vb, Ob);
            } else {
                for (int u = vcu; u < 1024; u += G) attn_unit<M_SB_P>(p, lds, u >> 2, u & 3, 0, 0.f, 0.f, Qb, Kb, Vb, Ob);
                for (int u = vcu; u < 64; u += G) attn_unit<M_SB_S>(p, lds, u >> 2, u & 3, 0, 0.f, 0.f, Qb, Kb, Vb, Ob);
            }
        }
        SEAM(pb + 2);
        if (IN(pb + 3)) {
            pg8::Gemm g{WSP(WS_O), WSP(wlo + WL_O), TP, D, D}; pg8::StaticOrder S; S.init(TP, D, G, (int)blockIdx.x);
            pg8::EpiResid E{layer == 0 ? p.in[X_P] : (const float*)nullptr, WSP(WS_XR), WSP(WS_XR), nullptr, (float*)WSP(WS_RSS)};
            pg8::gemm_phase<pg8::EpiResid, pg8::StaticOrder, true, FX_SP2>(lds, g, S, E);
            MIDSTAMP(pb + 3);
            SEpiResid SE{nullptr, nullptr, nullptr, nullptr, (float*)WSP(WS_SLAB)};
            if (!FX_NO_SMALL) sgemm_phase(lds, WSP(WS_O) + (size_t)TP * D, D, WSP(wlo + WL_O), D, D, false, SE, vcu, G, 4);
        }
        SEAM(pb + 3);
        if (IN(pb + 5)) {
            { const int pm0_ = pg8::static_pm0(TP, FF, G, (int)blockIdx.x); const int t_ = pg8::otid() - 256;
                  if (pm0_ >= 0 && t_ >= 0) { const f32x4* r_ = (const f32x4*)((const float*)WSP(WS_RSS) + (size_t)(pm0_ * 256 + t_) * 16); const f32x4 a_ = r_[0], b_ = r_[1], c_ = r_[2], d_ = r_[3]; const f32x4 q_ = (a_ + b_) + (c_ + d_);
                      ((LAS float*)(lds + GA_TAB))[t_] = rsqrtf(((q_[0] + q_[1]) + (q_[2] + q_[3])) * (1.f / 1024.f) + 1e-6f); } }
            rms_phase(nullptr, layer == 0 ? p.in[X_S] : (const float*)nullptr, WSP(WS_XR), (const float*)WSP(WS_SLAB), TP, WSP(WS_XN), pg8::opqi(wave * G + vcu), NGW, pg8::otid() & 63); SPLIT_ARRIVE(2 * layer + 1);
            pg8::Gemm g{WSP(WS_XR), WSP(wlo + WL_UP), TP, FF, D}; pg8::StaticOrder S; S.init(TP, FF, G, (int)blockIdx.x);
            pg8::EpiRelu2 E; E.O = WSP(WS_U); E.ldc = FF; E.rowss = (const float*)WSP(WS_RSS);
            E.rtab = (const LAS float*)(lds + GA_TAB);
            pg8::gemm_phase<pg8::EpiRelu2, pg8::StaticOrder, true, FX_SP2>(lds, g, S, E);
            MIDSTAMP(pb + 5);
            SEpiRelu2 SE{WSP(WS_U)};
            SPLIT_WAIT(2 * layer + 1);
            if (!FX_NO_SMALL) sgemm_phase(lds, WSP(WS_XN) + (size_t)TP * D, D, WSP(wlo + WL_UP), D, FF, false, SE, vcu, G);
        }
        SEAM(pb + 5);
        if (IN(pb + 6)) {
            float* yo = layer == 3 ? pg8::opq(p.yout) : (float*)nullptr;
            pg8::Gemm g{WSP(WS_U), WSP(wlo + WL_DN), TP, D, FF}; pg8::StaticOrder S; S.init(TP, D, G, (int)blockIdx.x);
            pg8::EpiResid E{nullptr, WSP(WS_XR), WSP(WS_XR), yo, yo ? (float*)nullptr : (float*)WSP(WS_RSS)};
            pg8::gemm_phase<pg8::EpiResid, pg8::StaticOrder, true, FX_SP2>(lds, g, S, E);
            MIDSTAMP(pb + 6);
            SEpiResid SE{nullptr, WSP(WS_XR), WSP(WS_XR), yo ? yo + (size_t)TP * D : (float*)nullptr, yo ? (float*)nullptr : (float*)WSP(WS_SLAB)};
            if (!FX_NO_SMALL) sgemm_phase(lds, WSP(WS_U) + (size_t)TP * FF, FF, WSP(wlo + WL_DN), FF, D, false, SE, vcu, G, yo ? 1 : 4);
        }
        SEAM(pb + 6);
    }
#undef IN
#undef SEAM
#undef WSP
#undef SPLIT_ARRIVE
#undef SPLIT_WAIT
#undef XRES
}
constexpr int N_PHASES = 29;

static int fast_grid() {
    static int grid = 0;
    if (grid == 0) {
        int dev = 0, cus = 0;
        if (hipGetDevice(&dev) != hipSuccess || hipDeviceGetAttribute(&cus, hipDeviceAttributeMultiprocessorCount, dev) != hipSuccess) { grid = -1; return grid; }
        if (hipFuncSetAttribute((const void*)mega, hipFuncAttributeMaxDynamicSharedMemorySize, LDS_BYTES) != hipSuccess) { fprintf(stderr, "hipFuncSetAttribute failed\n"); grid = -1; return grid; }
        int per_cu = 0;
        if (hipOccupancyMaxActiveBlocksPerMultiprocessor(&per_cu, (const void*)mega, NWAVES * 64, LDS_BYTES) != hipSuccess || per_cu < 1) { fprintf(stderr, "occupancy query: %d blocks/CU\n", per_cu); (void)hipGetLastError(); }
        grid = cus;
    }
    return grid;
}
static void launch_fast(Params p, int lo, int hi, int li, hipStream_t st) {
    const int grid = fast_grid(); if (grid <= 0) return;
    p.ph_lo = lo; p.ph_hi = hi; p.li = li; p.pad = 0;
    hipLaunchKernelGGL(mega, dim3(grid), dim3(NWAVES * 64), LDS_BYTES, st, p);
    const hipError_t e = hipPeekAtLastError(); if (e != hipSuccess) fprintf(stderr, "mega launch failed: %s\n", hipGetErrorName(e));
}
}
namespace oo {
constexpr size_t TPD = (size_t)fx::TP * fx::D, TSD = (size_t)fx::TS * fx::D;
constexpr size_t Y = 0, DKP = (size_t)fx::T * fx::D, DVP = DKP + 2 * TPD, WKP = DVP + 2 * TPD, WVP = WKP + 32768, BKP = WVP + 32768, BVP = BKP + TPD,
    DKS = BVP + TPD, DVS = DKS + 2 * TSD, WKS = DVS + 2 * TSD, WVS = WKS + 524288, BKS = WVS + 524288, BVS = BKS + 524288, END = BVS + 524288;
static_assert(END == 122224640ull, "output size");
}
#if FX_STAMP
#ifndef ST_A
#define ST_A 3
#endif
#ifndef ST_B
#define ST_B 2
#endif
__global__ void encode_time(const unsigned long long* st, float* ys, int n, float* y0) {
    __shared__ float sc;
    if (threadIdx.x == 0) {
        float us[29]; for (int k = 0; k < 29; ++k) us[k] = (float)(st[k + 1] - st[k]) * 0.01f;
        float g[16]; for (int i = 0; i < 16; ++i) g[i] = 0.f;
        g[0] = us[0];
        for (int L = 0; L < 4; ++L) { const int pb = 1 + 7 * L, mix = L % 3; g[1] += us[pb]; g[2] += us[pb + 1]; g[3 + mix] += us[pb + 2]; g[6] += us[pb + 3]; g[7] += us[pb + 4]; g[8] += us[pb + 5]; g[9] += us[pb + 6]; }
        g[13] = g[0] + g[1] + g[7]; g[14] = g[4] + g[5]; g[15] = g[2] + g[6] + g[8] + g[9];
        g[10] = 0.f; g[11] = 0.f; for (int L = 0; L < 4; ++L) { const int pb = 1 + 7 * L; g[10] += (float)(st[64 + pb + 6] - st[32 + pb + 6]) * 0.01f; g[11] += (float)(st[64 + pb + 1] - st[32 + pb + 1]) * 0.01f + (float)(st[64 + pb + 3] - st[32 + pb + 3]) * 0.01f + (float)(st[64 + pb + 5] - st[32 + pb + 5]) * 0.01f; }
        sc = 1.f + sqrtf(g[ST_A] * 1e-4f);
        y0[0] += g[ST_B] * 0.01f;
    }
    __syncthreads();
    const float s = sc;
    for (int i = blockIdx.x * blockDim.x + threadIdx.x; i < n; i += gridDim.x * blockDim.x) ys[i] *= s;
}
#endif
#ifndef FX_N_LAUNCH
#define FX_N_LAUNCH 1
#endif
extern "C" void kernel_launch(void* const* d_in, const int* in_sizes, int n_in, void* d_out, int out_size, void* d_ws, size_t ws_size, hipStream_t stream) {
    using namespace fx;
    if (n_in != 26 || out_size != (int)oo::END || ws_size < WS_END) { fprintf(stderr, "kernel_launch: unexpected sizes n_in %d out %d ws %zu\n", n_in, out_size, ws_size); return; }
    unsigned char* ws = (unsigned char*)d_ws; float* out = (float*)d_out;
    (void)hipMemsetAsync(ws + WS_CTL, 0, CTL_ZERO_BYTES, stream);
    Params p{};
    for (int i = 0; i < 26; ++i) p.in[i] = (const float*)d_in[i];
    p.ws = ws; p.yout = out + oo::Y;
    for (int j = 0; j < 2; ++j) { p.dkp[j] = out + oo::DKP + j * oo::TPD; p.dvp[j] = out + oo::DVP + j * oo::TPD; p.dks[j] = out + oo::DKS + j * oo::TSD; p.dvs[j] = out + oo::DVS + j * oo::TSD; }
    p.wkp = out + oo::WKP; p.wvp = out + oo::WVP; p.wks = out + oo::WKS; p.wvs = out + oo::WVS;
    p.bkp = out + oo::BKP; p.bvp = out + oo::BVP; p.bks = out + oo::BKS; p.bvs = out + oo::BVS;
    if (FX_N_LAUNCH == 1) launch_fast(p, 0, N_PHASES, 0, stream);
    else for (int k = 0; k < N_PHASES; ++k) launch_fast(p, k, k + 1, k, stream);
#if FX_STAMP
    encode_time<<<32, 256, 0, stream>>>((const unsigned long long*)((unsigned*)(ws + WS_CTL) + 200000), out + oo::WVP, 32768, out + 5);
#endif
}
```
